# Optimizing an MI355X kernel written in HIP

```python
import math
import jax
import jax.numpy as jnp
from jax import lax
import numpy as np

D_MODEL = 1024
BATCH = 8
SEQ = 4096
DEPTH = 2

GRID_W = 64
CTX_LEN = 256
EPS = 1e-6
A_WIDTH = 512
A_CONV = 3
B_HEADS = 4
B_DK = 128
B_DV = 128
B_CONV = 3
B_CHUNK = 64
B_QK = B_HEADS * B_DK
B_VW = B_HEADS * B_DV
IN_EVEN = 3 * A_WIDTH + 2 * B_QK + 2 * B_VW + 4 * B_HEADS
MIX_EVEN = A_WIDTH + B_VW
C_HEADS = 8
C_Q_LORA = 384
C_KV_LORA = 256
C_NOPE = 128
C_ROPE = 64
C_VDIM = 128
C_QBLOCK = 128
IN_ODD = C_Q_LORA + C_KV_LORA + C_ROPE
MIX_ODD = C_HEADS * C_VDIM
ROPE_BASE = 10000.0
P_HEADS = 8
P_NKEYS = 128
P_NEXP = P_NKEYS * P_NKEYS
P_DKEY = 128
P_TOPK = 16
P_BLOCK = 128
N_EVEN = (DEPTH + 1) // 2
N_ODD = DEPTH // 2

kernel_name = 'hybrid_conv_deltanet_mla_peer_dit'


def rms_norm(x, gain):
    xf = x.astype(jnp.float32)
    y = xf * lax.rsqrt(jnp.mean(xf * xf, axis=-1, keepdims=True) + EPS)
    return (y * gain.astype(jnp.float32)).astype(x.dtype)


def modulate(h, shift, scale):
    return h * (1 + scale[..., None, :]) + shift[..., None, :]


def dwconv_centred(x, w):
    p = w.shape[0] // 2
    return lax.conv_general_dilated(x, w[:, None, :].astype(x.dtype), window_strides=(1,), padding=[(p, p)],
                                    dimension_numbers=('NWC', 'WIO', 'NWC'), feature_group_count=x.shape[-1])


def l2_normalize(t):
    return t * lax.rsqrt(jnp.sum(t * t, axis=-1, keepdims=True) + EPS)


def gdn_chunked(q, k, v, g, beta, s0):
    Bn, H, L, dk = q.shape
    dv = v.shape[-1]
    n = L // B_CHUNK
    q = q * (dk ** -0.5)
    rs = lambda t: t.reshape((Bn, H, n, B_CHUNK) + t.shape[3:])
    q, k, v, g, beta = rs(q), rs(k), rs(v), rs(g), rs(beta)
    decay = jnp.cumsum(g, axis=-1)
    tri = jnp.tril(jnp.ones((B_CHUNK, B_CHUNK), bool))
    strict = jnp.tril(jnp.ones((B_CHUNK, B_CHUNK), bool), -1)
    gamma = jnp.exp(jnp.where(tri, decay[..., :, None] - decay[..., None, :], -jnp.inf))
    kb = k * beta[..., None]
    a = jnp.where(strict, jnp.einsum('bhncd,bhnmd->bhncm', kb, k) * gamma, 0.0)
    eye = jnp.eye(B_CHUNK, dtype=jnp.float32)
    rhs = jnp.concatenate([v * beta[..., None], kb * jnp.exp(decay)[..., None]], axis=-1)
    sol = lax.linalg.triangular_solve(eye + a, rhs, left_side=True, lower=True)
    u, w = sol[..., :dv], sol[..., dv:]
    intra = jnp.where(tri, jnp.einsum('bhncd,bhnmd->bhncm', q, k) * gamma, 0.0)
    q_dec = q * jnp.exp(decay)[..., None]
    k_dec = k * jnp.exp(decay[..., -1:] - decay)[..., None]
    last = jnp.exp(decay[..., -1])

    def step(s, inp):
        u_c, w_c, qd_c, kd_c, intra_c, last_c = inp
        v_new = u_c - jnp.einsum('bhck,bhkv->bhcv', w_c, s)
        o = jnp.einsum('bhck,bhkv->bhcv', qd_c, s) + jnp.einsum('bhcm,bhmv->bhcv', intra_c, v_new)
        s = s * last_c[..., None, None] + jnp.einsum('bhck,bhcv->bhkv', kd_c, v_new)
        return s, o

    xs = tuple(jnp.moveaxis(t, 2, 0) for t in (u, w, q_dec, k_dec, intra, last))
    s_fin, o = lax.scan(step, s0, xs)
    o = jnp.moveaxis(o, 0, 2).reshape(Bn, H, L, dv)
    return o, s_fin


def even_mixer(h, w_in, a_conv, qkv_conv, a_log, dt_bias, o_norm, w_out, s0_f, s0_b):
    Bn, L, _ = h.shape
    proj = h @ w_in
    bg, cg, xa, qkv, z, ab = jnp.split(
        proj, [A_WIDTH, 2 * A_WIDTH, 3 * A_WIDTH, 3 * A_WIDTH + 2 * B_QK + B_VW, 3 * A_WIDTH + 2 * B_QK + 2 * B_VW], axis=-1)
    y_a = bg * dwconv_centred(cg * xa, a_conv)
    qkv = jax.nn.silu(dwconv_centred(qkv, qkv_conv)).astype(jnp.float32)
    q, k, v = jnp.split(qkv, [B_QK, 2 * B_QK], axis=-1)
    heads = lambda t, d: t.reshape(Bn, L, B_HEADS, d).transpose(0, 2, 1, 3)
    q = l2_normalize(heads(q, B_DK))
    k = l2_normalize(heads(k, B_DK))
    v = heads(v, B_DV)
    ab4 = ab.reshape(Bn, L, 4, B_HEADS).transpose(2, 0, 3, 1).astype(jnp.float32)
    a_log = a_log.astype(jnp.float32)
    dt_bias = dt_bias.astype(jnp.float32)
    g_f = -jnp.exp(a_log[0])[None, :, None] * jax.nn.softplus(ab4[0] + dt_bias[0][None, :, None])
    g_b = -jnp.exp(a_log[1])[None, :, None] * jax.nn.softplus(ab4[1] + dt_bias[1][None, :, None])
    beta_f = jax.nn.sigmoid(ab4[2])
    beta_b = jax.nn.sigmoid(ab4[3])
    o_f, s_f = gdn_chunked(q, k, v, g_f, beta_f, s0_f)
    flip = lambda t: jnp.flip(t, axis=2)
    o_b, s_b = gdn_chunked(flip(q), flip(k), flip(v), flip(g_b), flip(beta_b), s0_b)
    o = (o_f + flip(o_b)).transpose(0, 2, 1, 3).astype(h.dtype)
    y_b = (rms_norm(o, o_norm) * jax.nn.silu(z.reshape(Bn, L, B_HEADS, B_DV))).reshape(Bn, L, B_VW)
    y = jnp.concatenate([y_a, y_b], axis=-1) @ w_out
    return y, s_f, s_b


def axial_rope(x, rows, cols):
    half = x.shape[-1] // 2

    def rot(seg, pos):
        n = seg.shape[-1] // 2
        freqs = ROPE_BASE ** (-jnp.arange(n, dtype=jnp.float32) / n)
        ang = pos.astype(jnp.float32)[:, None] * freqs[None, :]
        cos = jnp.cos(ang)[None, :, None, :]
        sin = jnp.sin(ang)[None, :, None, :]
        s1 = seg[..., :n].astype(jnp.float32)
        s2 = seg[..., n:].astype(jnp.float32)
        return jnp.concatenate([s1 * cos - s2 * sin, s2 * cos + s1 * sin], axis=-1)

    return jnp.concatenate([rot(x[..., :half], rows), rot(x[..., half:], cols)], axis=-1).astype(x.dtype)


def mla_project(h, w_in, q_norm, kv_norm, w_uq, w_ukv, rows, cols):
    Bn, L, _ = h.shape
    proj = h @ w_in
    cq, ckv, k_rope = jnp.split(proj, [C_Q_LORA, C_Q_LORA + C_KV_LORA], axis=-1)
    q = (rms_norm(cq, q_norm) @ w_uq).reshape(Bn, L, C_HEADS, C_NOPE + C_ROPE)
    kv = (rms_norm(ckv, kv_norm) @ w_ukv).reshape(Bn, L, C_HEADS, C_NOPE + C_VDIM)
    q_nope, q_rope = q[..., :C_NOPE], q[..., C_NOPE:]
    k_nope, v = kv[..., :C_NOPE], kv[..., C_NOPE:]
    k_rope = k_rope[:, :, None, :]
    if rows is not None:
        q_rope = axial_rope(q_rope, rows, cols)
        k_rope = axial_rope(k_rope, rows, cols)
    q = jnp.concatenate([q_nope, q_rope], axis=-1)
    k = jnp.concatenate([k_nope, jnp.broadcast_to(k_rope, (Bn, L, C_HEADS, C_ROPE))], axis=-1)
    return q, k, v


def block_attention(q, k, v):
    Bn, Lq, H, dq = q.shape
    nb = Lq // C_QBLOCK
    qb = q.reshape(Bn, nb, C_QBLOCK, H, dq).transpose(1, 0, 2, 3, 4)
    scale = dq ** -0.5

    def one(qblk):
        s = jnp.einsum('bqhd,bkhd->bhqk', qblk, k).astype(jnp.float32) * scale
        p = jax.nn.softmax(s, axis=-1).astype(v.dtype)
        return jnp.einsum('bhqk,bkhd->bqhd', p, v)

    o = lax.map(one, qb)
    return o.transpose(1, 0, 2, 3, 4).reshape(Bn, Lq, H, v.shape[-1])


def attn_out(o, w_out):
    Bn, L, H, dv = o.shape
    return o.reshape(Bn, L, H * dv) @ w_out


def peer(h, w_q, sub_keys, u_tab, v_tab):
    Bn, L, D = h.shape
    tok = h.reshape(-1, P_BLOCK, D)

    def one(hb):
        q = (hb @ w_q).reshape(P_BLOCK, P_HEADS, 2, P_DKEY // 2)
        s = jnp.einsum('thpk,hpnk->thpn', q, sub_keys).astype(jnp.float32)
        s1, i1 = lax.top_k(s[:, :, 0], P_TOPK)
        s2, i2 = lax.top_k(s[:, :, 1], P_TOPK)
        cand = (s1[..., :, None] + s2[..., None, :]).reshape(P_BLOCK, P_HEADS, P_TOPK * P_TOPK)
        sc, pos = lax.top_k(cand, P_TOPK)
        idx = (jnp.take_along_axis(i1, pos // P_TOPK, axis=-1) * P_NKEYS
               + jnp.take_along_axis(i2, pos % P_TOPK, axis=-1))
        gate = jax.nn.softmax(sc, axis=-1).astype(hb.dtype)
        act = jax.nn.gelu(jnp.einsum('td,thkd->thk', hb, u_tab[idx]), approximate=False)
        return jnp.einsum('thk,thkd->td', gate * act, v_tab[idx])

    return lax.map(one, tok).reshape(Bn, L, D)


def setup_inputs(seed: int = 0) -> dict:
    key = jax.random.key(seed)
    ks = iter(jax.random.split(key, 40))
    D = D_MODEL
    nrm = lambda shape, s: jax.random.normal(next(ks), shape, jnp.float32) * s
    gain = lambda shape: 1.0 + 0.02 * jax.random.normal(next(ks), shape, jnp.float32)
    x = nrm((BATCH, SEQ, D), 1.0)
    c = nrm((BATCH, D), 1.0)
    ctx = nrm((BATCH, CTX_LEN, D), 1.0)
    c_ctx = nrm((D,), 1.0)
    w_mod = nrm((DEPTH, D, 6 * D), 0.5 * D ** -0.5)
    b_mod = nrm((DEPTH, 6 * D), 0.02)
    norm1 = gain((DEPTH, D))
    norm2 = gain((DEPTH, D))
    ev_w_in = nrm((N_EVEN, D, IN_EVEN), D ** -0.5)
    ev_a_conv = nrm((N_EVEN, A_CONV, A_WIDTH), A_CONV ** -0.5)
    ev_qkv_conv = nrm((N_EVEN, B_CONV, 2 * B_QK + B_VW), B_CONV ** -0.5)
    ev_a_log = jnp.log(jax.random.uniform(next(ks), (N_EVEN, 2, B_HEADS), jnp.float32, 1.0, 16.0))
    dt = jnp.exp(jax.random.uniform(next(ks), (N_EVEN, 2, B_HEADS), jnp.float32, math.log(1e-3), math.log(1e-1)))
    ev_dt_bias = dt + jnp.log(-jnp.expm1(-dt))
    ev_o_norm = gain((N_EVEN, B_DV))
    ev_w_out = nrm((N_EVEN, MIX_EVEN, D), MIX_EVEN ** -0.5)
    od_w_in = nrm((N_ODD, D, IN_ODD), D ** -0.5)
    od_q_norm = gain((N_ODD, C_Q_LORA))
    od_kv_norm = gain((N_ODD, C_KV_LORA))
    od_w_uq = nrm((N_ODD, C_Q_LORA, C_HEADS * (C_NOPE + C_ROPE)), C_Q_LORA ** -0.5)
    od_w_ukv = nrm((N_ODD, C_KV_LORA, C_HEADS * (C_NOPE + C_VDIM)), C_KV_LORA ** -0.5)
    od_w_out = nrm((N_ODD, MIX_ODD, D), MIX_ODD ** -0.5)
    p_w_q = nrm((DEPTH, D, P_HEADS * P_DKEY), D ** -0.5)
    p_keys = nrm((DEPTH, P_HEADS, 2, P_NKEYS, P_DKEY // 2), (P_DKEY // 2) ** -0.5)
    p_u = nrm((DEPTH, P_NEXP, D), D ** -0.5)
    p_v = nrm((DEPTH, P_NEXP, D), 0.5)
    norm_f = gain((D,))
    return {'x': x, 'c': c, 'ctx': ctx, 'c_ctx': c_ctx, 'w_mod': w_mod, 'b_mod': b_mod,
            'norm1': norm1, 'norm2': norm2, 'ev_w_in': ev_w_in, 'ev_a_conv': ev_a_conv,
            'ev_qkv_conv': ev_qkv_conv, 'ev_a_log': ev_a_log, 'ev_dt_bias': ev_dt_bias,
            'ev_o_norm': ev_o_norm, 'ev_w_out': ev_w_out, 'od_w_in': od_w_in, 'od_q_norm': od_q_norm,
            'od_kv_norm': od_kv_norm, 'od_w_uq': od_w_uq, 'od_w_ukv': od_w_ukv, 'od_w_out': od_w_out,
            'p_w_q': p_w_q, 'p_keys': p_keys, 'p_u': p_u, 'p_v': p_v, 'norm_f': norm_f}


def reference(x, c, ctx, c_ctx, w_mod, b_mod, norm1, norm2, ev_w_in, ev_a_conv, ev_qkv_conv, ev_a_log,
              ev_dt_bias, ev_o_norm, ev_w_out, od_w_in, od_q_norm, od_kv_norm, od_w_uq, od_w_ukv, od_w_out,
              p_w_q, p_keys, p_u, p_v, norm_f):
    Bn, S, _ = x.shape
    n_rows = S // GRID_W
    rows = jnp.repeat(jnp.arange(n_rows, dtype=jnp.int32), GRID_W)
    cols = jnp.tile(jnp.arange(GRID_W, dtype=jnp.int32), n_rows)
    for i in range(DEPTH):
        last = i == DEPTH - 1
        j = i // 2
        mod_x = jnp.split(jax.nn.silu(c) @ w_mod[i] + b_mod[i], 6, axis=-1)
        mod_c = jnp.split(jax.nn.silu(c_ctx) @ w_mod[i] + b_mod[i], 6, axis=-1)
        hx = modulate(rms_norm(x, norm1[i]), mod_x[0], mod_x[1])
        hc = modulate(rms_norm(ctx, norm1[i]), mod_c[0], mod_c[1])
        if i % 2 == 0:
            zero = jnp.zeros((Bn, B_HEADS, B_DK, B_DV), jnp.float32)
            yc, s_f, s_b = even_mixer(hc, ev_w_in[j], ev_a_conv[j], ev_qkv_conv[j], ev_a_log[j], ev_dt_bias[j],
                                      ev_o_norm[j], ev_w_out[j], zero, zero)
            yx, _, _ = even_mixer(hx, ev_w_in[j], ev_a_conv[j], ev_qkv_conv[j], ev_a_log[j], ev_dt_bias[j],
                                  ev_o_norm[j], ev_w_out[j], s_f, s_b)
        else:
            qc, kc, vc = mla_project(hc, od_w_in[j], od_q_norm[j], od_kv_norm[j], od_w_uq[j], od_w_ukv[j], None, None)
            qx, kx, vx = mla_project(hx, od_w_in[j], od_q_norm[j], od_kv_norm[j], od_w_uq[j], od_w_ukv[j], rows, cols)
            yx = attn_out(block_attention(qx, jnp.concatenate([kx, kc], axis=1), jnp.concatenate([vx, vc], axis=1)),
                          od_w_out[j])
            yc = None if last else attn_out(block_attention(qc, kc, vc), od_w_out[j])
        x = x + mod_x[2][:, None, :] * yx
        hx2 = modulate(rms_norm(x, norm2[i]), mod_x[3], mod_x[4])
        x = x + mod_x[5][:, None, :] * peer(hx2, p_w_q[i], p_keys[i], p_u[i], p_v[i])
        if not last:
            ctx = ctx + mod_c[2] * yc
            hc2 = modulate(rms_norm(ctx, norm2[i]), mod_c[3], mod_c[4])
            ctx = ctx + mod_c[5] * peer(hc2, p_w_q[i], p_keys[i], p_u[i], p_v[i])
    return rms_norm(x, norm_f)
```

```cpp
#include <hip/hip_runtime.h>
#include <hip/hip_cooperative_groups.h>
#include <stdint.h>
namespace cg = cooperative_groups;

#ifndef MEGA
#define MEGA 0
#endif

typedef unsigned short bf16_t;
using bf16x8 = __attribute__((ext_vector_type(8))) short;
using f32x16 = __attribute__((ext_vector_type(16))) float;
using f32x4 = __attribute__((ext_vector_type(4))) float;
#define DI __device__ __forceinline__
#define NT 512

constexpr int D = 1024;
constexpr int NB = 8;
constexpr int SEQ = 4096;
constexpr int CTXL = 256;
constexpr int TX = NB * SEQ;
constexpr int TC = NB * CTXL;
constexpr int TT = TX + TC;
constexpr int NKEY = SEQ + CTXL;
constexpr int NCH = 68;
constexpr int NITEM = NB * 4 * NCH;
constexpr float EPS = 1e-6f;

constexpr size_t OFF_MOD = 0;
constexpr size_t OFF_ROPE = OFF_MOD + 442368;
constexpr size_t OFF_WAB = OFF_ROPE + 8192;
constexpr size_t OFF_WT_IN0 = OFF_WAB + 65536;
constexpr size_t OFF_WT_OUT0 = OFF_WT_IN0 + 7340032;
constexpr size_t OFF_WT_IN1 = OFF_WT_OUT0 + 2097152;
constexpr size_t OFF_WT_UQ = OFF_WT_IN1 + 1572864;
constexpr size_t OFF_WT_UKV = OFF_WT_UQ + 1179648;
constexpr size_t OFF_WT_OUT1 = OFF_WT_UKV + 1048576;
constexpr size_t OFF_WT_PQ = OFF_WT_OUT1 + 2097152;
constexpr size_t OFF_KEYS = OFF_WT_PQ + 4194304;
constexpr size_t OFF_CTXBUF = OFF_KEYS + 524288;
constexpr size_t OFF_HBUF = OFF_CTXBUF + 8388608;
constexpr size_t OFF_AB = OFF_HBUF + 71303168;
constexpr size_t OFF_SCR = OFF_AB + 2228224;
constexpr size_t OFF_GATE = OFF_SCR;
constexpr size_t OFF_Z = OFF_GATE + 106954752;
constexpr size_t OFF_QN = OFF_Z + 35651584;
constexpr size_t OFF_KT = OFF_QN + 35651584;
constexpr size_t OFF_W = OFF_KT + 35651584;
constexpr size_t OFF_UT = OFF_W + 71303168;
constexpr size_t OFF_INTRA = OFF_UT + 71303168;
constexpr size_t OFF_SC = OFF_INTRA + 35651584;
constexpr size_t END_L0 = OFF_SC + 4456448;
constexpr size_t OFF_SELI = OFF_SCR;
constexpr size_t OFF_SELG = OFF_SELI + 17825792;
constexpr size_t OFF_PROJ1 = OFF_SELG + 17825792;
constexpr size_t OFF_Q = OFF_PROJ1 + 53477376;
constexpr size_t OFF_K = OFF_Q + 100663296;
constexpr size_t OFF_VT = OFF_K + 106954752;
constexpr size_t END_L1 = OFF_VT + 71303168;
constexpr size_t WS_NEED = END_L0 > END_L1 ? END_L0 : END_L1;
constexpr size_t DO_QKV = 0;
constexpr size_t DO_OF = 0;
constexpr size_t DO_OB = 35651584;

struct Params {
  const float *x, *c, *ctx, *c_ctx, *w_mod, *b_mod, *norm1, *norm2, *ev_w_in, *ev_a_conv, *ev_qkv_conv, *ev_a_log,
      *ev_dt_bias, *ev_o_norm, *ev_w_out, *od_w_in, *od_q_norm, *od_kv_norm, *od_w_uq, *od_w_ukv, *od_w_out, *p_w_q,
      *p_keys, *p_u, *p_v, *norm_f;
  float* out;
  char* ws;
};

DI bf16_t f2bf(float x) {
  unsigned u = __float_as_uint(x);
  u += 0x7fffu + ((u >> 16) & 1u);
  return (bf16_t)(u >> 16);
}
DI float bf2f(bf16_t b) { return __uint_as_float(((unsigned)b) << 16); }
DI unsigned pack2(float a, float b) { return (unsigned)f2bf(a) | ((unsigned)f2bf(b) << 16); }
DI float bflo(unsigned u) { return __uint_as_float(u << 16); }
DI float bfhi(unsigned u) { return __uint_as_float(u & 0xffff0000u); }
DI float wave_sum(float v) {
#pragma unroll
  for (int o = 32; o > 0; o >>= 1) v += __shfl_xor(v, o);
  return v;
}
DI float siluf(float x) { return x / (1.f + __expf(-x)); }
DI float softplusf(float x) { return x > 20.f ? x : log1pf(expf(x)); }
DI float sigmoidf(float x) { return 1.f / (1.f + expf(-x)); }
DI int row_mb(int row) { return row < TX ? (row >> 12) : 8; }
#define MFMA32(a, b, c) __builtin_amdgcn_mfma_f32_32x32x16_bf16((a), (b), (c), 0, 0, 0)
#define MFMA16(a, b, c) __builtin_amdgcn_mfma_f32_16x16x32_bf16((a), (b), (c), 0, 0, 0)
DI int crow32(int reg, int h) { return (reg & 3) + 8 * (reg >> 2) + 4 * h; }

constexpr int G_RS = 144;
constexpr int G_STAGE = (256 + 128) * G_RS;
constexpr int G_LDS = 2 * G_STAGE;

template <class Epi>
DI void gemm_tile(const bf16_t* __restrict__ A, int lda, const bf16_t* __restrict__ Bt, int ldb, int K, char* smem, Epi epi) {
  const int t = threadIdx.x, lane = t & 63, wv = t >> 6, wm = wv >> 1, wn = wv & 1, r = lane & 31, h = lane >> 5;
  f32x16 acc[2][2];
#pragma unroll
  for (int i = 0; i < 2; ++i)
#pragma unroll
    for (int j = 0; j < 2; ++j)
#pragma unroll
      for (int e = 0; e < 16; ++e) acc[i][j][e] = 0.f;
  uint4 ra[4], rb[2];
  const int nk = K >> 6;
  auto gload = [&](int kt) {
#pragma unroll
    for (int e = 0; e < 4; ++e) {
      int c = t + e * NT, row = c >> 3, kc = c & 7;
      ra[e] = *(const uint4*)(A + (size_t)row * lda + kt * 64 + kc * 8);
    }
#pragma unroll
    for (int e = 0; e < 2; ++e) {
      int c = t + e * NT, row = c >> 3, kc = c & 7;
      rb[e] = *(const uint4*)(Bt + (size_t)row * ldb + kt * 64 + kc * 8);
    }
  };
  auto lstore = [&](int s) {
    char* As = smem + s * G_STAGE;
    char* Bs = As + 256 * G_RS;
#pragma unroll
    for (int e = 0; e < 4; ++e) {
      int c = t + e * NT, row = c >> 3, kc = c & 7;
      *(uint4*)(As + row * G_RS + kc * 16) = ra[e];
    }
#pragma unroll
    for (int e = 0; e < 2; ++e) {
      int c = t + e * NT, row = c >> 3, kc = c & 7;
      *(uint4*)(Bs + row * G_RS + kc * 16) = rb[e];
    }
  };
  gload(0);
  lstore(0);
  __syncthreads();
  for (int kt = 0; kt < nk; ++kt) {
    if (kt + 1 < nk) gload(kt + 1);
    const char* As = smem + (kt & 1) * G_STAGE;
    const char* Bs = As + 256 * G_RS;
#pragma unroll
    for (int kk = 0; kk < 4; ++kk) {
      bf16x8 a[2], b[2];
#pragma unroll
      for (int i = 0; i < 2; ++i) a[i] = *(const bf16x8*)(As + (wm * 64 + i * 32 + r) * G_RS + (2 * kk + h) * 16);
#pragma unroll
      for (int j = 0; j < 2; ++j) b[j] = *(const bf16x8*)(Bs + (wn * 64 + j * 32 + r) * G_RS + (2 * kk + h) * 16);
#pragma unroll
      for (int i = 0; i < 2; ++i)
#pragma unroll
        for (int j = 0; j < 2; ++j) acc[i][j] = MFMA32(a[i], b[j], acc[i][j]);
    }
    if (kt + 1 < nk) lstore((kt + 1) & 1);
    __syncthreads();
  }
#pragma unroll
  for (int i = 0; i < 2; ++i)
#pragma unroll
    for (int j = 0; j < 2; ++j) epi(wm * 64 + i * 32, wn * 64 + j * 32, acc[i][j]);
}

DI void transpose_job(const float* __restrict__ src, int ldsrc, int n_off, int K, bf16_t* __restrict__ dst, const float* __restrict__ kgain,
                      float scal, int tile, int ntn, float* tl) {
  const int t = threadIdx.x;
  int kt = tile / ntn, nt = tile % ntn;
  int k0 = kt * 64, n0 = nt * 64;
  __syncthreads();
#pragma unroll
  for (int e = 0; e < 2; ++e) {
    int kk = (t >> 4) + e * 32, n4 = (t & 15) * 4;
    float4 v = *(const float4*)(src + (size_t)(k0 + kk) * ldsrc + n_off + n0 + n4);
    float g = scal * (kgain ? kgain[k0 + kk] : 1.f);
    tl[kk * 65 + n4 + 0] = v.x * g;
    tl[kk * 65 + n4 + 1] = v.y * g;
    tl[kk * 65 + n4 + 2] = v.z * g;
    tl[kk * 65 + n4 + 3] = v.w * g;
  }
  __syncthreads();
  {
    int n = t >> 3, k8 = (t & 7) * 8;
    uint4 o;
    o.x = pack2(tl[(k8 + 0) * 65 + n], tl[(k8 + 1) * 65 + n]);
    o.y = pack2(tl[(k8 + 2) * 65 + n], tl[(k8 + 3) * 65 + n]);
    o.z = pack2(tl[(k8 + 4) * 65 + n], tl[(k8 + 5) * 65 + n]);
    o.w = pack2(tl[(k8 + 6) * 65 + n], tl[(k8 + 7) * 65 + n]);
    *(uint4*)(dst + (size_t)(n0 + n) * K + k0 + k8) = o;
  }
}

DI void phase_prep(const Params& p, char* smem) {
  const int t = threadIdx.x, nb = gridDim.x, bid = blockIdx.x;
  char* ws = p.ws;
  {
    float* sl = (float*)smem;
    float* red = sl + 9 * 1024;
    bool have = false;
    for (int job = bid; job < 192; job += nb) {
      if (!have) {
        for (int i = t; i < 9 * 1024; i += NT) {
          float v = i < 8192 ? p.c[i] : p.c_ctx[i - 8192];
          sl[i] = siluf(v);
        }
        have = true;
      }
      __syncthreads();
      int l = job / 96, ch = job % 96, col = t & 63, kg = t >> 6;
      const float* w = p.w_mod + (size_t)l * 1024 * 6144 + ch * 64 + col;
      float acc[9];
#pragma unroll
      for (int r = 0; r < 9; ++r) acc[r] = 0.f;
      for (int k = kg * 128; k < kg * 128 + 128; ++k) {
        float wv = w[(size_t)k * 6144];
#pragma unroll
        for (int r = 0; r < 9; ++r) acc[r] += sl[r * 1024 + k] * wv;
      }
#pragma unroll
      for (int r = 0; r < 9; ++r) red[(kg * 9 + r) * 64 + col] = acc[r];
      __syncthreads();
      for (int i = t; i < 9 * 64; i += NT) {
        int r = i >> 6, cc = i & 63;
        float s = 0.f;
#pragma unroll
        for (int g = 0; g < 8; ++g) s += red[(g * 9 + r) * 64 + cc];
        int n = ch * 64 + cc;
        ((float*)(ws + OFF_MOD))[((size_t)l * 9 + r) * 6144 + n] = s + p.b_mod[l * 6144 + n];
      }
    }
    __syncthreads();
  }
  {
    float* tl = (float*)smem;
    const float qscale = 0.07216878364870322f * 1.4426950408889634f;
    const int n0_ = 16 * 56, n1_ = 256, n2_ = 16 * 11, n3_ = 6 * 24, n4_ = 4 * 32, n5_ = 256, n6_ = 256, n7_ = 256;
    const int total = n0_ + n1_ + n2_ + n3_ + n4_ + n5_ + n6_ + n7_;
    for (int job = bid; job < total; job += nb) {
      int j = job;
      if (j < n0_) { transpose_job(p.ev_w_in, 3600, 0, 1024, (bf16_t*)(ws + OFF_WT_IN0), nullptr, 1.f, j, 56, tl); continue; }
      j -= n0_;
      if (j < n1_) { transpose_job(p.ev_w_out, 1024, 0, 1024, (bf16_t*)(ws + OFF_WT_OUT0), nullptr, 1.f, j, 16, tl); continue; }
      j -= n1_;
      if (j < n2_) { transpose_job(p.od_w_in, 704, 0, 1024, (bf16_t*)(ws + OFF_WT_IN1), nullptr, 1.f, j, 11, tl); continue; }
      j -= n2_;
      if (j < n3_) { transpose_job(p.od_w_uq, 1536, 0, 384, (bf16_t*)(ws + OFF_WT_UQ), p.od_q_norm, qscale, j, 24, tl); continue; }
      j -= n3_;
      if (j < n4_) { transpose_job(p.od_w_ukv, 2048, 0, 256, (bf16_t*)(ws + OFF_WT_UKV), p.od_kv_norm, 1.f, j, 32, tl); continue; }
      j -= n4_;
      if (j < n5_) { transpose_job(p.od_w_out, 1024, 0, 1024, (bf16_t*)(ws + OFF_WT_OUT1), nullptr, 1.f, j, 16, tl); continue; }
      j -= n5_;
      if (j < n6_) { transpose_job(p.p_w_q, 1024, 0, 1024, (bf16_t*)(ws + OFF_WT_PQ), nullptr, 1.f, j, 16, tl); continue; }
      j -= n6_;
      transpose_job(p.p_w_q + 1024 * 1024, 1024, 0, 1024, (bf16_t*)(ws + OFF_WT_PQ) + 1024 * 1024, nullptr, 1.f, j, 16, tl);
    }
  }
  const int gt = bid * NT + t, gs = nb * NT;
  for (int i = gt; i < 2 * 8 * 2 * 128 * 64; i += gs) ((bf16_t*)(ws + OFF_KEYS))[i] = f2bf(p.p_keys[i]);
  for (int i = gt; i < 16 * 1024; i += gs) {
    int n = i >> 10, k = i & 1023;
    ((float*)(ws + OFF_WAB))[i] = p.ev_w_in[(size_t)k * 3600 + 3584 + n];
  }
  for (int i = gt; i < 64 * 1024; i += gs) ((bf16_t*)(ws + OFF_WT_IN1))[704 * 1024 + i] = 0;
  for (int i = gt; i < 64 * 16; i += gs) {
    int pos = i >> 4, f = i & 15;
    float freq = powf(10000.f, -(float)f / 16.f);
    float ang = (float)pos * freq;
    ((float*)(ws + OFF_ROPE))[i] = cosf(ang);
    ((float*)(ws + OFF_ROPE))[1024 + i] = sinf(ang);
  }
}

DI void load_row(const float* __restrict__ row, int lane, float (&v)[16]) {
#pragma unroll
  for (int j = 0; j < 4; ++j) {
    float4 a = *(const float4*)(row + 256 * j + 4 * lane);
    v[4 * j] = a.x; v[4 * j + 1] = a.y; v[4 * j + 2] = a.z; v[4 * j + 3] = a.w;
  }
}
DI void norm_mod(const float (&xv)[16], const float* __restrict__ gain, const float* __restrict__ shift, const float* __restrict__ scale,
                 int lane, float (&hv)[16]) {
  float ss = 0.f;
#pragma unroll
  for (int i = 0; i < 16; ++i) ss += xv[i] * xv[i];
  ss = wave_sum(ss);
  float r = rsqrtf(ss * (1.f / 1024.f) + EPS);
#pragma unroll
  for (int j = 0; j < 4; ++j) {
    float4 g = *(const float4*)(gain + 256 * j + 4 * lane);
    float4 sh = *(const float4*)(shift + 256 * j + 4 * lane);
    float4 sc = *(const float4*)(scale + 256 * j + 4 * lane);
    hv[4 * j + 0] = xv[4 * j + 0] * r * g.x * (1.f + sc.x) + sh.x;
    hv[4 * j + 1] = xv[4 * j + 1] * r * g.y * (1.f + sc.y) + sh.y;
    hv[4 * j + 2] = xv[4 * j + 2] * r * g.z * (1.f + sc.z) + sh.z;
    hv[4 * j + 3] = xv[4 * j + 3] * r * g.w * (1.f + sc.w) + sh.w;
  }
}
DI void store_row_bf16(bf16_t* __restrict__ row, int lane, const float (&v)[16]) {
#pragma unroll
  for (int j = 0; j < 4; ++j) {
    uint2 o;
    o.x = pack2(v[4 * j], v[4 * j + 1]);
    o.y = pack2(v[4 * j + 2], v[4 * j + 3]);
    *(uint2*)(row + 256 * j + 4 * lane) = o;
  }
}

DI void phase_h0(const Params& p, char* smem) {
  const int t = threadIdx.x, lane = t & 63, wv = t >> 6;
  float* wab = (float*)smem;
  for (int i = t; i < 16 * 1024; i += NT) wab[i] = ((const float*)(p.ws + OFF_WAB))[i];
  __syncthreads();
  const float* mod = (const float*)(p.ws + OFF_MOD);
  bf16_t* hbuf = (bf16_t*)(p.ws + OFF_HBUF);
  float* ab = (float*)(p.ws + OFF_AB);
  for (int row = blockIdx.x * 8 + wv; row < TT; row += gridDim.x * 8) {
    const float* xr = row < TX ? p.x + (size_t)row * D : p.ctx + (size_t)(row - TX) * D;
    int mb = row_mb(row);
    float xv[16], hv[16];
    load_row(xr, lane, xv);
    norm_mod(xv, p.norm1, mod + (size_t)mb * 6144, mod + (size_t)mb * 6144 + 1024, lane, hv);
    store_row_bf16(hbuf + (size_t)row * D, lane, hv);
    float myab = 0.f;
#pragma unroll 1
    for (int n = 0; n < 16; ++n) {
      float s = 0.f;
#pragma unroll
      for (int j = 0; j < 4; ++j) {
        float4 w = *(const float4*)(wab + n * 1024 + 256 * j + 4 * lane);
        s += hv[4 * j] * w.x + hv[4 * j + 1] * w.y + hv[4 * j + 2] * w.z + hv[4 * j + 3] * w.w;
      }
      s = wave_sum(s);
      if (lane == n) myab = s;
    }
    if (lane < 16) ab[(size_t)row * 16 + lane] = myab;
  }
}

DI void phase_hnorm(const Params& p, const float* gain, int layer, int shift_idx, int nrows) {
  const int t = threadIdx.x, lane = t & 63, wv = t >> 6;
  const float* mod = (const float*)(p.ws + OFF_MOD) + (size_t)layer * 9 * 6144;
  bf16_t* hbuf = (bf16_t*)(p.ws + OFF_HBUF);
  for (int row = blockIdx.x * 8 + wv; row < nrows; row += gridDim.x * 8) {
    const float* xr = row < TX ? p.out + (size_t)row * D : (const float*)(p.ws + OFF_CTXBUF) + (size_t)(row - TX) * D;
    int mb = row_mb(row);
    float xv[16], hv[16];
    load_row(xr, lane, xv);
    norm_mod(xv, gain, mod + (size_t)mb * 6144 + shift_idx * 1024, mod + (size_t)mb * 6144 + (shift_idx + 1) * 1024, lane, hv);
    store_row_bf16(hbuf + (size_t)row * D, lane, hv);
  }
}

DI void phase_inproj0(const Params& p, char* smem) {
  const bf16_t* A = (const bf16_t*)(p.ws + OFF_HBUF);
  const bf16_t* Bt = (const bf16_t*)(p.ws + OFF_WT_IN0);
  bf16_t* gate = (bf16_t*)(p.ws + OFF_GATE);
  bf16_t* qkv = (bf16_t*)((char*)p.out + DO_QKV);
  bf16_t* z = (bf16_t*)(p.ws + OFF_Z);
  const int lane = threadIdx.x & 63, r = lane & 31, h = lane >> 5;
  const int ntn = 28, ntm = TT / 256;
  for (int tile = blockIdx.x; tile < ntm * ntn; tile += gridDim.x) {
    int tm = tile / ntn, tn = tile % ntn;
    int m0 = tm * 256, n0 = tn * 128;
    bf16_t* dst; int ld, nb;
    if (n0 < 1536) { dst = gate; ld = 1536; nb = n0; }
    else if (n0 < 3072) { dst = qkv; ld = 1536; nb = n0 - 1536; }
    else { dst = z; ld = 512; nb = n0 - 3072; }
    gemm_tile(A + (size_t)m0 * D, D, Bt + (size_t)n0 * D, D, D, smem, [&](int rb, int cb, const f32x16& acc) {
#pragma unroll
      for (int e = 0; e < 16; ++e) {
        int row = m0 + rb + crow32(e, h), col = nb + cb + r;
        dst[(size_t)row * ld + col] = f2bf(acc[e]);
      }
    });
  }
}

template <bool UPPER>
DI void tri_inverse_wave(const float* __restrict__ A, float* __restrict__ T32, int lane) {
  int g = lane >> 4, c = lane & 15;
  asm volatile("" : "+v"(g), "+v"(c));
#define LA_(i, j) (UPPER ? A[(63 - (i)) * 68 + (63 - (j))] : A[(i) * 68 + (j)])
#define TI_(i, j) (UPPER ? ((63 - (i)) * 65 + (63 - (j))) : ((i) * 65 + (j)))
  {
    float tv[16];
#pragma unroll
    for (int i = 0; i < 16; ++i) {
      float acc = (i == c) ? 1.f : 0.f;
#pragma unroll
      for (int j = 0; j < i; ++j) acc -= LA_(16 * g + i, 16 * g + j) * tv[j];
      tv[i] = acc;
    }
#pragma unroll
    for (int i = 0; i < 16; ++i) T32[TI_(16 * g + i, 16 * g + c)] = tv[i];
  }
  asm volatile("" ::: "memory");
  __builtin_amdgcn_sched_barrier(0);
#pragma unroll
  for (int d = 1; d < 4; ++d) {
#pragma unroll
    for (int q = 0; q + d < 4; ++q) {
      const int pb = q + d;
      f32x4 S = {0.f, 0.f, 0.f, 0.f};
#pragma unroll
      for (int k = q; k < pb; ++k) {
#pragma unroll
        for (int ks = 0; ks < 4; ++ks) {
          float av = LA_(16 * pb + c, 16 * k + 4 * ks + g);
          float bv = T32[TI_(16 * k + 4 * ks + g, 16 * q + c)];
          S = __builtin_amdgcn_mfma_f32_16x16x4f32(av, bv, S, 0, 0, 0);
        }
      }
      f32x4 R = {0.f, 0.f, 0.f, 0.f};
#pragma unroll
      for (int ks = 0; ks < 4; ++ks) {
        float av = T32[TI_(16 * pb + c, 16 * pb + 4 * g + ks)];
        R = __builtin_amdgcn_mfma_f32_16x16x4f32(av, S[ks], R, 0, 0, 0);
      }
#pragma unroll
      for (int e = 0; e < 4; ++e) T32[TI_(16 * pb + 4 * g + e, 16 * q + c)] = -R[e];
      asm volatile("" ::: "memory");
      __builtin_amdgcn_sched_barrier(0);
    }
  }
#undef LA_
#undef TI_
}

DI int item_row0(int b, int gc) { return gc < 4 ? TX + b * CTXL + gc * 64 : b * SEQ + (gc - 4) * 64; }

DI void phase_g1(const Params& p, char* smem) {
  const int tid0 = threadIdx.x;
  bf16_t* qn = (bf16_t*)smem;
  bf16_t* kn = qn + 64 * 136;
  bf16_t* vn = kn + 64 * 136;
  char* big = (char*)(vn + 64 * 136);
  float* KKs = (float*)big;
  float* QKs = KKs + 64 * 65;
  float* T32f = KKs;
  float* T32b = QKs;
  float* Af = (float*)(big + 33280);
  float* Ab = Af + 64 * 68;
  bf16_t* kbdT = (bf16_t*)big;
  bf16_t* vbT = kbdT + 128 * 72;
  bf16_t* Tf = (bf16_t*)(big + 68096);
  bf16_t* Tb = Tf + 64 * 72;
  float* sc = (float*)(Tb + 64 * 72);
  float *decf = sc, *decb = sc + 64, *betaf = sc + 128, *betab = sc + 192, *ckf = sc + 256, *ckb = sc + 320;

  const bf16_t* gate = (const bf16_t*)(p.ws + OFF_GATE);
  const bf16_t* qkv = (const bf16_t*)((const char*)p.out + DO_QKV);
  const float* ab = (const float*)(p.ws + OFF_AB);
  bf16_t* y = (bf16_t*)(p.ws + OFF_HBUF);
  const float scale = 0.08838834764831845f;

  for (int item = blockIdx.x; item < NITEM; item += gridDim.x) {
    int t = tid0;
    asm volatile("" : "+v"(t));
    const int lane = t & 63, wv = __builtin_amdgcn_readfirstlane(t >> 6), r = lane & 31, h2 = lane >> 5;
    const int b = item / (4 * NCH), hh = (item / NCH) & 3, gc = item % NCH;
    const int row0 = item_row0(b, gc);
    const int L = gc < 4 ? CTXL : SEQ;
    const int tpos0 = gc < 4 ? gc * 64 : (gc - 4) * 64;
    __syncthreads();
    {
      const int i = t >> 3, part = t & 7;
      const int tp = tpos0 + i;
      const bool hasm = tp > 0, hasp = tp < L - 1;
      const size_t rowc = (size_t)(row0 + i);
#pragma unroll
      for (int ten = 0; ten < 3; ++ten) {
        const int ch0 = ten * 512 + hh * 128 + part * 16;
        float v[16];
        uint4 cm[2], cc[2], cp[2];
        const bf16_t* src = qkv + rowc * 1536 + ch0;
        cc[0] = *(const uint4*)(src); cc[1] = *(const uint4*)(src + 8);
        if (hasm) { cm[0] = *(const uint4*)(src - 1536); cm[1] = *(const uint4*)(src - 1536 + 8); } else { cm[0] = make_uint4(0, 0, 0, 0); cm[1] = cm[0]; }
        if (hasp) { cp[0] = *(const uint4*)(src + 1536); cp[1] = *(const uint4*)(src + 1536 + 8); } else { cp[0] = make_uint4(0, 0, 0, 0); cp[1] = cp[0]; }
        const unsigned* um = (const unsigned*)cm; const unsigned* uc = (const unsigned*)cc; const unsigned* up = (const unsigned*)cp;
        const float* w0 = p.ev_qkv_conv + ch0; const float* w1 = w0 + 1536; const float* w2 = w0 + 3072;
        float ss = 0.f;
#pragma unroll
        for (int e = 0; e < 8; ++e) {
          float a0 = w0[2 * e] * bflo(um[e]) + w1[2 * e] * bflo(uc[e]) + w2[2 * e] * bflo(up[e]);
          float a1 = w0[2 * e + 1] * bfhi(um[e]) + w1[2 * e + 1] * bfhi(uc[e]) + w2[2 * e + 1] * bfhi(up[e]);
          a0 = siluf(a0); a1 = siluf(a1);
          v[2 * e] = a0; v[2 * e + 1] = a1;
          ss += a0 * a0 + a1 * a1;
        }
        float sc_ = 1.f;
        if (ten < 2) {
          ss += __shfl_xor(ss, 1); ss += __shfl_xor(ss, 2); ss += __shfl_xor(ss, 4);
          sc_ = rsqrtf(ss + EPS);
        }
        uint4 o0, o1;
        o0.x = pack2(v[0] * sc_, v[1] * sc_); o0.y = pack2(v[2] * sc_, v[3] * sc_); o0.z = pack2(v[4] * sc_, v[5] * sc_); o0.w = pack2(v[6] * sc_, v[7] * sc_);
        o1.x = pack2(v[8] * sc_, v[9] * sc_); o1.y = pack2(v[10] * sc_, v[11] * sc_); o1.z = pack2(v[12] * sc_, v[13] * sc_); o1.w = pack2(v[14] * sc_, v[15] * sc_);
        bf16_t* dstl = (ten == 0 ? qn : ten == 1 ? kn : vn) + i * 136 + part * 16;
        *(uint4*)dstl = o0; *(uint4*)(dstl + 8) = o1;
      }
      {
        const int ch0 = hh * 128 + part * 16;
        const bf16_t* src = gate + rowc * 1536 + ch0;
        uint4 bg[2], cgm[2], cgc[2], cgp[2], xam[2], xac[2], xap[2];
        bg[0] = *(const uint4*)(src); bg[1] = *(const uint4*)(src + 8);
        cgc[0] = *(const uint4*)(src + 512); cgc[1] = *(const uint4*)(src + 512 + 8);
        xac[0] = *(const uint4*)(src + 1024); xac[1] = *(const uint4*)(src + 1024 + 8);
        const uint4 z4 = make_uint4(0, 0, 0, 0);
        if (hasm) { cgm[0] = *(const uint4*)(src - 1536 + 512); cgm[1] = *(const uint4*)(src - 1536 + 512 + 8); xam[0] = *(const uint4*)(src - 1536 + 1024); xam[1] = *(const uint4*)(src - 1536 + 1024 + 8); }
        else { cgm[0] = cgm[1] = xam[0] = xam[1] = z4; }
        if (hasp) { cgp[0] = *(const uint4*)(src + 1536 + 512); cgp[1] = *(const uint4*)(src + 1536 + 512 + 8); xap[0] = *(const uint4*)(src + 1536 + 1024); xap[1] = *(const uint4*)(src + 1536 + 1024 + 8); }
        else { cgp[0] = cgp[1] = xap[0] = xap[1] = z4; }
        const unsigned *ubg = (const unsigned*)bg, *ucm = (const unsigned*)cgm, *ucc = (const unsigned*)cgc, *ucp = (const unsigned*)cgp, *uxm = (const unsigned*)xam, *uxc = (const unsigned*)xac, *uxp = (const unsigned*)xap;
        const float* w0 = p.ev_a_conv + ch0; const float* w1 = w0 + 512; const float* w2 = w0 + 1024;
        unsigned o[8];
#pragma unroll
        for (int e = 0; e < 8; ++e) {
          float a0 = w0[2 * e] * bflo(ucm[e]) * bflo(uxm[e]) + w1[2 * e] * bflo(ucc[e]) * bflo(uxc[e]) + w2[2 * e] * bflo(ucp[e]) * bflo(uxp[e]);
          float a1 = w0[2 * e + 1] * bfhi(ucm[e]) * bfhi(uxm[e]) + w1[2 * e + 1] * bfhi(ucc[e]) * bfhi(uxc[e]) + w2[2 * e + 1] * bfhi(ucp[e]) * bfhi(uxp[e]);
          o[e] = pack2(bflo(ubg[e]) * a0, bfhi(ubg[e]) * a1);
        }
        bf16_t* yd = y + rowc * 1024 + ch0;
        *(uint4*)yd = make_uint4(o[0], o[1], o[2], o[3]);
        *(uint4*)(yd + 8) = make_uint4(o[4], o[5], o[6], o[7]);
      }
    }
    if (wv == 0) {
      const float* abr = ab + (size_t)(row0 + lane) * 16;
      float af = abr[hh], abk = abr[4 + hh], bfv = abr[8 + hh], bbv = abr[12 + hh];
      float gf = -expf(p.ev_a_log[hh]) * softplusf(af + p.ev_dt_bias[hh]);
      float gb = -expf(p.ev_a_log[4 + hh]) * softplusf(abk + p.ev_dt_bias[4 + hh]);
      float bef = sigmoidf(bfv), beb = sigmoidf(bbv);
      float pf = gf, sb = gb;
#pragma unroll
      for (int o = 1; o < 64; o <<= 1) {
        float u = __shfl_up(pf, o);
        if (lane >= o) pf += u;
        float d = __shfl_down(sb, o);
        if (lane + o < 64) sb += d;
      }
      decf[lane] = pf; decb[lane] = sb; betaf[lane] = bef; betab[lane] = beb;
      ckf[lane] = bef * expf(pf); ckb[lane] = beb * expf(sb);
      float lastf = __shfl(pf, 63), lastb = __shfl(sb, 0);
      float* scg = (float*)(p.ws + OFF_SC) + (size_t)(item * 2) * 256;
      scg[lane] = scale * expf(pf);
      scg[64 + lane] = expf(lastf - pf);
      if (lane == 0) scg[128] = expf(lastf);
      scg[256 + lane] = scale * expf(sb);
      scg[256 + 64 + lane] = expf(lastb - sb);
      if (lane == 0) scg[256 + 128] = expf(lastb);
    }
    __syncthreads();
    {
      const int which = wv >> 2, mt = (wv >> 1) & 1, nt = wv & 1;
      const bf16_t* Asrc = which ? qn : kn;
      f32x16 acc;
#pragma unroll
      for (int e = 0; e < 16; ++e) acc[e] = 0.f;
#pragma unroll
      for (int kk = 0; kk < 8; ++kk) {
        bf16x8 a = *(const bf16x8*)(Asrc + (mt * 32 + r) * 136 + (2 * kk + h2) * 8);
        bf16x8 bb = *(const bf16x8*)(kn + (nt * 32 + r) * 136 + (2 * kk + h2) * 8);
        acc = MFMA32(a, bb, acc);
      }
      float* dstm = which ? QKs : KKs;
#pragma unroll
      for (int e = 0; e < 16; ++e) dstm[(mt * 32 + crow32(e, h2)) * 65 + nt * 32 + r] = acc[e];
    }
    __syncthreads();
    {
      bf16_t* qg = (bf16_t*)(p.ws + OFF_QN) + (size_t)item * 8192;
#pragma unroll
      for (int e = 0; e < 2; ++e) {
        int c = t + e * NT, row = c >> 4, cc = c & 15;
        *(uint4*)(qg + row * 128 + cc * 8) = *(const uint4*)(qn + row * 136 + cc * 8);
      }
      bf16_t* kg = (bf16_t*)(p.ws + OFF_KT) + (size_t)item * 8192;
      const int d = t >> 2, jg = t & 3;
      unsigned o[8];
#pragma unroll
      for (int e = 0; e < 8; ++e) {
        unsigned lo = kn[(jg * 16 + 2 * e) * 136 + d], hi = kn[(jg * 16 + 2 * e + 1) * 136 + d];
        o[e] = lo | (hi << 16);
      }
      *(uint4*)(kg + d * 64 + jg * 16) = make_uint4(o[0], o[1], o[2], o[3]);
      *(uint4*)(kg + d * 64 + jg * 16 + 8) = make_uint4(o[4], o[5], o[6], o[7]);
    }
    {
      bf16_t* inf_ = (bf16_t*)(p.ws + OFF_INTRA) + (size_t)(item * 2) * 4096;
      bf16_t* inb_ = inf_ + 4096;
#pragma unroll
      for (int e = 0; e < 8; ++e) {
        int idx = t + e * NT, i = idx >> 6, j = idx & 63;
        float kk = KKs[i * 65 + j], qk = QKs[i * 65 + j];
        float ef = expf(fminf(decf[i] - decf[j], 0.f)), eb = expf(fminf(decb[i] - decb[j], 0.f));
        Af[i * 68 + j] = (i > j) ? betaf[i] * kk * ef : 0.f;
        Ab[i * 68 + j] = (i < j) ? betab[i] * kk * eb : 0.f;
        inf_[idx] = f2bf((i >= j) ? scale * qk * ef : 0.f);
        inb_[idx] = f2bf((i <= j) ? scale * qk * eb : 0.f);
      }
    }
    __syncthreads();
    if (wv == 0) tri_inverse_wave<false>(Af, T32f, lane);
    else if (wv == 1) tri_inverse_wave<true>(Ab, T32b, lane);
    __syncthreads();
#pragma unroll
    for (int e = 0; e < 8; ++e) {
      int idx = t + e * NT, i = idx >> 6, j = idx & 63;
      Tf[i * 72 + j] = f2bf(((i >> 4) >= (j >> 4)) ? T32f[i * 65 + j] : 0.f);
      Tb[i * 72 + j] = f2bf(((i >> 4) <= (j >> 4)) ? T32b[i * 65 + j] : 0.f);
    }
    __syncthreads();
#pragma unroll 1
    for (int dir = 0; dir < 2; ++dir) {
      const float* ck = dir ? ckb : ckf;
      const float* be = dir ? betab : betaf;
      {
        const int d = t >> 2, jg = t & 3;
        unsigned ok[8], ov[8];
#pragma unroll
        for (int e = 0; e < 8; ++e) {
          int j0 = jg * 16 + 2 * e, j1 = j0 + 1;
          ok[e] = pack2(bf2f(kn[j0 * 136 + d]) * ck[j0], bf2f(kn[j1 * 136 + d]) * ck[j1]);
          ov[e] = pack2(bf2f(vn[j0 * 136 + d]) * be[j0], bf2f(vn[j1 * 136 + d]) * be[j1]);
        }
        *(uint4*)(kbdT + d * 72 + jg * 16) = make_uint4(ok[0], ok[1], ok[2], ok[3]);
        *(uint4*)(kbdT + d * 72 + jg * 16 + 8) = make_uint4(ok[4], ok[5], ok[6], ok[7]);
        *(uint4*)(vbT + d * 72 + jg * 16) = make_uint4(ov[0], ov[1], ov[2], ov[3]);
        *(uint4*)(vbT + d * 72 + jg * 16 + 8) = make_uint4(ov[4], ov[5], ov[6], ov[7]);
      }
      __syncthreads();
      {
        const bf16_t* T = dir ? Tb : Tf;
        const int mt = wv >> 2, nt = wv & 3;
        f32x16 aw, au;
#pragma unroll
        for (int e = 0; e < 16; ++e) { aw[e] = 0.f; au[e] = 0.f; }
#pragma unroll
        for (int kk = 0; kk < 4; ++kk) {
          bf16x8 a = *(const bf16x8*)(T + (mt * 32 + r) * 72 + (2 * kk + h2) * 8);
          bf16x8 bk = *(const bf16x8*)(kbdT + (nt * 32 + r) * 72 + (2 * kk + h2) * 8);
          bf16x8 bv = *(const bf16x8*)(vbT + (nt * 32 + r) * 72 + (2 * kk + h2) * 8);
          aw = MFMA32(a, bk, aw);
          au = MFMA32(a, bv, au);
        }
        bf16_t* wg = (bf16_t*)(p.ws + OFF_W) + (size_t)(item * 2 + dir) * 8192;
        bf16_t* ug = (bf16_t*)(p.ws + OFF_UT) + (size_t)(item * 2 + dir) * 8192;
#pragma unroll
        for (int e = 0; e < 16; ++e) wg[(mt * 32 + crow32(e, h2)) * 128 + nt * 32 + r] = f2bf(aw[e]);
#pragma unroll
        for (int g = 0; g < 4; ++g) {
          uint2 o;
          o.x = pack2(au[4 * g], au[4 * g + 1]);
          o.y = pack2(au[4 * g + 2], au[4 * g + 3]);
          *(uint2*)(ug + (nt * 32 + r) * 64 + mt * 32 + 8 * g + 4 * h2) = o;
        }
      }
      __syncthreads();
    }
  }
}

DI void phase_g2(const Params& p, char* smem) {
  const int t = threadIdx.x, lane = t & 63, wv = t >> 6, l15 = lane & 15, lg = lane >> 4;
  bf16_t* wS = (bf16_t*)smem;
  bf16_t* qS = wS + 64 * 136;
  bf16_t* kTS = qS + 64 * 136;
  bf16_t* inS = kTS + 128 * 72;
  bf16_t* Sbf = inS + 64 * 72;
  bf16_t* vnT = Sbf + 2 * 32 * 136;
  bf16_t* veT = vnT + 32 * 72;
  const int mt = wv >> 1, nt = wv & 1;

  for (int chain = blockIdx.x; chain < 256; chain += gridDim.x) {
    const int b = chain >> 5, hh = (chain >> 3) & 3, dir = (chain >> 2) & 1, dvq = chain & 3;
    bf16_t* og = (bf16_t*)((char*)p.out + (dir ? DO_OB : DO_OF));
    __syncthreads();
    f32x4 Sacc[2];
#pragma unroll
    for (int n = 0; n < 2; ++n)
#pragma unroll
      for (int e = 0; e < 4; ++e) Sacc[n][e] = 0.f;
    for (int i = t; i < 32 * 136; i += NT) Sbf[i] = 0;
    int cur = 0;
    auto gc_of = [&](int n) { return dir == 0 ? n : (n < 4 ? 3 - n : 71 - n); };
    auto item_of = [&](int n) { return (b * 4 + hh) * NCH + gc_of(n); };
    uint4 rw0, rw1, rq0, rq1, rk0, rk1, ri;
    uint2 ru; float4 rs4, re4; float rlast;
#define G2_LOAD_W(n_) { \
      const bf16_t* wg_ = (const bf16_t*)(p.ws + OFF_W) + (size_t)(item_of(n_) * 2 + dir) * 8192; \
      rw0 = *(const uint4*)(wg_ + (size_t)t * 8); rw1 = *(const uint4*)(wg_ + (size_t)(t + NT) * 8); }
#define G2_STORE_W() { \
      *(uint4*)(wS + (t >> 4) * 136 + (t & 15) * 8) = rw0; \
      *(uint4*)(wS + ((t + NT) >> 4) * 136 + (t & 15) * 8) = rw1; }
#define G2_LOAD_REST(n_) { \
      const int it_ = item_of(n_); \
      const bf16_t* qg_ = (const bf16_t*)(p.ws + OFF_QN) + (size_t)it_ * 8192; \
      const bf16_t* kg_ = (const bf16_t*)(p.ws + OFF_KT) + (size_t)it_ * 8192; \
      const bf16_t* ig_ = (const bf16_t*)(p.ws + OFF_INTRA) + (size_t)(it_ * 2 + dir) * 4096; \
      const bf16_t* ug_ = (const bf16_t*)(p.ws + OFF_UT) + (size_t)(it_ * 2 + dir) * 8192; \
      const float* scg_ = (const float*)(p.ws + OFF_SC) + (size_t)(it_ * 2 + dir) * 256; \
      rq0 = *(const uint4*)(qg_ + (size_t)t * 8); rq1 = *(const uint4*)(qg_ + (size_t)(t + NT) * 8); \
      rk0 = *(const uint4*)(kg_ + (size_t)t * 8); rk1 = *(const uint4*)(kg_ + (size_t)(t + NT) * 8); \
      ri = *(const uint4*)(ig_ + (size_t)t * 8); \
      ru = *(const uint2*)(ug_ + (dvq * 32 + nt * 16 + l15) * 64 + mt * 16 + 4 * lg); \
      rs4 = *(const float4*)(scg_ + mt * 16 + 4 * lg); \
      re4 = *(const float4*)(scg_ + 64 + mt * 16 + 4 * lg); \
      rlast = scg_[128]; }
#define G2_STORE_REST() { \
      *(uint4*)(qS + (t >> 4) * 136 + (t & 15) * 8) = rq0; \
      *(uint4*)(qS + ((t + NT) >> 4) * 136 + (t & 15) * 8) = rq1; \
      *(uint4*)(kTS + (t >> 3) * 72 + (t & 7) * 8) = rk0; \
      *(uint4*)(kTS + ((t + NT) >> 3) * 72 + (t & 7) * 8) = rk1; \
      *(uint4*)(inS + (t >> 3) * 72 + (t & 7) * 8) = ri; }
    G2_LOAD_W(0); G2_STORE_W();
    G2_LOAD_REST(0);
    __syncthreads();
#pragma unroll 1
    for (int n = 0; n < NCH; ++n) {
      uint2 u_cur = ru; float4 s_cur = rs4, e_cur = re4; float last_cur = rlast;
      G2_STORE_REST();
      if (n + 1 < NCH) G2_LOAD_W(n + 1);
      {
        f32x4 R = {0.f, 0.f, 0.f, 0.f};
        const bf16_t* Sb = Sbf + cur * 32 * 136;
#pragma unroll
        for (int kk = 0; kk < 4; ++kk) {
          bf16x8 a = *(const bf16x8*)(wS + (mt * 16 + l15) * 136 + (4 * kk + lg) * 8);
          bf16x8 bb = *(const bf16x8*)(Sb + (nt * 16 + l15) * 136 + (4 * kk + lg) * 8);
          R = MFMA16(a, bb, R);
        }
        float v0 = bflo(u_cur.x) - R[0], v1 = bfhi(u_cur.x) - R[1], v2 = bflo(u_cur.y) - R[2], v3 = bfhi(u_cur.y) - R[3];
        uint2 o, oe;
        o.x = pack2(v0, v1); o.y = pack2(v2, v3);
        oe.x = pack2(v0 * e_cur.x, v1 * e_cur.y); oe.y = pack2(v2 * e_cur.z, v3 * e_cur.w);
        *(uint2*)(vnT + (nt * 16 + l15) * 72 + mt * 16 + 4 * lg) = o;
        *(uint2*)(veT + (nt * 16 + l15) * 72 + mt * 16 + 4 * lg) = oe;
      }
      __syncthreads();
      if (n + 1 < NCH) G2_LOAD_REST(n + 1);
      {
        const bf16_t* Sb = Sbf + cur * 32 * 136;
        f32x4 O = {0.f, 0.f, 0.f, 0.f};
#pragma unroll
        for (int kk = 0; kk < 4; ++kk) {
          bf16x8 a = *(const bf16x8*)(qS + (mt * 16 + l15) * 136 + (4 * kk + lg) * 8);
          bf16x8 bb = *(const bf16x8*)(Sb + (nt * 16 + l15) * 136 + (4 * kk + lg) * 8);
          O = MFMA16(a, bb, O);
        }
        O[0] *= s_cur.x; O[1] *= s_cur.y; O[2] *= s_cur.z; O[3] *= s_cur.w;
#pragma unroll
        for (int kk = 0; kk < 2; ++kk) {
          bf16x8 a = *(const bf16x8*)(inS + (mt * 16 + l15) * 72 + (4 * kk + lg) * 8);
          bf16x8 bb = *(const bf16x8*)(vnT + (nt * 16 + l15) * 72 + (4 * kk + lg) * 8);
          O = MFMA16(a, bb, O);
        }
        const int row0 = item_row0(b, gc_of(n));
#pragma unroll
        for (int e = 0; e < 4; ++e)
          og[(size_t)(row0 + mt * 16 + 4 * lg + e) * 512 + hh * 128 + dvq * 32 + nt * 16 + l15] = f2bf(O[e]);
        bf16_t* Sn = Sbf + (cur ^ 1) * 32 * 136;
#pragma unroll
        for (int n2 = 0; n2 < 2; ++n2) {
          f32x4 sa = Sacc[n2];
          sa[0] *= last_cur; sa[1] *= last_cur; sa[2] *= last_cur; sa[3] *= last_cur;
#pragma unroll
          for (int kk = 0; kk < 2; ++kk) {
            bf16x8 a = *(const bf16x8*)(kTS + (wv * 16 + l15) * 72 + (4 * kk + lg) * 8);
            bf16x8 bb = *(const bf16x8*)(veT + (n2 * 16 + l15) * 72 + (4 * kk + lg) * 8);
            sa = MFMA16(a, bb, sa);
          }
          Sacc[n2] = sa;
          uint2 o;
          o.x = pack2(sa[0], sa[1]); o.y = pack2(sa[2], sa[3]);
          *(uint2*)(Sn + (n2 * 16 + l15) * 136 + wv * 16 + 4 * lg) = o;
        }
      }
      if (n + 1 < NCH) G2_STORE_W();
      __syncthreads();
      cur ^= 1;
    }
  }
}

DI void phase_yb(const Params& p) {
  const int t = threadIdx.x, lane = t & 63, wv = t >> 6;
  const bf16_t* of = (const bf16_t*)((const char*)p.out + DO_OF);
  const bf16_t* ob = (const bf16_t*)((const char*)p.out + DO_OB);
  const bf16_t* z = (const bf16_t*)(p.ws + OFF_Z);
  bf16_t* y = (bf16_t*)(p.ws + OFF_HBUF);
  for (int row = blockIdx.x * 8 + wv; row < TT; row += gridDim.x * 8) {
    uint4 a = *(const uint4*)(of + (size_t)row * 512 + lane * 8);
    uint4 b = *(const uint4*)(ob + (size_t)row * 512 + lane * 8);
    uint4 zz = *(const uint4*)(z + (size_t)row * 512 + lane * 8);
    const unsigned *ua = (const unsigned*)&a, *ub = (const unsigned*)&b, *uz = (const unsigned*)&zz;
    float o[8], ss = 0.f;
#pragma unroll
    for (int e = 0; e < 4; ++e) {
      o[2 * e] = bflo(ua[e]) + bflo(ub[e]);
      o[2 * e + 1] = bfhi(ua[e]) + bfhi(ub[e]);
      ss += o[2 * e] * o[2 * e] + o[2 * e + 1] * o[2 * e + 1];
    }
    ss += __shfl_xor(ss, 1); ss += __shfl_xor(ss, 2); ss += __shfl_xor(ss, 4); ss += __shfl_xor(ss, 8);
    float rr = rsqrtf(ss * (1.f / 128.f) + EPS);
    const float* gn = p.ev_o_norm + (lane & 15) * 8;
    unsigned oo[4];
#pragma unroll
    for (int e = 0; e < 4; ++e) {
      float z0 = bflo(uz[e]), z1 = bfhi(uz[e]);
      oo[e] = pack2(o[2 * e] * rr * gn[2 * e] * siluf(z0), o[2 * e + 1] * rr * gn[2 * e + 1] * siluf(z1));
    }
    *(uint4*)(y + (size_t)row * 1024 + 512 + lane * 8) = make_uint4(oo[0], oo[1], oo[2], oo[3]);
  }
}

DI void phase_outproj(const Params& p, char* smem, int layer) {
  const bf16_t* A = (const bf16_t*)(p.ws + OFF_HBUF);
  const bf16_t* Bt = (const bf16_t*)(p.ws + (layer ? OFF_WT_OUT1 : OFF_WT_OUT0));
  const float* mod = (const float*)(p.ws + OFF_MOD) + (size_t)layer * 9 * 6144;
  float* ctxbuf = (float*)(p.ws + OFF_CTXBUF);
  const int lane = threadIdx.x & 63, r = lane & 31, h = lane >> 5;
  const int ntm = (layer ? TX : TT) / 256, ntn = 8;
  for (int tile = blockIdx.x; tile < ntm * ntn; tile += gridDim.x) {
    int tm = tile / ntn, tn = tile % ntn;
    int m0 = tm * 256, n0 = tn * 128;
    int mb = row_mb(m0);
    const float* g = mod + (size_t)mb * 6144 + 2 * 1024;
    gemm_tile(A + (size_t)m0 * D, D, Bt + (size_t)n0 * D, D, D, smem, [&](int rb, int cb, const f32x16& acc) {
      int col = n0 + cb + r;
      float gg = g[col];
#pragma unroll
      for (int e = 0; e < 16; ++e) {
        int row = m0 + rb + crow32(e, h);
        if (row < TX) {
          float res = layer ? p.out[(size_t)row * D + col] : p.x[(size_t)row * D + col];
          p.out[(size_t)row * D + col] = res + gg * acc[e];
        } else {
          ctxbuf[(size_t)(row - TX) * D + col] = p.ctx[(size_t)(row - TX) * D + col] + gg * acc[e];
        }
      }
    });
  }
}

DI unsigned f2ord(float f) { unsigned u = __float_as_uint(f); return (u & 0x80000000u) ? ~u : (u | 0x80000000u); }
DI float ord2f(unsigned u) { return __uint_as_float((u & 0x80000000u) ? (u & 0x7fffffffu) : ~u); }
#define CE_DESC(a, b) { unsigned mx_ = max(a, b), mn_ = min(a, b); a = mx_; b = mn_; }

DI void bitonic_merge16(unsigned (&v)[16]) {
#pragma unroll
  for (int j = 8; j > 0; j >>= 1)
#pragma unroll
    for (int i = 0; i < 16; ++i)
      if ((i & j) == 0) CE_DESC(v[i], v[i | j]);
}
DI void sort16_desc(unsigned (&v)[16]) {
#pragma unroll
  for (int k = 2; k <= 16; k <<= 1)
#pragma unroll
    for (int j = k >> 1; j > 0; j >>= 1)
#pragma unroll
      for (int i = 0; i < 16; ++i) {
        int l = i ^ j;
        if (l > i) {
          if ((i & k) == 0) { CE_DESC(v[i], v[l]); } else { CE_DESC(v[l], v[i]); }
        }
      }
}
DI void merge_top16(unsigned (&a)[16], const unsigned (&b)[16]) {
#pragma unroll
  for (int i = 0; i < 16; ++i) a[i] = max(a[i], b[15 - i]);
  bitonic_merge16(a);
}
DI void top16_of_64(unsigned (&g0)[16], unsigned (&g1)[16], unsigned (&g2)[16], unsigned (&g3)[16]) {
  sort16_desc(g0); sort16_desc(g1); sort16_desc(g2); sort16_desc(g3);
  merge_top16(g0, g1);
  merge_top16(g2, g3);
  merge_top16(g0, g2);
}


__constant__ unsigned char CAND_AB[64] = {
    0x00, 0x01, 0x02, 0x03, 0x04, 0x05, 0x06, 0x07, 0x08, 0x09, 0x0A, 0x0B, 0x0C, 0x0D, 0x0E, 0x0F,
    0x10, 0x11, 0x12, 0x13, 0x14, 0x15, 0x16, 0x17,
    0x20, 0x21, 0x22, 0x23, 0x24,
    0x30, 0x31, 0x32, 0x33,
    0x40, 0x41, 0x42,
    0x50, 0x51, 0x60, 0x61, 0x70, 0x71,
    0x80, 0x90, 0xA0, 0xB0, 0xC0, 0xD0, 0xE0, 0xF0,
    0, 0, 0, 0, 0, 0, 0, 0, 0, 0, 0, 0, 0, 0};
constexpr int cand_index(int a, int b) {
  int c = 0;
  for (int aa = 0; aa < 16; ++aa)
    for (int bb = 0; bb < 16; ++bb) {
      if (aa == a && bb == b) return c;
      if ((aa + 1) * (bb + 1) <= 16) ++c;
    }
  return c;
}

DI void phase_peerq(const Params& p, char* smem, int layer) {
  const int t = threadIdx.x, lane = t & 63, wv = t >> 6, r = lane & 31, h = lane >> 5;
  const bf16_t* A = (const bf16_t*)(p.ws + OFF_HBUF);
  const bf16_t* Bt = (const bf16_t*)(p.ws + OFF_WT_PQ) + (size_t)layer * 1024 * 1024;
  const bf16_t* keys = (const bf16_t*)(p.ws + OFF_KEYS) + (size_t)layer * 8 * 2 * 128 * 64;
  int* seli = (int*)(p.ws + OFF_SELI);
  float* selg = (float*)(p.ws + OFF_SELG);
  bf16_t* qs = (bf16_t*)smem;
  unsigned char* isc = (unsigned char*)(smem + 69632);
  const int ntm = (layer ? TX : TT) / 256;
  for (int tile = blockIdx.x; tile < ntm * 8; tile += gridDim.x) {
    const int tm = tile >> 3, hd = tile & 7;
    const int m0 = tm * 256, n0 = hd * 128;
    __syncthreads();
    gemm_tile(A + (size_t)m0 * D, D, Bt + (size_t)n0 * D, D, D, smem, [&](int rb, int cb, const f32x16& acc) {
#pragma unroll
      for (int e = 0; e < 16; ++e) qs[(rb + crow32(e, h)) * 136 + cb + r] = f2bf(acc[e]);
    });
    __syncthreads();
    unsigned top0[16], top1[16];
#pragma unroll
    for (int half = 0; half < 2; ++half) {
      f32x16 acc[4];
#pragma unroll
      for (int m = 0; m < 4; ++m)
#pragma unroll
        for (int e = 0; e < 16; ++e) acc[m][e] = 0.f;
      const bf16_t* kb = keys + (size_t)((hd * 2 + half) * 128) * 64;
#pragma unroll
      for (int kk = 0; kk < 4; ++kk) {
        bf16x8 bq = *(const bf16x8*)(qs + (wv * 32 + r) * 136 + half * 64 + 16 * kk + 8 * h);
#pragma unroll
        for (int m = 0; m < 4; ++m) {
          bf16x8 ak = *(const bf16x8*)(kb + (m * 32 + r) * 64 + 16 * kk + 8 * h);
          acc[m] = MFMA32(ak, bq, acc[m]);
        }
      }
      unsigned g0[16], g1[16], g2[16], g3[16];
#pragma unroll
      for (int e = 0; e < 16; ++e) {
        g0[e] = (f2ord(acc[0][e]) & ~127u) | (unsigned)(0 + crow32(e, h));
        g1[e] = (f2ord(acc[1][e]) & ~127u) | (unsigned)(32 + crow32(e, h));
        g2[e] = (f2ord(acc[2][e]) & ~127u) | (unsigned)(64 + crow32(e, h));
        g3[e] = (f2ord(acc[3][e]) & ~127u) | (unsigned)(96 + crow32(e, h));
      }
      top16_of_64(g0, g1, g2, g3);
      unsigned pp[16];
#pragma unroll
      for (int i = 0; i < 16; ++i) pp[i] = __shfl_xor(g0[i], 32);
      merge_top16(g0, pp);
      if (half == 0) {
#pragma unroll
        for (int i = 0; i < 16; ++i) top0[i] = g0[i];
      } else {
#pragma unroll
        for (int i = 0; i < 16; ++i) top1[i] = g0[i];
      }
    }
#pragma unroll
    for (int i = 0; i < 16; ++i) {
      isc[t * 32 + i] = (unsigned char)(top0[i] & 127u);
      isc[t * 32 + 16 + i] = (unsigned char)(top1[i] & 127u);
    }
    float v1[16], v2[16];
#pragma unroll
    for (int i = 0; i < 16; ++i) { v1[i] = ord2f(top0[i] & ~127u); v2[i] = ord2f(top1[i] & ~127u); }
    unsigned c0[16], c1[16], c2[16], c3[16];
#pragma unroll
    for (int i = 0; i < 16; ++i) { c0[i] = 0u; c1[i] = 0u; c2[i] = 0u; c3[i] = 0u; }
#pragma unroll
    for (int a = 0; a < 16; ++a)
#pragma unroll
      for (int b = 0; b < 16; ++b)
        if ((a + 1) * (b + 1) <= 16) {
          const int ci = cand_index(a, b);
          const unsigned val = (f2ord(v1[a] + v2[b]) & ~63u) | (unsigned)ci;
          if (ci < 16) c0[ci & 15] = val; else if (ci < 32) c1[ci & 15] = val; else if (ci < 48) c2[ci & 15] = val; else c3[ci & 15] = val;
        }
    top16_of_64(c0, c1, c2, c3);
    float sc[16], mx = ord2f(c0[0] & ~63u), sum = 0.f;
#pragma unroll
    for (int i = 0; i < 16; ++i) { sc[i] = __expf(ord2f(c0[i] & ~63u) - mx); sum += sc[i]; }
    float inv = 1.f / sum;
    const int row = m0 + wv * 32 + r;
    int* di = seli + ((size_t)row * 8 + hd) * 16 + 8 * h;
    float* dg = selg + ((size_t)row * 8 + hd) * 16 + 8 * h;
    const unsigned hm = (unsigned)(-h);
#pragma unroll
    for (int i = 0; i < 8; ++i) {
      const unsigned lo = c0[i], hi = c0[8 + i];
      const unsigned s_ = lo ^ ((lo ^ hi) & hm);
      const unsigned gl = __float_as_uint(sc[i]), gh = __float_as_uint(sc[8 + i]);
      const float g_ = __uint_as_float(gl ^ ((gl ^ gh) & hm)) * inv;
      unsigned ab = CAND_AB[s_ & 63u];
      int i1 = isc[t * 32 + (ab >> 4)], i2 = isc[t * 32 + 16 + (ab & 15)];
      di[i] = i1 * 128 + i2;
      dg[i] = g_;
    }
  }
}

DI float gelu_exact(float x) { return 0.5f * x * (1.f + erff(x * 0.7071067811865476f)); }

DI void phase_gather(const Params& p, int layer) {
  const int t = threadIdx.x, lane = t & 63, wv = t >> 6;
  const float* mod = (const float*)(p.ws + OFF_MOD) + (size_t)layer * 9 * 6144;
  const float* mod1 = (const float*)(p.ws + OFF_MOD) + (size_t)9 * 6144;
  const float* ut = p.p_u + (size_t)layer * 16384 * 1024;
  const float* vt = p.p_v + (size_t)layer * 16384 * 1024;
  const int* seli = (const int*)(p.ws + OFF_SELI);
  const float* selg = (const float*)(p.ws + OFF_SELG);
  bf16_t* hbuf = (bf16_t*)(p.ws + OFF_HBUF);
  const int nrows = layer ? TX : TT;
  for (int row_ = blockIdx.x * 8 + wv; row_ < nrows; row_ += gridDim.x * 8) {
    const int row = __builtin_amdgcn_readfirstlane(row_);
    float* xr = row < TX ? p.out + (size_t)row * D : (float*)(p.ws + OFF_CTXBUF) + (size_t)(row - TX) * D;
    const int mb = row_mb(row);
    float xv[16], hv[16], acc[16];
    load_row(xr, lane, xv);
    norm_mod(xv, p.norm2 + layer * 1024, mod + (size_t)mb * 6144 + 3 * 1024, mod + (size_t)mb * 6144 + 4 * 1024, lane, hv);
#pragma unroll
    for (int i = 0; i < 16; ++i) acc[i] = 0.f;
    const int* si = seli + (size_t)row * 128;
    const float* sg = selg + (size_t)row * 128;
#pragma unroll 1
    for (int g = 0; g < 32; ++g) {
      int e[4]; float gt[4];
#pragma unroll
      for (int q = 0; q < 4; ++q) { e[q] = si[g * 4 + q]; gt[q] = sg[g * 4 + q]; }
      float4 uu[4][4], vv[4][4];
#pragma unroll
      for (int q = 0; q < 4; ++q)
#pragma unroll
        for (int j = 0; j < 4; ++j) uu[q][j] = *(const float4*)(ut + (size_t)e[q] * 1024 + 256 * j + 4 * lane);
#pragma unroll
      for (int q = 0; q < 4; ++q)
#pragma unroll
        for (int j = 0; j < 4; ++j) vv[q][j] = *(const float4*)(vt + (size_t)e[q] * 1024 + 256 * j + 4 * lane);
      float d[4];
#pragma unroll
      for (int q = 0; q < 4; ++q) {
        float s = 0.f;
#pragma unroll
        for (int j = 0; j < 4; ++j)
          s += hv[4 * j] * uu[q][j].x + hv[4 * j + 1] * uu[q][j].y + hv[4 * j + 2] * uu[q][j].z + hv[4 * j + 3] * uu[q][j].w;
        d[q] = s;
      }
#pragma unroll
      for (int o = 32; o > 0; o >>= 1) {
#pragma unroll
        for (int q = 0; q < 4; ++q) d[q] += __shfl_xor(d[q], o);
      }
#pragma unroll
      for (int q = 0; q < 4; ++q) {
        float a = gt[q] * gelu_exact(d[q]);
#pragma unroll
        for (int j = 0; j < 4; ++j) {
          acc[4 * j] += a * vv[q][j].x; acc[4 * j + 1] += a * vv[q][j].y; acc[4 * j + 2] += a * vv[q][j].z; acc[4 * j + 3] += a * vv[q][j].w;
        }
      }
    }
    const float* g5 = mod + (size_t)mb * 6144 + 5 * 1024;
    float xn[16];
#pragma unroll
    for (int j = 0; j < 4; ++j) {
      float4 g = *(const float4*)(g5 + 256 * j + 4 * lane);
      xn[4 * j] = xv[4 * j] + g.x * acc[4 * j];
      xn[4 * j + 1] = xv[4 * j + 1] + g.y * acc[4 * j + 1];
      xn[4 * j + 2] = xv[4 * j + 2] + g.z * acc[4 * j + 2];
      xn[4 * j + 3] = xv[4 * j + 3] + g.w * acc[4 * j + 3];
    }
    if (layer == 0) {
#pragma unroll
      for (int j = 0; j < 4; ++j) *(float4*)(xr + 256 * j + 4 * lane) = make_float4(xn[4 * j], xn[4 * j + 1], xn[4 * j + 2], xn[4 * j + 3]);
      float hn[16];
      norm_mod(xn, p.norm1 + 1024, mod1 + (size_t)mb * 6144, mod1 + (size_t)mb * 6144 + 1024, lane, hn);
      store_row_bf16(hbuf + (size_t)row * D, lane, hn);
    } else {
      float ss = 0.f;
#pragma unroll
      for (int i = 0; i < 16; ++i) ss += xn[i] * xn[i];
      ss = wave_sum(ss);
      float rr = rsqrtf(ss * (1.f / 1024.f) + EPS);
#pragma unroll
      for (int j = 0; j < 4; ++j) {
        float4 g = *(const float4*)(p.norm_f + 256 * j + 4 * lane);
        *(float4*)(xr + 256 * j + 4 * lane) = make_float4(xn[4 * j] * rr * g.x, xn[4 * j + 1] * rr * g.y, xn[4 * j + 2] * rr * g.z, xn[4 * j + 3] * rr * g.w);
      }
    }
  }
}

DI void phase_inproj1(const Params& p, char* smem) {
  const bf16_t* A = (const bf16_t*)(p.ws + OFF_HBUF);
  const bf16_t* Bt = (const bf16_t*)(p.ws + OFF_WT_IN1);
  bf16_t* pr = (bf16_t*)(p.ws + OFF_PROJ1);
  const int lane = threadIdx.x & 63, r = lane & 31, h = lane >> 5;
  const int ntn = 6, ntm = TT / 256;
  for (int tile = blockIdx.x; tile < ntm * ntn; tile += gridDim.x) {
    int tm = tile / ntn, tn = tile % ntn;
    int m0 = tm * 256, n0 = tn * 128;
    gemm_tile(A + (size_t)m0 * D, D, Bt + (size_t)n0 * D, D, D, smem, [&](int rb, int cb, const f32x16& acc) {
#pragma unroll
      for (int e = 0; e < 16; ++e) pr[(size_t)(m0 + rb + crow32(e, h)) * 768 + n0 + cb + r] = f2bf(acc[e]);
    });
  }
}

DI void upproj_rowscale(const bf16_t* __restrict__ pr, int m0, int koff, int K, float* rs) {
  const int t = threadIdx.x;
  const int rowl = t >> 1, hf = t & 1, len = K >> 1;
  const bf16_t* src = pr + (size_t)(m0 + rowl) * 768 + koff + hf * len;
  float ss = 0.f;
  for (int c = 0; c < len; c += 8) {
    uint4 v = *(const uint4*)(src + c);
    float a0 = bflo(v.x), a1 = bfhi(v.x), a2 = bflo(v.y), a3 = bfhi(v.y), a4 = bflo(v.z), a5 = bfhi(v.z), a6 = bflo(v.w), a7 = bfhi(v.w);
    ss += a0 * a0 + a1 * a1 + a2 * a2 + a3 * a3 + a4 * a4 + a5 * a5 + a6 * a6 + a7 * a7;
  }
  ss += __shfl_xor(ss, 1);
  if (hf == 0) rs[rowl] = rsqrtf(ss / (float)K + EPS);
}

DI void phase_upproj_q(const Params& p, char* smem) {
  const int t = threadIdx.x, lane = t & 63, r = lane & 31, h = lane >> 5;
  const bf16_t* pr = (const bf16_t*)(p.ws + OFF_PROJ1);
  const bf16_t* wq = (const bf16_t*)(p.ws + OFF_WT_UQ);
  bf16_t* Qb = (bf16_t*)(p.ws + OFF_Q);
  const float* ropec = (const float*)(p.ws + OFF_ROPE);
  float* rs = (float*)(smem + G_LDS);
  float* rtab = rs + 256;
  for (int i = t; i < 2048; i += NT) rtab[i] = ropec[i];
  const int nq = (TX / 256) * 12;
  for (int tile = blockIdx.x; tile < nq; tile += gridDim.x) {
    const int tm = tile / 12, tn = tile % 12;
    const int m0 = tm * 256, n0 = tn * 128;
    __syncthreads();
    upproj_rowscale(pr, m0, 0, 384, rs);
    __syncthreads();
    const int b = m0 >> 12, t0 = m0 & 4095;
    gemm_tile(pr + (size_t)m0 * 768, 768, wq + (size_t)n0 * 384, 384, 384, smem, [&](int rb, int cb, const f32x16& acc) {
      const int cg = n0 + cb;
      const int hd = cg / 192, d0 = cg % 192;
      const int col = d0 + r;
      const bool rope = d0 >= 128;
      const int seg = (d0 - 128) >> 5;
      const int fi = r & 15;
      bf16_t* qd = Qb + ((size_t)(b * 8 + hd) * 4096 + t0 + rb + 4 * h) * 192 + col;
      const float* rsl = rs + rb + 4 * h;
      const float* rt = rtab + (seg == 0 ? ((t0 + rb) >> 6) : (((t0 + rb) & 63) + 4 * h)) * 16 + fi;
      const int estr = seg == 0 ? 0 : 16;
      const float sgn = (r & 16) ? 1.f : -1.f;
#pragma unroll
      for (int e = 0; e < 16; ++e) {
        const int ro = (e & 3) + 8 * (e >> 2);
        float v = acc[e] * rsl[ro];
        if (rope) {
          float pv = __shfl_xor(v, 16);
          float cs = rt[ro * estr], sn = rt[1024 + ro * estr];
          v = v * cs + sgn * pv * sn;
        }
        qd[(size_t)ro * 192] = f2bf(v);
      }
    });
  }
}

DI void phase_upproj_kv(const Params& p, char* smem) {
  const int tid0 = threadIdx.x;
  const bf16_t* pr = (const bf16_t*)(p.ws + OFF_PROJ1);
  const bf16_t* wkv = (const bf16_t*)(p.ws + OFF_WT_UKV);
  bf16_t* Kb = (bf16_t*)(p.ws + OFF_K);
  bf16_t* VTb = (bf16_t*)(p.ws + OFF_VT);
  const float* ropec = (const float*)(p.ws + OFF_ROPE);
  const float* ropes = ropec + 1024;
  float* rs = (float*)(smem + G_LDS);
  bf16_t* vts = (bf16_t*)smem;
  const int nkv = (TT / 256) * 16;
  for (int tile = blockIdx.x; tile < nkv; tile += gridDim.x) {
    int t = tid0;
    asm volatile("" : "+v"(t));
    const int lane = t & 63, r = lane & 31, h = lane >> 5;
    const int tm = tile / 16, tn = tile % 16;
    const int m0 = tm * 256, n0 = tn * 128;
    __syncthreads();
    upproj_rowscale(pr, m0, 384, 256, rs);
    __syncthreads();
    const bool isx = m0 < TX;
    const int b = isx ? (m0 >> 12) : ((m0 - TX) >> 8);
    const int key0 = isx ? (m0 & 4095) : 4096;
    const int hd = n0 >> 8;
    const bool isv = (n0 & 128) != 0;
    const size_t bh = (size_t)(b * 8 + hd);
    if (!isv) {
      gemm_tile(pr + (size_t)m0 * 768 + 384, 768, wkv + (size_t)n0 * 256, 256, 256, smem, [&](int rb, int cb, const f32x16& acc) {
        bf16_t* kd = Kb + (bh * NKEY + key0) * 192 + cb + r;
#pragma unroll
        for (int e = 0; e < 16; ++e) {
          const int rowl = rb + crow32(e, h);
          kd[(size_t)rowl * 192] = f2bf(acc[e] * rs[rowl]);
        }
      });
      const int tok = t >> 1, seg = t & 1;
      const bf16_t* src = pr + (size_t)(m0 + tok) * 768 + 640 + seg * 32;
      const uint4 i0 = *(const uint4*)(src), i1 = *(const uint4*)(src + 8), i2 = *(const uint4*)(src + 16), i3 = *(const uint4*)(src + 24);
      const unsigned ua[8] = {i0.x, i0.y, i0.z, i0.w, i1.x, i1.y, i1.z, i1.w};
      const unsigned ub[8] = {i2.x, i2.y, i2.z, i2.w, i3.x, i3.y, i3.z, i3.w};
      float a[16], bq[16];
#pragma unroll
      for (int e = 0; e < 8; ++e) { a[2 * e] = bflo(ua[e]); a[2 * e + 1] = bfhi(ua[e]); bq[2 * e] = bflo(ub[e]); bq[2 * e + 1] = bfhi(ub[e]); }
      if (isx) {
        const int tt = key0 + tok;
        const int pos = seg == 0 ? (tt >> 6) : (tt & 63);
#pragma unroll
        for (int i = 0; i < 16; ++i) {
          float cs = ropec[pos * 16 + i], sn = ropes[pos * 16 + i];
          float na = a[i] * cs - bq[i] * sn, nb = bq[i] * cs + a[i] * sn;
          a[i] = na; bq[i] = nb;
        }
      }
      bf16_t* dst = Kb + (bh * NKEY + key0 + tok) * 192 + 128 + seg * 32;
      *(uint4*)(dst) = make_uint4(pack2(a[0], a[1]), pack2(a[2], a[3]), pack2(a[4], a[5]), pack2(a[6], a[7]));
      *(uint4*)(dst + 8) = make_uint4(pack2(a[8], a[9]), pack2(a[10], a[11]), pack2(a[12], a[13]), pack2(a[14], a[15]));
      *(uint4*)(dst + 16) = make_uint4(pack2(bq[0], bq[1]), pack2(bq[2], bq[3]), pack2(bq[4], bq[5]), pack2(bq[6], bq[7]));
      *(uint4*)(dst + 24) = make_uint4(pack2(bq[8], bq[9]), pack2(bq[10], bq[11]), pack2(bq[12], bq[13]), pack2(bq[14], bq[15]));
    } else {
      gemm_tile(pr + (size_t)m0 * 768 + 384, 768, wkv + (size_t)n0 * 256, 256, 256, smem, [&](int rb, int cb, const f32x16& acc) {
#pragma unroll
        for (int e = 0; e < 16; ++e) {
          const int rowl = rb + crow32(e, h);
          vts[(cb + r) * 264 + rowl] = f2bf(acc[e] * rs[rowl]);
        }
      });
      __syncthreads();
#pragma unroll
      for (int e = 0; e < 8; ++e) {
        int idx = t + e * NT, rowd = idx >> 5, c16 = idx & 31;
        *(uint4*)(VTb + (bh * 128 + rowd) * NKEY + key0 + c16 * 8) = *(const uint4*)(vts + rowd * 264 + c16 * 8);
      }
    }
  }
}

constexpr int AT_KS = 64 * 200 * 2;
constexpr int AT_VS = 128 * 68 * 2;
constexpr int AT_STAGE = AT_KS + AT_VS;
DI void phase_attn(const Params& p, char* smem) {
  const int t = threadIdx.x, lane = t & 63, wv = t >> 6, r = lane & 31, h = lane >> 5;
  const bf16_t* Qb = (const bf16_t*)(p.ws + OFF_Q);
  const bf16_t* Kb = (const bf16_t*)(p.ws + OFF_K);
  const bf16_t* VTb = (const bf16_t*)(p.ws + OFF_VT);
  bf16_t* ob = (bf16_t*)(p.ws + OFF_HBUF);
  for (int item = blockIdx.x; item < 1024; item += gridDim.x) {
    const int bh = item >> 4, qb = item & 15;
    const int b = bh >> 3, hd = bh & 7;
    const bf16_t* Kg = Kb + (size_t)bh * NKEY * 192;
    const bf16_t* Vg = VTb + (size_t)bh * 128 * NKEY;
    bf16x8 qf[12];
    {
      const bf16_t* qrow = Qb + ((size_t)bh * 4096 + qb * 256 + wv * 32 + r) * 192 + 8 * h;
#pragma unroll
      for (int kk = 0; kk < 12; ++kk) qf[kk] = *(const bf16x8*)(qrow + 16 * kk);
    }
    f32x16 O[4];
#pragma unroll
    for (int m = 0; m < 4; ++m)
#pragma unroll
      for (int e = 0; e < 16; ++e) O[m][e] = 0.f;
    float mrun = -1e30f, lsum = 0.f;
    uint4 rk0, rk1, rk2, rv0, rv1;
    const int kc0 = t, kc1 = t + NT, kc2 = t + 2 * NT;
    const int kr0 = kc0 / 24, kq0 = kc0 % 24, kr1 = kc1 / 24, kq1 = kc1 % 24, kr2 = kc2 / 24, kq2 = kc2 % 24;
#define AT_GLOAD(kt_) { \
      rk0 = *(const uint4*)(Kg + (size_t)((kt_) * 64 + kr0) * 192 + kq0 * 8); \
      rk1 = *(const uint4*)(Kg + (size_t)((kt_) * 64 + kr1) * 192 + kq1 * 8); \
      rk2 = *(const uint4*)(Kg + (size_t)((kt_) * 64 + kr2) * 192 + kq2 * 8); \
      rv0 = *(const uint4*)(Vg + (size_t)(t >> 3) * NKEY + (kt_) * 64 + (t & 7) * 8); \
      rv1 = *(const uint4*)(Vg + (size_t)((t + NT) >> 3) * NKEY + (kt_) * 64 + (t & 7) * 8); }
#define AT_LSTORE(s_) { \
      bf16_t* Ks_ = (bf16_t*)(smem + (s_) * AT_STAGE); \
      bf16_t* Vs_ = (bf16_t*)(smem + (s_) * AT_STAGE + AT_KS); \
      *(uint4*)(Ks_ + kr0 * 200 + kq0 * 8) = rk0; \
      *(uint4*)(Ks_ + kr1 * 200 + kq1 * 8) = rk1; \
      *(uint4*)(Ks_ + kr2 * 200 + kq2 * 8) = rk2; \
      *(uint2*)(Vs_ + (t >> 3) * 68 + (t & 7) * 8) = make_uint2(rv0.x, rv0.y); \
      *(uint2*)(Vs_ + (t >> 3) * 68 + (t & 7) * 8 + 4) = make_uint2(rv0.z, rv0.w); \
      *(uint2*)(Vs_ + ((t + NT) >> 3) * 68 + (t & 7) * 8) = make_uint2(rv1.x, rv1.y); \
      *(uint2*)(Vs_ + ((t + NT) >> 3) * 68 + (t & 7) * 8 + 4) = make_uint2(rv1.z, rv1.w); }
    __syncthreads();
    AT_GLOAD(0); AT_LSTORE(0);
    __syncthreads();
#pragma unroll 1
    for (int kt = 0; kt < NCH; ++kt) {
      if (kt + 1 < NCH) AT_GLOAD(kt + 1);
      const bf16_t* Ks = (const bf16_t*)(smem + (kt & 1) * AT_STAGE);
      const bf16_t* Vs = (const bf16_t*)(smem + (kt & 1) * AT_STAGE + AT_KS);
      f32x16 st[2];
#pragma unroll
      for (int m = 0; m < 2; ++m)
#pragma unroll
        for (int e = 0; e < 16; ++e) st[m][e] = 0.f;
#pragma unroll
      for (int kk = 0; kk < 12; ++kk) {
#pragma unroll
        for (int m = 0; m < 2; ++m) {
          bf16x8 a = *(const bf16x8*)(Ks + (m * 32 + r) * 200 + 16 * kk + 8 * h);
          st[m] = MFMA32(a, qf[kk], st[m]);
        }
      }
      float mx = st[0][0];
#pragma unroll
      for (int m = 0; m < 2; ++m)
#pragma unroll
        for (int e = 0; e < 16; ++e) mx = fmaxf(mx, st[m][e]);
      mx = fmaxf(mx, __shfl_xor(mx, 32));
      const float mnew = fmaxf(mrun, mx);
      const float alpha = exp2f(mrun - mnew);
      mrun = mnew;
      float ps = 0.f;
#pragma unroll
      for (int m = 0; m < 2; ++m)
#pragma unroll
        for (int e = 0; e < 16; ++e) { float pe = exp2f(st[m][e] - mnew); st[m][e] = pe; ps += pe; }
      lsum = lsum * alpha + ps;
#pragma unroll
      for (int m = 0; m < 4; ++m)
#pragma unroll
        for (int e = 0; e < 16; ++e) O[m][e] *= alpha;
#pragma unroll
      for (int ks = 0; ks < 4; ++ks) {
        const int m = ks >> 1, s = ks & 1;
        union { bf16x8 v; unsigned u[4]; } pf;
#pragma unroll
        for (int e = 0; e < 4; ++e) pf.u[e] = pack2(st[m][8 * s + 2 * e], st[m][8 * s + 2 * e + 1]);
#pragma unroll
        for (int mo = 0; mo < 4; ++mo) {
          union { bf16x8 v; uint2 u[2]; } af;
          af.u[0] = *(const uint2*)(Vs + (mo * 32 + r) * 68 + ks * 16 + 4 * h);
          af.u[1] = *(const uint2*)(Vs + (mo * 32 + r) * 68 + ks * 16 + 8 + 4 * h);
          O[mo] = MFMA32(af.v, pf.v, O[mo]);
        }
      }
      if (kt + 1 < NCH) AT_LSTORE((kt + 1) & 1);
      __syncthreads();
    }
    lsum += __shfl_xor(lsum, 32);
    const float inv = 1.f / lsum;
    bf16_t* orow = ob + ((size_t)b * 4096 + qb * 256 + wv * 32 + r) * 1024 + hd * 128;
#pragma unroll
    for (int mo = 0; mo < 4; ++mo)
#pragma unroll
      for (int g = 0; g < 4; ++g) {
        uint2 o;
        o.x = pack2(O[mo][4 * g] * inv, O[mo][4 * g + 1] * inv);
        o.y = pack2(O[mo][4 * g + 2] * inv, O[mo][4 * g + 3] * inv);
        *(uint2*)(orow + mo * 32 + 8 * g + 4 * h) = o;
      }
  }
}

constexpr int NPHASE = 18;
DI void run_phase(const Params& p, int ph, char* smem) {
  switch (ph) {
    case 0: phase_prep(p, smem); break;
    case 1: phase_h0(p, smem); break;
    case 2: phase_inproj0(p, smem); break;
    case 3: phase_g1(p, smem); break;
    case 4: phase_g2(p, smem); break;
    case 5: phase_yb(p); break;
    case 6: phase_outproj(p, smem, 0); break;
    case 7: phase_hnorm(p, p.norm2, 0, 3, TT); break;
    case 8: phase_peerq(p, smem, 0); break;
    case 9: phase_gather(p, 0); break;
    case 10: phase_inproj1(p, smem); break;
    case 11: phase_upproj_q(p, smem); phase_upproj_kv(p, smem); break;
    case 12: phase_attn(p, smem); break;
    case 13: phase_outproj(p, smem, 1); break;
    case 14: phase_hnorm(p, p.norm2 + 1024, 1, 3, TX); break;
    case 15: phase_peerq(p, smem, 1); break;
    case 16: phase_gather(p, 1); break;
    default: break;
  }
}

constexpr int SMEM_BYTES = 147456;

#if MEGA
__global__ void __launch_bounds__(NT) mega_kernel(Params p) {
  __shared__ __attribute__((aligned(16))) char smem[SMEM_BYTES];
  cg::grid_group grid = cg::this_grid();
  for (int ph = 0; ph < 17; ++ph) {
    run_phase(p, ph, smem);
    if (ph != 16) grid.sync();
  }
}
#else
template <int PH>
__global__ void __launch_bounds__(NT) phase_kernel(Params p) {
  __shared__ __attribute__((aligned(16))) char smem[SMEM_BYTES];
  run_phase(p, PH, smem);
}
#endif

extern "C" void kernel_launch(void* const* d_in, const int* in_sizes, int n_in, void* d_out, int out_size, void* d_ws,
                              size_t ws_size, hipStream_t stream) {
  (void)in_sizes; (void)n_in; (void)out_size; (void)ws_size;
  Params p{};
  const float** f = (const float**)&p;
  for (int i = 0; i < 26; ++i) f[i] = (const float*)d_in[i];
  p.out = (float*)d_out;
  p.ws = (char*)d_ws;
#if MEGA
  static int grid_blocks = 0;
  if (!grid_blocks) {
    int dev = 0, cus = 0, per_cu = 0;
    hipGetDevice(&dev);
    hipDeviceGetAttribute(&cus, hipDeviceAttributeMultiprocessorCount, dev);
    hipOccupancyMaxActiveBlocksPerMultiprocessor(&per_cu, mega_kernel, NT, 0);
    if (per_cu > 1) per_cu = 1;
    grid_blocks = cus * per_cu;
  }
  void* args[] = {&p};
  hipLaunchCooperativeKernel((void*)mega_kernel, dim3(grid_blocks), dim3(NT), args, 0, stream);
#else
  const dim3 g(256), b(NT);
  phase_kernel<0><<<g, b, 0, stream>>>(p);
  phase_kernel<1><<<g, b, 0, stream>>>(p);
  phase_kernel<2><<<g, b, 0, stream>>>(p);
  phase_kernel<3><<<g, b, 0, stream>>>(p);
  phase_kernel<4><<<g, b, 0, stream>>>(p);
  phase_kernel<5><<<g, b, 0, stream>>>(p);
  phase_kernel<6><<<g, b, 0, stream>>>(p);
  phase_kernel<7><<<g, b, 0, stream>>>(p);
  phase_kernel<8><<<g, b, 0, stream>>>(p);
  phase_kernel<9><<<g, b, 0, stream>>>(p);
  phase_kernel<10><<<g, b, 0, stream>>>(p);
  phase_kernel<11><<<g, b, 0, stream>>>(p);
  phase_kernel<12><<<g, b, 0, stream>>>(p);
  phase_kernel<13><<<g, b, 0, stream>>>(p);
  phase_kernel<14><<<g, b, 0, stream>>>(p);
  phase_kernel<15><<<g, b, 0, stream>>>(p);
  phase_kernel<16><<<g, b, 0, stream>>>(p);
#endif
}
```

```cpp
#include <hip/hip_runtime.h>
#include <hip/hip_cooperative_groups.h>
#include <stdint.h>
namespace cg = cooperative_groups;

#ifndef MEGA
#define MEGA 1
#endif


typedef unsigned short bf16_t;
using bf16x8 = __attribute__((ext_vector_type(8))) short;
using f32x16 = __attribute__((ext_vector_type(16))) float;
using f32x4 = __attribute__((ext_vector_type(4))) float;
typedef unsigned u32x4 __attribute__((ext_vector_type(4)));
#define DI __device__ __forceinline__
#define LAS __attribute__((address_space(3)))
#define NT 512
__device__ __forceinline__ int lane_id_fresh() {
  unsigned z = 0u;
  asm volatile("" : "+v"(z));
  return (int)__builtin_amdgcn_mbcnt_hi(~0u, __builtin_amdgcn_mbcnt_lo(~0u, z));
}
#define TIDX (wave_ * 64 + lane_id_fresh())

constexpr int D = 1024;
constexpr int NB = 8;
constexpr int SEQ = 4096;
constexpr int CTXL = 256;
constexpr int TX = NB * SEQ;
constexpr int TC = NB * CTXL;
constexpr int TT = TX + TC;
constexpr int NKEY = SEQ + CTXL;
constexpr int NCH = 68;
constexpr int NITEM = NB * 4 * NCH;
constexpr float EPS = 1e-6f;

constexpr size_t OFF_MOD = 0;
constexpr size_t OFF_ROPE = OFF_MOD + 442368;
constexpr size_t OFF_WAB = OFF_ROPE + 8192;
constexpr size_t OFF_WT_IN0 = OFF_WAB + 65536;
constexpr size_t OFF_WT_OUT0 = OFF_WT_IN0 + 7340032;
constexpr size_t OFF_WT_IN1 = OFF_WT_OUT0 + 2097152;
constexpr size_t OFF_WT_UQ = OFF_WT_IN1 + 1572864;
constexpr size_t OFF_WT_UKV = OFF_WT_UQ + 1179648;
constexpr size_t OFF_WT_OUT1 = OFF_WT_UKV + 1048576;
constexpr size_t OFF_WT_PQ = OFF_WT_OUT1 + 2097152;
constexpr size_t OFF_KEYS = OFF_WT_PQ + 4194304;
constexpr size_t OFF_CTXBUF = OFF_KEYS + 524288;
constexpr size_t OFF_HBUF = OFF_CTXBUF + 8388608;
constexpr size_t OFF_AB = OFF_HBUF + 71303168;
constexpr size_t OFF_SCR = OFF_AB + 2228224;
constexpr size_t OFF_GATE = OFF_SCR;
constexpr size_t OFF_Z = OFF_GATE + 106954752;
constexpr size_t OFF_QN = OFF_Z + 35651584;
constexpr size_t OFF_KT = OFF_QN + 35651584;
constexpr size_t OFF_W = OFF_KT + 35651584;
constexpr size_t OFF_UT = OFF_W + 71303168;
constexpr size_t OFF_INTRA = OFF_UT + 71303168;
constexpr size_t OFF_SC = OFF_INTRA + 35651584;
constexpr size_t END_L0 = OFF_SC + 4456448;
constexpr size_t OFF_SELI = OFF_SCR;
constexpr size_t OFF_SELG = OFF_SELI + 17825792;
constexpr size_t OFF_PROJ1 = OFF_SELG + 17825792;
constexpr size_t OFF_Q = OFF_PROJ1 + 53477376;
constexpr size_t OFF_K = OFF_Q + 100663296;
constexpr size_t OFF_VT = OFF_K + 106954752;
constexpr size_t OFF_SELU = OFF_VT + 71303168;
constexpr size_t OFF_TSC = OFF_SELU + 17825792;
constexpr size_t OFF_SSQ = OFF_TSC + 131072;
constexpr size_t OFF_SSQ2 = OFF_SSQ + (size_t)TT * 32;
constexpr size_t END_L1 = OFF_SSQ2 + (size_t)TT * 16;
constexpr size_t OFF_TAB = OFF_PROJ1;
constexpr size_t OFF_BAR = (END_L0 > END_L1 ? END_L0 : END_L1);
constexpr size_t OFF_TAB1 = OFF_BAR + 16384;
constexpr size_t OFF_TSC1 = OFF_TAB1 + 25165824;
constexpr size_t OFF_PQB = OFF_TSC1 + 131072;
constexpr size_t WS_NEED = OFF_PQB + 2 * 9 * 1024 * 4;
constexpr size_t DO_QKV = 0;
constexpr size_t DO_OF = 0;
constexpr size_t DO_OB = 35651584;

struct Params {
  const float *x, *c, *ctx, *c_ctx, *w_mod, *b_mod, *norm1, *norm2, *ev_w_in, *ev_a_conv, *ev_qkv_conv, *ev_a_log,
      *ev_dt_bias, *ev_o_norm, *ev_w_out, *od_w_in, *od_q_norm, *od_kv_norm, *od_w_uq, *od_w_ukv, *od_w_out, *p_w_q,
      *p_keys, *p_u, *p_v, *norm_f;
  float* out;
  char* ws;
};

DI bf16_t f2bf(float x) {
  unsigned u = __float_as_uint(x);
  u += 0x7fffu + ((u >> 16) & 1u);
  return (bf16_t)(u >> 16);
}
DI float bf2f(bf16_t b) { return __uint_as_float(((unsigned)b) << 16); }
typedef float float2v __attribute__((ext_vector_type(2)));
typedef __bf16 bf16x2v __attribute__((ext_vector_type(2)));
DI unsigned pack2(float a, float b) {
  float2v f = {a, b};
  bf16x2v h = __builtin_convertvector(f, bf16x2v);
  return __builtin_bit_cast(unsigned, h);
}
DI float bflo(unsigned u) { return __uint_as_float(u << 16); }
DI float bfhi(unsigned u) { return __uint_as_float(u & 0xffff0000u); }
DI float wave_sum(float v) {
#pragma unroll
  for (int o = 32; o > 0; o >>= 1) v += __shfl_xor(v, o);
  return v;
}
DI float siluf(float x) { return x / (1.f + __expf(-x)); }
DI float softplusf(float x) { return x > 20.f ? x : log1pf(expf(x)); }
DI float sigmoidf(float x) { return 1.f / (1.f + expf(-x)); }
DI int row_mb(int row) { return row < TX ? (row >> 12) : 8; }
#define MFMA32(a, b, c) __builtin_amdgcn_mfma_f32_32x32x16_bf16((a), (b), (c), 0, 0, 0)
#define MFMA16(a, b, c) __builtin_amdgcn_mfma_f32_16x16x32_bf16((a), (b), (c), 0, 0, 0)
DI int crow32(int reg, int h) { return (reg & 3) + 8 * (reg >> 2) + 4 * h; }
DI int xcd_item(int base) { const int b = blockIdx.x, g8 = gridDim.x >> 3; return base + (b & 7) * g8 + (b >> 3); }

DI int g8_lds_byte(int r, int c) {
  int st = (r >> 4) * 2 + (c >> 5), rr = r & 15, cc = c & 31, ob = rr * 64 + cc * 2;
  return st * 1024 + (ob ^ (((ob >> 9) & 1) << 5));
}
DI void g8_stage_rc(int b, int& R, int& C) {
  int st = b / 1024, sb = b % 1024, swz = sb ^ (((sb >> 9) & 1) << 5);
  R = (st >> 1) * 16 + swz / 64; C = (st & 1) * 32 + (swz % 64) / 2;
}
constexpr int G8_HT = 16384;
constexpr int G8_LDS = 8 * G8_HT;
typedef f32x4 acc256_t[2][2][4][2];

template <int SWAPMASK>
DI void gemm256(const bf16_t* __restrict__ A, int lda, const bf16_t* __restrict__ Bt, int ldb, int K, char* smem, const int wave_, acc256_t& acc) {
  int t = TIDX;
  asm volatile("" : "+v"(t));
  const int lane = t & 63, wid = t >> 6, wr = wid >> 2, wc = wid & 3, fr = lane & 15, fq = lane >> 4;
#pragma unroll
  for (int a = 0; a < 2; ++a)
#pragma unroll
    for (int b = 0; b < 2; ++b)
#pragma unroll
      for (int m = 0; m < 4; ++m)
#pragma unroll
        for (int n = 0; n < 2; ++n) acc[a][b][m][n] = f32x4{0.f, 0.f, 0.f, 0.f};
  const __amdgpu_buffer_rsrc_t ars = __builtin_amdgcn_make_buffer_rsrc((void*)A, 0, 256 * lda * 2, 0x00020000);
  const __amdgpu_buffer_rsrc_t brs = __builtin_amdgcn_make_buffer_rsrc((void*)Bt, 0, 256 * ldb * 2, 0x00020000);
  int r0, c0, r1, c1;
  g8_stage_rc(t * 16, r0, c0);
  g8_stage_rc(t * 16 + 8192, r1, c1);
  const int avo0 = (r0 * lda + c0) * 2, avo1 = (r1 * lda + c1) * 2, bvo0 = (r0 * ldb + c0) * 2, bvo1 = (r1 * ldb + c1) * 2;
  const int ahalf = 128 * lda * 2, bhalf = 128 * ldb * 2;
  LAS char* lds = (LAS char*)smem;
#define G8_SA(b, h) (lds + ((b) * 2 + (h)) * G8_HT)
#define G8_SB(b, h) (lds + (4 + (b) * 2 + (h)) * G8_HT)
#define G8_STAGE_A(b, h, kt) { \
    __builtin_amdgcn_raw_ptr_buffer_load_lds(ars, (LAS void*)(G8_SA(b, h) + t * 16), 16, avo0, (h) * ahalf + (kt) * 128, 0, 0); \
    __builtin_amdgcn_raw_ptr_buffer_load_lds(ars, (LAS void*)(G8_SA(b, h) + t * 16 + 8192), 16, avo1, (h) * ahalf + (kt) * 128, 0, 0); }
#define G8_STAGE_B(b, h, kt) { \
    __builtin_amdgcn_raw_ptr_buffer_load_lds(brs, (LAS void*)(G8_SB(b, h) + t * 16), 16, bvo0, (h) * bhalf + (kt) * 128, 0, 0); \
    __builtin_amdgcn_raw_ptr_buffer_load_lds(brs, (LAS void*)(G8_SB(b, h) + t * 16 + 8192), 16, bvo1, (h) * bhalf + (kt) * 128, 0, 0); }
  const int fro = (fr * 64 + fq * 16) ^ ((fr >> 3) << 5);
  const int aoff = wr * 8 * 1024 + fro, boff = wc * 4 * 1024 + fro;
#define G8_LDA(dst, b, h) { _Pragma("unroll") for (int m = 0; m < 4; ++m) _Pragma("unroll") for (int k = 0; k < 2; ++k) \
    dst[m][k] = *(const LAS bf16x8*)(G8_SA(b, h) + aoff + (m * 2 + k) * 1024); }
#define G8_LDB(dst, b, h) { _Pragma("unroll") for (int n = 0; n < 2; ++n) _Pragma("unroll") for (int k = 0; k < 2; ++k) \
    dst[n][k] = *(const LAS bf16x8*)(G8_SB(b, h) + boff + (n * 2 + k) * 1024); }
#define G8_MMA(ai, bj, At_, Bt_) { __builtin_amdgcn_s_setprio(1); \
    _Pragma("unroll") for (int m = 0; m < 4; ++m) _Pragma("unroll") for (int n = 0; n < 2; ++n) _Pragma("unroll") for (int k = 0; k < 2; ++k) \
      acc[ai][bj][m][n] = ((SWAPMASK >> (bj)) & 1) ? MFMA16(Bt_[n][k], At_[m][k], acc[ai][bj][m][n]) : MFMA16(At_[m][k], Bt_[n][k], acc[ai][bj][m][n]); \
    __builtin_amdgcn_s_setprio(0); }
#define G8_WAIT_V(n) asm volatile("s_waitcnt vmcnt(" #n ")" ::: "memory")
#define G8_WAIT_L(n) asm volatile("s_waitcnt lgkmcnt(" #n ")" ::: "memory")
#define G8_BAR __builtin_amdgcn_s_barrier()
#define G8_SCHED __builtin_amdgcn_sched_barrier(0)
  bf16x8 At[4][2], B0[2][2], B1[2][2];
  const int nt = K >> 6;
  G8_STAGE_B(0, 0, 0); G8_STAGE_A(0, 0, 0);
  G8_STAGE_B(0, 1, 0); G8_STAGE_A(0, 1, 0);
  if (wr == 1) G8_BAR;
  G8_WAIT_V(4); G8_BAR;
  G8_STAGE_B(1, 0, 1); G8_STAGE_A(1, 0, 1); G8_STAGE_B(1, 1, 1);
  G8_WAIT_V(6); G8_BAR;
  for (int tt = 0; tt < nt - 2; tt += 2) {
    G8_LDB(B0, 0, 0); G8_SCHED; G8_LDA(At, 0, 0); G8_STAGE_A(1, 1, tt + 1);
    G8_WAIT_L(8); G8_BAR; G8_WAIT_L(0); G8_MMA(0, 0, At, B0); G8_BAR; G8_SCHED;
    G8_LDB(B1, 0, 1); G8_STAGE_B(0, 0, tt + 2);
    G8_BAR; G8_WAIT_L(0); G8_MMA(0, 1, At, B1); G8_BAR;
    G8_LDA(At, 0, 1); G8_STAGE_A(0, 0, tt + 2);
    G8_BAR; G8_WAIT_L(0); G8_MMA(1, 0, At, B0); G8_BAR; G8_SCHED;
    G8_STAGE_B(0, 1, tt + 2);
    G8_WAIT_V(6); G8_BAR; G8_MMA(1, 1, At, B1); G8_BAR;
    G8_LDB(B0, 1, 0); G8_SCHED; G8_LDA(At, 1, 0); G8_STAGE_A(0, 1, tt + 2);
    G8_WAIT_L(8); G8_BAR; G8_WAIT_L(0); G8_MMA(0, 0, At, B0); G8_BAR; G8_SCHED;
    G8_LDB(B1, 1, 1); G8_STAGE_B(1, 0, tt + 3);
    G8_BAR; G8_WAIT_L(0); G8_MMA(0, 1, At, B1); G8_BAR;
    G8_LDA(At, 1, 1); G8_STAGE_A(1, 0, tt + 3);
    G8_BAR; G8_WAIT_L(0); G8_MMA(1, 0, At, B0); G8_BAR; G8_SCHED;
    G8_STAGE_B(1, 1, tt + 3);
    G8_WAIT_V(6); G8_BAR; G8_MMA(1, 1, At, B1); G8_BAR;
  }
  { G8_LDB(B0, 0, 0); G8_LDA(At, 0, 0); G8_STAGE_A(1, 1, nt - 1);
    G8_BAR; G8_WAIT_L(0); G8_MMA(0, 0, At, B0); G8_BAR;
    G8_LDB(B1, 0, 1); G8_BAR; G8_WAIT_L(0); G8_MMA(0, 1, At, B1); G8_BAR;
    G8_LDA(At, 0, 1); G8_WAIT_V(4); G8_BAR; G8_WAIT_L(0); G8_MMA(1, 0, At, B0); G8_MMA(1, 1, At, B1); G8_BAR; }
  { G8_LDB(B0, 1, 0); G8_LDA(At, 1, 0); G8_WAIT_V(2); G8_BAR; G8_WAIT_L(0); G8_MMA(0, 0, At, B0); G8_BAR;
    G8_LDB(B1, 1, 1); G8_WAIT_V(0); G8_BAR; G8_WAIT_L(0); G8_MMA(0, 1, At, B1); G8_BAR;
    G8_LDA(At, 1, 1); G8_BAR; G8_WAIT_L(0); G8_MMA(1, 0, At, B0); G8_MMA(1, 1, At, B1); G8_BAR; }
  if (wr == 0) G8_BAR;
  __syncthreads();
}

DI void store_bf16x8_pair(bf16_t* rowp, const f32x4& v0, const f32x4& v1, int fq) {
  const unsigned a0 = pack2(v0[0], v0[1]), a1 = pack2(v0[2], v0[3]), b0 = pack2(v1[0], v1[1]), b1 = pack2(v1[2], v1[3]);
  const unsigned om = (fq & 1) ? ~0u : 0u;
  const unsigned s0 = b0 ^ ((b0 ^ a0) & om), s1 = b1 ^ ((b1 ^ a1) & om);
  const unsigned r0 = (unsigned)__shfl_xor((int)s0, 16), r1 = (unsigned)__shfl_xor((int)s1, 16);
  const unsigned o0 = a0 ^ ((a0 ^ r0) & om), o1 = a1 ^ ((a1 ^ r1) & om), o2 = r0 ^ ((r0 ^ b0) & om), o3 = r1 ^ ((r1 ^ b1) & om);
  bf16_t* dst = rowp + ((fq & 1) ? 16 + 4 * (fq - 1) : 4 * fq);
  *(uint4*)dst = make_uint4(o0, o1, o2, o3);
}

struct TJob { const float* src; const float* kgain; bf16_t* dst; int ldsrc, K, ntn, tile; float scal; };
DI void tjob_load(const TJob& jb, float* tl, int t) {
  const int kt = jb.tile / jb.ntn, nt = jb.tile % jb.ntn;
  const int k0 = kt * 64, n0 = nt * 64;
#pragma unroll
  for (int e = 0; e < 2; ++e) {
    int kk = (t >> 4) + e * 32, n4 = (t & 15) * 4;
    float4 v = *(const float4*)(jb.src + (size_t)(k0 + kk) * jb.ldsrc + n0 + n4);
    float g = jb.scal * (jb.kgain ? jb.kgain[k0 + kk] : 1.f);
    tl[kk * 65 + n4 + 0] = v.x * g;
    tl[kk * 65 + n4 + 1] = v.y * g;
    tl[kk * 65 + n4 + 2] = v.z * g;
    tl[kk * 65 + n4 + 3] = v.w * g;
  }
}
DI void tjob_store(const TJob& jb, const float* tl, int t) {
  const int kt = jb.tile / jb.ntn, nt = jb.tile % jb.ntn;
  const int k0 = kt * 64, n0 = nt * 64;
  int n = t >> 3, k8 = (t & 7) * 8;
  uint4 o;
  o.x = pack2(tl[(k8 + 0) * 65 + n], tl[(k8 + 1) * 65 + n]);
  o.y = pack2(tl[(k8 + 2) * 65 + n], tl[(k8 + 3) * 65 + n]);
  o.z = pack2(tl[(k8 + 4) * 65 + n], tl[(k8 + 5) * 65 + n]);
  o.w = pack2(tl[(k8 + 6) * 65 + n], tl[(k8 + 7) * 65 + n]);
  *(uint4*)(jb.dst + (size_t)(n0 + n) * jb.K + k0 + k8) = o;
}

DI void phase_prep(const Params& p, char* smem, const int wave_) {
  const int t = TIDX, nb = gridDim.x, bid = blockIdx.x;
  char* ws = p.ws;
  {
    float* sl = (float*)smem;
    float* red = sl + 9 * 1024;
    bool have = false;
    for (int job = bid; job < 192; job += nb) {
      if (!have) {
        for (int i = t; i < 9 * 1024; i += NT) {
          float v = i < 8192 ? p.c[i] : p.c_ctx[i - 8192];
          sl[i] = siluf(v);
        }
        have = true;
      }
      __syncthreads();
      int l = job / 96, ch = job % 96, col = t & 63, kg = t >> 6;
      const float* w = p.w_mod + (size_t)l * 1024 * 6144 + ch * 64 + col;
      float acc[9];
#pragma unroll
      for (int r = 0; r < 9; ++r) acc[r] = 0.f;
      for (int k = kg * 128; k < kg * 128 + 128; ++k) {
        float wv = w[(size_t)k * 6144];
#pragma unroll
        for (int r = 0; r < 9; ++r) acc[r] += sl[r * 1024 + k] * wv;
      }
#pragma unroll
      for (int r = 0; r < 9; ++r) red[(kg * 9 + r) * 64 + col] = acc[r];
      __syncthreads();
      for (int i = t; i < 9 * 64; i += NT) {
        int r = i >> 6, cc = i & 63;
        float s = 0.f;
#pragma unroll
        for (int g = 0; g < 8; ++g) s += red[(g * 9 + r) * 64 + cc];
        int n = ch * 64 + cc;
        ((float*)(ws + OFF_MOD))[((size_t)l * 9 + r) * 6144 + n] = s + p.b_mod[l * 6144 + n];
      }
    }
    __syncthreads();
  }
  {
    float* tl = (float*)smem;
    const float qscale = 0.07216878364870322f * 1.4426950408889634f;
    const int n0_ = 16 * 56, n1_ = 256, n2_ = 16 * 11, n3_ = 6 * 24, n4_ = 4 * 32, n5_ = 256, n6_ = 256, n7_ = 256;
    const int total = n0_ + n1_ + n2_ + n3_ + n4_ + n5_ + n6_ + n7_;
#define TJOB_DECODE(jb, job_) { int j = (job_); \
      if (j < n0_) jb = TJob{p.ev_w_in, nullptr, (bf16_t*)(ws + OFF_WT_IN0), 3600, 1024, 56, j, 1.f}; \
      else if ((j -= n0_) < n1_) jb = TJob{p.ev_w_out, nullptr, (bf16_t*)(ws + OFF_WT_OUT0), 1024, 1024, 16, j, 1.f}; \
      else if ((j -= n1_) < n2_) jb = TJob{p.od_w_in, nullptr, (bf16_t*)(ws + OFF_WT_IN1), 704, 1024, 11, j, 1.f}; \
      else if ((j -= n2_) < n3_) jb = TJob{p.od_w_uq, p.od_q_norm, (bf16_t*)(ws + OFF_WT_UQ), 1536, 384, 24, j, qscale}; \
      else if ((j -= n3_) < n4_) jb = TJob{p.od_w_ukv, p.od_kv_norm, (bf16_t*)(ws + OFF_WT_UKV), 2048, 256, 32, j, 1.f}; \
      else if ((j -= n4_) < n5_) jb = TJob{p.od_w_out, nullptr, (bf16_t*)(ws + OFF_WT_OUT1), 1024, 1024, 16, j, 1.f}; \
      else if ((j -= n5_) < n6_) jb = TJob{p.p_w_q, nullptr, (bf16_t*)(ws + OFF_WT_PQ), 1024, 1024, 16, j, 1.f}; \
      else { j -= n6_; jb = TJob{p.p_w_q + 1024 * 1024, nullptr, (bf16_t*)(ws + OFF_WT_PQ) + 1024 * 1024, 1024, 1024, 16, j, 1.f}; } }
    for (int base = bid * 4; base < total; base += nb * 4) {
      __syncthreads();
#pragma unroll
      for (int q = 0; q < 4; ++q)
        if (base + q < total) { TJob jb; TJOB_DECODE(jb, base + q) tjob_load(jb, tl + q * (64 * 65), t); }
      __syncthreads();
#pragma unroll
      for (int q = 0; q < 4; ++q)
        if (base + q < total) { TJob jb; TJOB_DECODE(jb, base + q) tjob_store(jb, tl + q * (64 * 65), t); }
    }
#undef TJOB_DECODE
  }
  const int gt = bid * NT + t, gs = nb * NT;
  for (int i = gt; i < 2 * 8 * 2 * 128 * 64; i += gs) ((bf16_t*)(ws + OFF_KEYS))[i] = f2bf(p.p_keys[i]);
  for (int i = gt; i < 16 * 1024; i += gs) {
    int n = i >> 10, k = i & 1023;
    ((float*)(ws + OFF_WAB))[i] = p.ev_w_in[(size_t)k * 3600 + 3584 + n];
  }
  for (int i = gt; i < 64 * 1024; i += gs) ((bf16_t*)(ws + OFF_WT_IN1))[704 * 1024 + i] = 0;
  for (int i = gt; i < 64 * 16; i += gs) {
    int pos = i >> 4, f = i & 15;
    float freq = powf(10000.f, -(float)f / 16.f);
    float ang = (float)pos * freq;
    ((float*)(ws + OFF_ROPE))[i] = cosf(ang);
    ((float*)(ws + OFF_ROPE))[1024 + i] = sinf(ang);
  }
}

DI void load_row(const float* __restrict__ row, int lane, float (&v)[16]) {
#pragma unroll
  for (int j = 0; j < 4; ++j) {
    float4 a = *(const float4*)(row + 256 * j + 4 * lane);
    v[4 * j] = a.x; v[4 * j + 1] = a.y; v[4 * j + 2] = a.z; v[4 * j + 3] = a.w;
  }
}
DI void norm_mod(const float (&xv)[16], const float* __restrict__ gain, const float* __restrict__ shift, const float* __restrict__ scale,
                 int lane, float (&hv)[16]) {
  float ss = 0.f;
#pragma unroll
  for (int i = 0; i < 16; ++i) ss += xv[i] * xv[i];
  ss = wave_sum(ss);
  float r = rsqrtf(ss * (1.f / 1024.f) + EPS);
#pragma unroll
  for (int j = 0; j < 4; ++j) {
    float4 g = *(const float4*)(gain + 256 * j + 4 * lane);
    float4 sh = *(const float4*)(shift + 256 * j + 4 * lane);
    float4 sc = *(const float4*)(scale + 256 * j + 4 * lane);
    hv[4 * j + 0] = xv[4 * j + 0] * r * g.x * (1.f + sc.x) + sh.x;
    hv[4 * j + 1] = xv[4 * j + 1] * r * g.y * (1.f + sc.y) + sh.y;
    hv[4 * j + 2] = xv[4 * j + 2] * r * g.z * (1.f + sc.z) + sh.z;
    hv[4 * j + 3] = xv[4 * j + 3] * r * g.w * (1.f + sc.w) + sh.w;
  }
}
DI void store_row_bf16(bf16_t* __restrict__ row, int lane, const float (&v)[16]) {
#pragma unroll
  for (int j = 0; j < 4; ++j) {
    uint2 o;
    o.x = pack2(v[4 * j], v[4 * j + 1]);
    o.y = pack2(v[4 * j + 2], v[4 * j + 3]);
    *(uint2*)(row + 256 * j + 4 * lane) = o;
  }
}

DI void phase_h0(const Params& p, char* smem, const int wave_) {
  const int t = TIDX, lane = t & 63, wv = t >> 6;
  float* wab = (float*)smem;
  for (int i = t; i < 16 * 1024; i += NT) wab[i] = ((const float*)(p.ws + OFF_WAB))[i];
  __syncthreads();
  const float* mod = (const float*)(p.ws + OFF_MOD);
  bf16_t* hbuf = (bf16_t*)(p.ws + OFF_HBUF);
  float* ab = (float*)(p.ws + OFF_AB);
  for (int row = blockIdx.x * 8 + wv; row < TT; row += gridDim.x * 8) {
    const float* xr = row < TX ? p.x + (size_t)row * D : p.ctx + (size_t)(row - TX) * D;
    int mb = row_mb(row);
    float xv[16], hv[16];
    load_row(xr, lane, xv);
    norm_mod(xv, p.norm1, mod + (size_t)mb * 6144, mod + (size_t)mb * 6144 + 1024, lane, hv);
    store_row_bf16(hbuf + (size_t)row * D, lane, hv);
    float sv[16];
#pragma unroll
    for (int n = 0; n < 16; ++n) {
      float s = 0.f;
#pragma unroll
      for (int j = 0; j < 4; ++j) {
        float4 w = *(const float4*)(wab + n * 1024 + 256 * j + 4 * lane);
        s += hv[4 * j] * w.x + hv[4 * j + 1] * w.y + hv[4 * j + 2] * w.z + hv[4 * j + 3] * w.w;
      }
      sv[n] = s;
      __builtin_amdgcn_sched_barrier(0);
    }
#define TR_(d, lo, hi, m, off) { const unsigned ul_ = __float_as_uint(lo), uh_ = __float_as_uint(hi); \
      d = __uint_as_float(ul_ ^ ((ul_ ^ uh_) & (m))) + __shfl_xor(__uint_as_float(uh_ ^ ((uh_ ^ ul_) & (m))), off); }
    {
      const unsigned m0_ = (lane & 1) ? ~0u : 0u, m1_ = (lane & 2) ? ~0u : 0u, m2_ = (lane & 4) ? ~0u : 0u, m3_ = (lane & 8) ? ~0u : 0u;
      float a0, a1, a2, a3, a4, a5, a6, a7, b0, b1, b2, b3, c0, c1;
      TR_(a0, sv[0], sv[1], m0_, 1) TR_(a1, sv[2], sv[3], m0_, 1) TR_(a2, sv[4], sv[5], m0_, 1) TR_(a3, sv[6], sv[7], m0_, 1)
      TR_(a4, sv[8], sv[9], m0_, 1) TR_(a5, sv[10], sv[11], m0_, 1) TR_(a6, sv[12], sv[13], m0_, 1) TR_(a7, sv[14], sv[15], m0_, 1)
      TR_(b0, a0, a1, m1_, 2) TR_(b1, a2, a3, m1_, 2) TR_(b2, a4, a5, m1_, 2) TR_(b3, a6, a7, m1_, 2)
      TR_(c0, b0, b1, m2_, 4) TR_(c1, b2, b3, m2_, 4)
      TR_(sv[0], c0, c1, m3_, 8)
    }
#undef TR_
    float myab = sv[0];
    myab += __shfl_xor(myab, 16);
    myab += __shfl_xor(myab, 32);
    if (lane < 16) ab[(size_t)row * 16 + lane] = myab;
  }
  {
    const bf16_t* wq = (const bf16_t*)(p.ws + OFF_WT_PQ);
    float* pqb = (float*)(p.ws + OFF_PQB);
    for (int j = blockIdx.x * 8 + wv; j < 2 * 9 * 1024; j += gridDim.x * 8) {
      const int layer = j / 9216, rem = j - layer * 9216, mb = rem >> 10, n = rem & 1023;
      const float* sh = mod + (size_t)(layer * 9 + mb) * 6144 + 3 * 1024 + 16 * lane;
      const bf16_t* wrow = wq + ((size_t)layer * 1024 + n) * 1024 + 16 * lane;
      const uint4 w0 = *(const uint4*)wrow, w1 = *(const uint4*)(wrow + 8);
      const unsigned wu[8] = {w0.x, w0.y, w0.z, w0.w, w1.x, w1.y, w1.z, w1.w};
      float sacc = 0.f;
#pragma unroll
      for (int i = 0; i < 8; ++i) sacc += sh[2 * i] * bflo(wu[i]) + sh[2 * i + 1] * bfhi(wu[i]);
      sacc = wave_sum(sacc);
      if (lane == 0) pqb[j] = sacc;
    }
  }
}

DI void phase_hnorm(const Params& p, const float* gain, int layer, int shift_idx, int nrows, const int wave_) {
  const int t = TIDX, lane = t & 63, wv = t >> 6;
  const float* mod = (const float*)(p.ws + OFF_MOD) + (size_t)layer * 9 * 6144;
  bf16_t* hbuf = (bf16_t*)(p.ws + OFF_HBUF);
  for (int row = blockIdx.x * 8 + wv; row < nrows; row += gridDim.x * 8) {
    const float* xr = row < TX ? p.out + (size_t)row * D : (const float*)(p.ws + OFF_CTXBUF) + (size_t)(row - TX) * D;
    int mb = row_mb(row);
    float xv[16], hv[16];
    load_row(xr, lane, xv);
    norm_mod(xv, gain, mod + (size_t)mb * 6144 + shift_idx * 1024, mod + (size_t)mb * 6144 + (shift_idx + 1) * 1024, lane, hv);
    store_row_bf16(hbuf + (size_t)row * D, lane, hv);
  }
}

DI void phase_inproj0(const Params& p, char* smem, const int wave_) {
  const bf16_t* A = (const bf16_t*)(p.ws + OFF_HBUF);
  const bf16_t* Bt = (const bf16_t*)(p.ws + OFF_WT_IN0);
  bf16_t* gate = (bf16_t*)(p.ws + OFF_GATE);
  bf16_t* qkv = (bf16_t*)((char*)p.out + DO_QKV);
  bf16_t* z = (bf16_t*)(p.ws + OFF_Z);
  const int ntn = 14, ntm = TT / 256;
  for (int tbase = 0; tbase < ntm * ntn; tbase += gridDim.x) {
    const int tile = xcd_item(tbase);
    if (tile >= ntm * ntn) continue;
    const int tm = tile / ntn, tn = tile % ntn;
    const int m0 = tm * 256, n0 = tn * 256;
    bf16_t* dst; int ld, nb;
    if (n0 < 1536) { dst = gate; ld = 1536; nb = n0; }
    else if (n0 < 3072) { dst = qkv; ld = 1536; nb = n0 - 1536; }
    else { dst = z; ld = 512; nb = n0 - 3072; }
    acc256_t acc;
    gemm256<3>(A + (size_t)m0 * D, D, Bt + (size_t)n0 * D, D, D, smem, wave_, acc);
    int t = TIDX; asm volatile("" : "+v"(t));
    const int lane = t & 63, wid = t >> 6, wr = wid >> 2, wc = wid & 3, fr = lane & 15, fq = lane >> 4;
#pragma unroll
    for (int ai = 0; ai < 2; ++ai)
#pragma unroll
      for (int m = 0; m < 4; ++m) {
        bf16_t* drow = dst + (size_t)(m0 + ai * 128 + wr * 64 + m * 16 + fr) * ld + nb + wc * 32;
#pragma unroll
        for (int bj = 0; bj < 2; ++bj) store_bf16x8_pair(drow + bj * 128, acc[ai][bj][m][0], acc[ai][bj][m][1], fq);
      }
  }
}

#define LA_(i, j) (UPPER ? A[(63 - (i)) * 68 + (63 - (j))] : A[(i) * 68 + (j)])
#define TI_(i, j) (UPPER ? ((63 - (i)) * 65 + (63 - (j))) : ((i) * 65 + (j)))
template <bool UPPER>
DI void tri_diag_wave(const float* __restrict__ A, float* __restrict__ T32, int lane) {
  int g = lane >> 4, c = lane & 15;
  asm volatile("" : "+v"(g), "+v"(c));
  float tv[16];
#pragma unroll
  for (int i = 0; i < 16; ++i) {
    float acc = (i == c) ? 1.f : 0.f;
#pragma unroll
    for (int j = 0; j < i; ++j) acc -= LA_(16 * g + i, 16 * g + j) * tv[j];
    tv[i] = acc;
  }
#pragma unroll
  for (int i = 0; i < 16; ++i) T32[TI_(16 * g + i, 16 * g + c)] = tv[i];
}
template <bool UPPER, int DD>
DI void tri_block_wave(const float* __restrict__ A, float* __restrict__ T32, int lane, int q) {
  int g = lane >> 4, c = lane & 15;
  asm volatile("" : "+v"(g), "+v"(c));
  const int pb = q + DD;
  f32x4 S = {0.f, 0.f, 0.f, 0.f};
#pragma unroll
  for (int kd = 0; kd < DD; ++kd) {
    const int k = q + kd;
#pragma unroll
    for (int ks = 0; ks < 4; ++ks) {
      float av = LA_(16 * pb + c, 16 * k + 4 * ks + g);
      float bv = T32[TI_(16 * k + 4 * ks + g, 16 * q + c)];
      S = __builtin_amdgcn_mfma_f32_16x16x4f32(av, bv, S, 0, 0, 0);
    }
  }
  f32x4 R = {0.f, 0.f, 0.f, 0.f};
#pragma unroll
  for (int ks = 0; ks < 4; ++ks) {
    float av = T32[TI_(16 * pb + c, 16 * pb + 4 * g + ks)];
    R = __builtin_amdgcn_mfma_f32_16x16x4f32(av, S[ks], R, 0, 0, 0);
  }
#pragma unroll
  for (int e = 0; e < 4; ++e) T32[TI_(16 * pb + 4 * g + e, 16 * q + c)] = -R[e];
}
#undef LA_
#undef TI_

DI int item_row0(int b, int gc) { return gc < 4 ? TX + b * CTXL + gc * 64 : b * SEQ + (gc - 4) * 64; }

DI void phase_g1(const Params& p, char* smem, const int wave_) {
  const int tid0 = TIDX;
  bf16_t* qn = (bf16_t*)smem;
  bf16_t* kn = qn + 64 * 136;
  bf16_t* vn = kn + 64 * 136;
  char* big = (char*)(vn + 64 * 136);
  float* KKs = (float*)big;
  float* QKs = KKs + 64 * 65;
  float* T32f = KKs;
  float* T32b = QKs;
  float* Af = (float*)(big + 33280);
  float* Ab = Af + 64 * 68;
  bf16_t* kbdT = (bf16_t*)big;
  bf16_t* vbT = kbdT + 128 * 72;
  bf16_t* Tf = (bf16_t*)(big + 68096);
  bf16_t* Tb = Tf + 64 * 72;
  float* sc = (float*)(Tb + 64 * 72);
  float *decf = sc, *decb = sc + 64, *betaf = sc + 128, *betab = sc + 192, *ckf = sc + 256, *ckb = sc + 320;
  float* cwq = sc + 384;
  float* cwa = cwq + 1152;

  const bf16_t* gate = (const bf16_t*)(p.ws + OFF_GATE);
  const bf16_t* qkv = (const bf16_t*)((const char*)p.out + DO_QKV);
  const float* ab = (const float*)(p.ws + OFF_AB);
  bf16_t* y = (bf16_t*)(p.ws + OFF_HBUF);
  const float scale = 0.08838834764831845f;

  for (int item = blockIdx.x; item < NITEM; item += gridDim.x) {
    int t = tid0;
    asm volatile("" : "+v"(t));
    const int lane = t & 63, wv = __builtin_amdgcn_readfirstlane(t >> 6), r = lane & 31, h2 = lane >> 5;
    const int b = item / (4 * NCH), hh = (item / NCH) & 3, gc = item % NCH;
    const int row0 = item_row0(b, gc);
    const int L = gc < 4 ? CTXL : SEQ;
    const int tpos0 = gc < 4 ? gc * 64 : (gc - 4) * 64;
    {
      float wst[3];
#pragma unroll
      for (int e = 0; e < 3; ++e) {
        const int idx = t + e * NT;
        const int ten = idx / 384, rem = idx - ten * 384, tap = rem >> 7, ch = rem & 127;
        const float* sp = idx < 1152 ? p.ev_qkv_conv + tap * 1536 + ten * 512 + hh * 128 + ch : p.ev_a_conv + tap * 512 + hh * 128 + ch;
        wst[e] = *sp;
      }
#pragma unroll
      for (int e = 0; e < 3; ++e) cwq[t + e * NT] = wst[e];
    }
    __syncthreads();
    float pre_a = 0.f, pre_b = 0.f;
    if (wv < 2) {
      const float* abr = ab + (size_t)(row0 + lane) * 16 + 4 * wv + hh;
      pre_a = abr[0]; pre_b = abr[8];
    }
    {
      const int i = t >> 3, part = t & 7;
      const int tp = tpos0 + i;
      const bool hasm = tp > 0, hasp = tp < L - 1;
      const int om = hasm ? 1536 : 0, op = hasp ? 1536 : 0;
      const unsigned mm = hasm ? ~0u : 0u, mp = hasp ? ~0u : 0u;
      const size_t rowc = (size_t)(row0 + i);
      const bf16_t* qsrc = qkv + rowc * 1536 + hh * 128 + part * 16;
      const bf16_t* gsrc = gate + rowc * 1536 + hh * 128 + part * 16;
      uint4 rc[3][2], rm[3][2], rp[3][2];
#pragma unroll
      for (int ten = 0; ten < 3; ++ten) {
        const bf16_t* src = qsrc + ten * 512;
        rc[ten][0] = *(const uint4*)(src); rc[ten][1] = *(const uint4*)(src + 8);
        rm[ten][0] = *(const uint4*)(src - om); rm[ten][1] = *(const uint4*)(src - om + 8);
        rp[ten][0] = *(const uint4*)(src + op); rp[ten][1] = *(const uint4*)(src + op + 8);
      }
      uint4 bg[2], cgm[2], cgc[2], cgp[2], xam[2], xac[2], xap[2];
      bg[0] = *(const uint4*)(gsrc); bg[1] = *(const uint4*)(gsrc + 8);
      cgc[0] = *(const uint4*)(gsrc + 512); cgc[1] = *(const uint4*)(gsrc + 512 + 8);
      xac[0] = *(const uint4*)(gsrc + 1024); xac[1] = *(const uint4*)(gsrc + 1024 + 8);
      cgm[0] = *(const uint4*)(gsrc - om + 512); cgm[1] = *(const uint4*)(gsrc - om + 512 + 8);
      xam[0] = *(const uint4*)(gsrc - om + 1024); xam[1] = *(const uint4*)(gsrc - om + 1024 + 8);
      cgp[0] = *(const uint4*)(gsrc + op + 512); cgp[1] = *(const uint4*)(gsrc + op + 512 + 8);
      xap[0] = *(const uint4*)(gsrc + op + 1024); xap[1] = *(const uint4*)(gsrc + op + 1024 + 8);
      __builtin_amdgcn_sched_barrier(0);
#pragma unroll
      for (int ten = 0; ten < 3; ++ten) {
        float v[16];
        const unsigned um[8] = {rm[ten][0].x & mm, rm[ten][0].y & mm, rm[ten][0].z & mm, rm[ten][0].w & mm, rm[ten][1].x & mm, rm[ten][1].y & mm, rm[ten][1].z & mm, rm[ten][1].w & mm};
        const unsigned uc[8] = {rc[ten][0].x, rc[ten][0].y, rc[ten][0].z, rc[ten][0].w, rc[ten][1].x, rc[ten][1].y, rc[ten][1].z, rc[ten][1].w};
        const unsigned up[8] = {rp[ten][0].x & mp, rp[ten][0].y & mp, rp[ten][0].z & mp, rp[ten][0].w & mp, rp[ten][1].x & mp, rp[ten][1].y & mp, rp[ten][1].z & mp, rp[ten][1].w & mp};
        const float* w0 = cwq + ten * 384 + part * 16; const float* w1 = w0 + 128; const float* w2 = w0 + 256;
        float ss = 0.f;
#pragma unroll
        for (int e = 0; e < 8; ++e) {
          float a0 = w0[2 * e] * bflo(um[e]) + w1[2 * e] * bflo(uc[e]) + w2[2 * e] * bflo(up[e]);
          float a1 = w0[2 * e + 1] * bfhi(um[e]) + w1[2 * e + 1] * bfhi(uc[e]) + w2[2 * e + 1] * bfhi(up[e]);
          a0 = siluf(a0); a1 = siluf(a1);
          v[2 * e] = a0; v[2 * e + 1] = a1;
          ss += a0 * a0 + a1 * a1;
        }
        float sc_ = 1.f;
        if (ten < 2) {
          ss += __shfl_xor(ss, 1); ss += __shfl_xor(ss, 2); ss += __shfl_xor(ss, 4);
          sc_ = rsqrtf(ss + EPS);
        }
        uint4 o0, o1;
        o0.x = pack2(v[0] * sc_, v[1] * sc_); o0.y = pack2(v[2] * sc_, v[3] * sc_); o0.z = pack2(v[4] * sc_, v[5] * sc_); o0.w = pack2(v[6] * sc_, v[7] * sc_);
        o1.x = pack2(v[8] * sc_, v[9] * sc_); o1.y = pack2(v[10] * sc_, v[11] * sc_); o1.z = pack2(v[12] * sc_, v[13] * sc_); o1.w = pack2(v[14] * sc_, v[15] * sc_);
        bf16_t* dstl = (ten == 0 ? qn : ten == 1 ? kn : vn) + i * 136 + part * 16;
        *(uint4*)dstl = o0; *(uint4*)(dstl + 8) = o1;
      }
      {
        const int ch0 = hh * 128 + part * 16;
        const unsigned ubg[8] = {bg[0].x, bg[0].y, bg[0].z, bg[0].w, bg[1].x, bg[1].y, bg[1].z, bg[1].w};
        const unsigned ucm[8] = {cgm[0].x & mm, cgm[0].y & mm, cgm[0].z & mm, cgm[0].w & mm, cgm[1].x & mm, cgm[1].y & mm, cgm[1].z & mm, cgm[1].w & mm};
        const unsigned ucc[8] = {cgc[0].x, cgc[0].y, cgc[0].z, cgc[0].w, cgc[1].x, cgc[1].y, cgc[1].z, cgc[1].w};
        const unsigned ucp[8] = {cgp[0].x & mp, cgp[0].y & mp, cgp[0].z & mp, cgp[0].w & mp, cgp[1].x & mp, cgp[1].y & mp, cgp[1].z & mp, cgp[1].w & mp};
        const unsigned uxm[8] = {xam[0].x, xam[0].y, xam[0].z, xam[0].w, xam[1].x, xam[1].y, xam[1].z, xam[1].w};
        const unsigned uxc[8] = {xac[0].x, xac[0].y, xac[0].z, xac[0].w, xac[1].x, xac[1].y, xac[1].z, xac[1].w};
        const unsigned uxp[8] = {xap[0].x, xap[0].y, xap[0].z, xap[0].w, xap[1].x, xap[1].y, xap[1].z, xap[1].w};
        const float* w0 = cwa + part * 16; const float* w1 = w0 + 128; const float* w2 = w0 + 256;
        unsigned o[8];
#pragma unroll
        for (int e = 0; e < 8; ++e) {
          float a0 = w0[2 * e] * bflo(ucm[e]) * bflo(uxm[e]) + w1[2 * e] * bflo(ucc[e]) * bflo(uxc[e]) + w2[2 * e] * bflo(ucp[e]) * bflo(uxp[e]);
          float a1 = w0[2 * e + 1] * bfhi(ucm[e]) * bfhi(uxm[e]) + w1[2 * e + 1] * bfhi(ucc[e]) * bfhi(uxc[e]) + w2[2 * e + 1] * bfhi(ucp[e]) * bfhi(uxp[e]);
          o[e] = pack2(bflo(ubg[e]) * a0, bfhi(ubg[e]) * a1);
        }
        bf16_t* yd = y + rowc * 1024 + ch0;
        *(uint4*)yd = make_uint4(o[0], o[1], o[2], o[3]);
        *(uint4*)(yd + 8) = make_uint4(o[4], o[5], o[6], o[7]);
      }
    }
    if (wv < 2) {
      const int dir = wv;
      const float g_ = -expf(p.ev_a_log[4 * dir + hh]) * softplusf(pre_a + p.ev_dt_bias[4 * dir + hh]);
      const float be = sigmoidf(pre_b);
      float ps = g_;
#pragma unroll
      for (int o = 1; o < 64; o <<= 1) {
        const float u = __shfl_up(ps, o), d = __shfl_down(ps, o);
        const float add = dir ? ((lane + o < 64) ? d : 0.f) : ((lane >= o) ? u : 0.f);
        ps += add;
      }
      sc[64 * dir + lane] = ps; sc[128 + 64 * dir + lane] = be;
      sc[256 + 64 * dir + lane] = be * __expf(ps);
      const float last = __shfl(ps, dir ? 0 : 63);
      float* scg = (float*)(p.ws + OFF_SC) + (size_t)(item * 2 + dir) * 256;
      scg[lane] = scale * __expf(ps);
      scg[64 + lane] = __expf(last - ps);
      if (lane == 0) scg[128] = __expf(last);
    }
    __syncthreads();
    {
      const int which = wv >> 2, mt = (wv >> 1) & 1, nt = wv & 1;
      const bf16_t* Asrc = which ? qn : kn;
      f32x16 acc;
#pragma unroll
      for (int e = 0; e < 16; ++e) acc[e] = 0.f;
#pragma unroll
      for (int kk = 0; kk < 8; ++kk) {
        bf16x8 a = *(const bf16x8*)(Asrc + (mt * 32 + r) * 136 + (2 * kk + h2) * 8);
        bf16x8 bb = *(const bf16x8*)(kn + (nt * 32 + r) * 136 + (2 * kk + h2) * 8);
        acc = MFMA32(a, bb, acc);
      }
      float* dstm = which ? QKs : KKs;
#pragma unroll
      for (int e = 0; e < 16; ++e) dstm[(mt * 32 + crow32(e, h2)) * 65 + nt * 32 + r] = acc[e];
    }
    __syncthreads();
    {
      bf16_t* qg = (bf16_t*)(p.ws + OFF_QN) + (size_t)item * 8192;
#pragma unroll
      for (int e = 0; e < 2; ++e) {
        int c = t + e * NT, row = c >> 4, cc = c & 15;
        *(uint4*)(qg + row * 128 + cc * 8) = *(const uint4*)(qn + row * 136 + cc * 8);
      }
      bf16_t* kg = (bf16_t*)(p.ws + OFF_KT) + (size_t)item * 8192;
      const int d = t >> 2, jg = t & 3;
      unsigned o[8];
#pragma unroll
      for (int e = 0; e < 8; ++e) {
        unsigned lo = kn[(jg * 16 + 2 * e) * 136 + d], hi = kn[(jg * 16 + 2 * e + 1) * 136 + d];
        o[e] = lo | (hi << 16);
      }
      *(uint4*)(kg + d * 64 + jg * 16) = make_uint4(o[0], o[1], o[2], o[3]);
      *(uint4*)(kg + d * 64 + jg * 16 + 8) = make_uint4(o[4], o[5], o[6], o[7]);
    }
    {
      bf16_t* inf_ = (bf16_t*)(p.ws + OFF_INTRA) + (size_t)(item * 2) * 4096;
      bf16_t* inb_ = inf_ + 4096;
      const int i = t >> 3, j8 = (t & 7) * 8;
      const float dfi = decf[i], dbi = decb[i], bfi = betaf[i], bbi = betab[i];
      float af_[8], ab_[8], if_[8], ib_[8];
#pragma unroll
      for (int e = 0; e < 8; ++e) {
        const int j = j8 + e;
        float kk = KKs[i * 65 + j], qk = QKs[i * 65 + j];
        float ef = __expf(fminf(dfi - decf[j], 0.f)), eb = __expf(fminf(dbi - decb[j], 0.f));
        af_[e] = (i > j) ? bfi * kk * ef : 0.f;
        ab_[e] = (i < j) ? bbi * kk * eb : 0.f;
        if_[e] = (i >= j) ? scale * qk * ef : 0.f;
        ib_[e] = (i <= j) ? scale * qk * eb : 0.f;
      }
      *(float4*)(Af + i * 68 + j8) = make_float4(af_[0], af_[1], af_[2], af_[3]);
      *(float4*)(Af + i * 68 + j8 + 4) = make_float4(af_[4], af_[5], af_[6], af_[7]);
      *(float4*)(Ab + i * 68 + j8) = make_float4(ab_[0], ab_[1], ab_[2], ab_[3]);
      *(float4*)(Ab + i * 68 + j8 + 4) = make_float4(ab_[4], ab_[5], ab_[6], ab_[7]);
      *(uint4*)(inf_ + i * 64 + j8) = make_uint4(pack2(if_[0], if_[1]), pack2(if_[2], if_[3]), pack2(if_[4], if_[5]), pack2(if_[6], if_[7]));
      *(uint4*)(inb_ + i * 64 + j8) = make_uint4(pack2(ib_[0], ib_[1]), pack2(ib_[2], ib_[3]), pack2(ib_[4], ib_[5]), pack2(ib_[6], ib_[7]));
    }
    __syncthreads();
    if (wv == 0) tri_diag_wave<false>(Af, T32f, lane);
    else if (wv == 1) tri_diag_wave<true>(Ab, T32b, lane);
    __syncthreads();
    if (wv < 6) { if (wv & 1) tri_block_wave<true, 1>(Ab, T32b, lane, wv >> 1); else tri_block_wave<false, 1>(Af, T32f, lane, wv >> 1); }
    __syncthreads();
    if (wv < 4) { if (wv & 1) tri_block_wave<true, 2>(Ab, T32b, lane, wv >> 1); else tri_block_wave<false, 2>(Af, T32f, lane, wv >> 1); }
    __syncthreads();
    if (wv < 2) { if (wv & 1) tri_block_wave<true, 3>(Ab, T32b, lane, 0); else tri_block_wave<false, 3>(Af, T32f, lane, 0); }
    __syncthreads();
#pragma unroll
    for (int e = 0; e < 8; ++e) {
      int idx = t + e * NT, i = idx >> 6, j = idx & 63;
      Tf[i * 72 + j] = f2bf(((i >> 4) >= (j >> 4)) ? T32f[i * 65 + j] : 0.f);
      Tb[i * 72 + j] = f2bf(((i >> 4) <= (j >> 4)) ? T32b[i * 65 + j] : 0.f);
    }
    __syncthreads();
#pragma unroll 1
    for (int dir = 0; dir < 2; ++dir) {
      const float* ck = dir ? ckb : ckf;
      const float* be = dir ? betab : betaf;
      {
        const int d = t >> 2, jg = t & 3;
        unsigned ok[8], ov[8];
#pragma unroll
        for (int e = 0; e < 8; ++e) {
          int j0 = jg * 16 + 2 * e, j1 = j0 + 1;
          ok[e] = pack2(bf2f(kn[j0 * 136 + d]) * ck[j0], bf2f(kn[j1 * 136 + d]) * ck[j1]);
          ov[e] = pack2(bf2f(vn[j0 * 136 + d]) * be[j0], bf2f(vn[j1 * 136 + d]) * be[j1]);
        }
        *(uint4*)(kbdT + d * 72 + jg * 16) = make_uint4(ok[0], ok[1], ok[2], ok[3]);
        *(uint4*)(kbdT + d * 72 + jg * 16 + 8) = make_uint4(ok[4], ok[5], ok[6], ok[7]);
        *(uint4*)(vbT + d * 72 + jg * 16) = make_uint4(ov[0], ov[1], ov[2], ov[3]);
        *(uint4*)(vbT + d * 72 + jg * 16 + 8) = make_uint4(ov[4], ov[5], ov[6], ov[7]);
      }
      __syncthreads();
      {
        const bf16_t* T = dir ? Tb : Tf;
        const int mt = wv >> 2, nt = wv & 3;
        f32x16 aw, au;
#pragma unroll
        for (int e = 0; e < 16; ++e) { aw[e] = 0.f; au[e] = 0.f; }
#pragma unroll
        for (int kk = 0; kk < 4; ++kk) {
          bf16x8 a = *(const bf16x8*)(T + (mt * 32 + r) * 72 + (2 * kk + h2) * 8);
          bf16x8 bk = *(const bf16x8*)(kbdT + (nt * 32 + r) * 72 + (2 * kk + h2) * 8);
          bf16x8 bv = *(const bf16x8*)(vbT + (nt * 32 + r) * 72 + (2 * kk + h2) * 8);
          aw = MFMA32(bk, a, aw);
          au = MFMA32(a, bv, au);
        }
        bf16_t* wg = (bf16_t*)(p.ws + OFF_W) + (size_t)(item * 2 + dir) * 8192;
        bf16_t* ug = (bf16_t*)(p.ws + OFF_UT) + (size_t)(item * 2 + dir) * 8192;
#pragma unroll
        for (int g = 0; g < 4; ++g) {
          uint2 o;
          o.x = pack2(aw[4 * g], aw[4 * g + 1]);
          o.y = pack2(aw[4 * g + 2], aw[4 * g + 3]);
          *(uint2*)(wg + (mt * 32 + r) * 128 + nt * 32 + 8 * g + 4 * h2) = o;
          o.x = pack2(au[4 * g], au[4 * g + 1]);
          o.y = pack2(au[4 * g + 2], au[4 * g + 3]);
          *(uint2*)(ug + (nt * 32 + r) * 64 + mt * 32 + 8 * g + 4 * h2) = o;
        }
      }
      __syncthreads();
    }
  }
}

DI void phase_g2(const Params& p, char* smem, const int wave_) {
  int t = TIDX;
  asm volatile("" : "+v"(t));
  const int lane = t & 63, wv = t >> 6, l15 = lane & 15, lg = lane >> 4;
  bf16_t* wS = (bf16_t*)smem;
  bf16_t* qS = wS + 64 * 136;
  bf16_t* kTS = qS + 64 * 136;
  bf16_t* inS = kTS + 128 * 72;
  bf16_t* Sbf = inS + 64 * 72;
  bf16_t* vnT = Sbf + 2 * 32 * 136;
  bf16_t* veT = vnT + 32 * 72;
  const int mt = wv >> 1, nt = wv & 1;

  for (int cbase = 0; cbase < 256; cbase += gridDim.x) {
    const int chain = xcd_item(cbase);
    if (chain >= 256) continue;
    const int b = chain >> 5, hh = (chain >> 3) & 3, dir = (chain >> 2) & 1, dvq = chain & 3;
    bf16_t* og = (bf16_t*)((char*)p.out + (dir ? DO_OB : DO_OF));
    __syncthreads();
    f32x4 Sacc[2];
#pragma unroll
    for (int n = 0; n < 2; ++n)
#pragma unroll
      for (int e = 0; e < 4; ++e) Sacc[n][e] = 0.f;
    for (int i = t; i < 32 * 136; i += NT) Sbf[i] = 0;
    int cur = 0;
    auto gc_of = [&](int n) { return dir == 0 ? n : (n < 4 ? 3 - n : 71 - n); };
    auto item_of = [&](int n) { return (b * 4 + hh) * NCH + gc_of(n); };
    uint4 rw0A, rw1A, rq0A, rq1A, rk0A, rk1A, riA, rw0B, rw1B, rq0B, rq1B, rk0B, rk1B, riB;
    uint2 ruA, ruB; float4 rs4A, re4A, rs4B, re4B; float rlastA, rlastB;
#define G2_LOAD_W(n_, S) { \
      const bf16_t* wg_ = (const bf16_t*)(p.ws + OFF_W) + (size_t)(item_of(n_) * 2 + dir) * 8192; \
      rw0##S = *(const uint4*)(wg_ + (size_t)t * 8); rw1##S = *(const uint4*)(wg_ + (size_t)(t + NT) * 8); }
#define G2_STORE_W(S) { \
      *(uint4*)(wS + (t >> 4) * 136 + (t & 15) * 8) = rw0##S; \
      *(uint4*)(wS + ((t + NT) >> 4) * 136 + (t & 15) * 8) = rw1##S; }
#define G2_LOAD_REST(n_, S) { \
      const int it_ = item_of(n_); \
      const bf16_t* qg_ = (const bf16_t*)(p.ws + OFF_QN) + (size_t)it_ * 8192; \
      const bf16_t* kg_ = (const bf16_t*)(p.ws + OFF_KT) + (size_t)it_ * 8192; \
      const bf16_t* ig_ = (const bf16_t*)(p.ws + OFF_INTRA) + (size_t)(it_ * 2 + dir) * 4096; \
      const bf16_t* ug_ = (const bf16_t*)(p.ws + OFF_UT) + (size_t)(it_ * 2 + dir) * 8192; \
      const float* scg_ = (const float*)(p.ws + OFF_SC) + (size_t)(it_ * 2 + dir) * 256; \
      rq0##S = *(const uint4*)(qg_ + (size_t)t * 8); rq1##S = *(const uint4*)(qg_ + (size_t)(t + NT) * 8); \
      rk0##S = *(const uint4*)(kg_ + (size_t)t * 8); rk1##S = *(const uint4*)(kg_ + (size_t)(t + NT) * 8); \
      ri##S = *(const uint4*)(ig_ + (size_t)t * 8); \
      ru##S = *(const uint2*)(ug_ + (dvq * 32 + nt * 16 + l15) * 64 + mt * 16 + 4 * lg); \
      rs4##S = *(const float4*)(scg_ + mt * 16 + 4 * lg); \
      re4##S = *(const float4*)(scg_ + 64 + mt * 16 + 4 * lg); \
      rlast##S = scg_[128]; }
#define G2_STORE_REST(S) { \
      *(uint4*)(qS + (t >> 4) * 136 + (t & 15) * 8) = rq0##S; \
      *(uint4*)(qS + ((t + NT) >> 4) * 136 + (t & 15) * 8) = rq1##S; \
      *(uint4*)(kTS + (t >> 3) * 72 + (t & 7) * 8) = rk0##S; \
      *(uint4*)(kTS + ((t + NT) >> 3) * 72 + (t & 7) * 8) = rk1##S; \
      *(uint4*)(inS + (t >> 3) * 72 + (t & 7) * 8) = ri##S; }
#define G2_STEP(n_, S, T) { \
      const uint2 u_cur = ru##S; const float4 s_cur = rs4##S, e_cur = re4##S; const float last_cur = rlast##S; \
      G2_STORE_REST(S); \
      if ((n_) + 2 < NCH) G2_LOAD_REST((n_) + 2, S); \
      { \
        f32x4 R = {0.f, 0.f, 0.f, 0.f}; \
        const bf16_t* Sb = Sbf + cur * 32 * 136; \
        _Pragma("unroll") for (int kk = 0; kk < 4; ++kk) { \
          bf16x8 a = *(const bf16x8*)(wS + (mt * 16 + l15) * 136 + (4 * kk + lg) * 8); \
          bf16x8 bb = *(const bf16x8*)(Sb + (nt * 16 + l15) * 136 + (4 * kk + lg) * 8); \
          R = MFMA16(a, bb, R); \
        } \
        float v0 = bflo(u_cur.x) - R[0], v1 = bfhi(u_cur.x) - R[1], v2 = bflo(u_cur.y) - R[2], v3 = bfhi(u_cur.y) - R[3]; \
        uint2 o, oe; \
        o.x = pack2(v0, v1); o.y = pack2(v2, v3); \
        oe.x = pack2(v0 * e_cur.x, v1 * e_cur.y); oe.y = pack2(v2 * e_cur.z, v3 * e_cur.w); \
        *(uint2*)(vnT + (nt * 16 + l15) * 72 + mt * 16 + 4 * lg) = o; \
        *(uint2*)(veT + (nt * 16 + l15) * 72 + mt * 16 + 4 * lg) = oe; \
      } \
      __syncthreads(); \
      { \
        const bf16_t* Sb = Sbf + cur * 32 * 136; \
        f32x4 O = {0.f, 0.f, 0.f, 0.f}; \
        _Pragma("unroll") for (int kk = 0; kk < 4; ++kk) { \
          bf16x8 a = *(const bf16x8*)(qS + (mt * 16 + l15) * 136 + (4 * kk + lg) * 8); \
          bf16x8 bb = *(const bf16x8*)(Sb + (nt * 16 + l15) * 136 + (4 * kk + lg) * 8); \
          O = MFMA16(a, bb, O); \
        } \
        O[0] *= s_cur.x; O[1] *= s_cur.y; O[2] *= s_cur.z; O[3] *= s_cur.w; \
        _Pragma("unroll") for (int kk = 0; kk < 2; ++kk) { \
          bf16x8 a = *(const bf16x8*)(inS + (mt * 16 + l15) * 72 + (4 * kk + lg) * 8); \
          bf16x8 bb = *(const bf16x8*)(vnT + (nt * 16 + l15) * 72 + (4 * kk + lg) * 8); \
          O = MFMA16(a, bb, O); \
        } \
        const int row0 = item_row0(b, gc_of(n_)); \
        _Pragma("unroll") for (int e = 0; e < 4; ++e) \
          og[(size_t)(row0 + mt * 16 + 4 * lg + e) * 512 + hh * 128 + dvq * 32 + nt * 16 + l15] = f2bf(O[e]); \
        bf16_t* Sn = Sbf + (cur ^ 1) * 32 * 136; \
        _Pragma("unroll") for (int n2 = 0; n2 < 2; ++n2) { \
          f32x4 sa = Sacc[n2]; \
          sa[0] *= last_cur; sa[1] *= last_cur; sa[2] *= last_cur; sa[3] *= last_cur; \
          _Pragma("unroll") for (int kk = 0; kk < 2; ++kk) { \
            bf16x8 a = *(const bf16x8*)(kTS + (wv * 16 + l15) * 72 + (4 * kk + lg) * 8); \
            bf16x8 bb = *(const bf16x8*)(veT + (n2 * 16 + l15) * 72 + (4 * kk + lg) * 8); \
            sa = MFMA16(a, bb, sa); \
          } \
          Sacc[n2] = sa; \
          uint2 o; \
          o.x = pack2(sa[0], sa[1]); o.y = pack2(sa[2], sa[3]); \
          *(uint2*)(Sn + (n2 * 16 + l15) * 136 + wv * 16 + 4 * lg) = o; \
        } \
      } \
      if ((n_) + 1 < NCH) G2_STORE_W(T); \
      if ((n_) + 3 < NCH) G2_LOAD_W((n_) + 3, T); \
      __syncthreads(); \
      cur ^= 1; }
    G2_LOAD_W(0, A); G2_STORE_W(A);
    G2_LOAD_REST(0, A);
    G2_LOAD_W(1, B); G2_LOAD_REST(1, B);
    G2_LOAD_W(2, A);
    __syncthreads();
#pragma unroll 1
    for (int n = 0; n < NCH; n += 2) {
      G2_STEP(n, A, B)
      G2_STEP(n + 1, B, A)
    }
#undef G2_STEP
  }
}

DI void phase_yb(const Params& p, const int wave_) {
  const int t = TIDX, lane = t & 63, wv = t >> 6;
  const bf16_t* of = (const bf16_t*)((const char*)p.out + DO_OF);
  const bf16_t* ob = (const bf16_t*)((const char*)p.out + DO_OB);
  const bf16_t* z = (const bf16_t*)(p.ws + OFF_Z);
  bf16_t* y = (bf16_t*)(p.ws + OFF_HBUF);
  for (int row = blockIdx.x * 8 + wv; row < TT; row += gridDim.x * 8) {
    uint4 a = *(const uint4*)(of + (size_t)row * 512 + lane * 8);
    uint4 b = *(const uint4*)(ob + (size_t)row * 512 + lane * 8);
    uint4 zz = *(const uint4*)(z + (size_t)row * 512 + lane * 8);
    const unsigned *ua = (const unsigned*)&a, *ub = (const unsigned*)&b, *uz = (const unsigned*)&zz;
    float o[8], ss = 0.f;
#pragma unroll
    for (int e = 0; e < 4; ++e) {
      o[2 * e] = bflo(ua[e]) + bflo(ub[e]);
      o[2 * e + 1] = bfhi(ua[e]) + bfhi(ub[e]);
      ss += o[2 * e] * o[2 * e] + o[2 * e + 1] * o[2 * e + 1];
    }
    ss += __shfl_xor(ss, 1); ss += __shfl_xor(ss, 2); ss += __shfl_xor(ss, 4); ss += __shfl_xor(ss, 8);
    float rr = rsqrtf(ss * (1.f / 128.f) + EPS);
    const float* gn = p.ev_o_norm + (lane & 15) * 8;
    unsigned oo[4];
#pragma unroll
    for (int e = 0; e < 4; ++e) {
      float z0 = bflo(uz[e]), z1 = bfhi(uz[e]);
      oo[e] = pack2(o[2 * e] * rr * gn[2 * e] * siluf(z0), o[2 * e + 1] * rr * gn[2 * e + 1] * siluf(z1));
    }
    *(uint4*)(y + (size_t)row * 1024 + 512 + lane * 8) = make_uint4(oo[0], oo[1], oo[2], oo[3]);
  }
}

DI void phase_outproj(const Params& p, char* smem, int layer, const int wave_) {
  const bf16_t* A = (const bf16_t*)(p.ws + OFF_HBUF);
  const bf16_t* Bt = (const bf16_t*)(p.ws + (layer ? OFF_WT_OUT1 : OFF_WT_OUT0));
  const float* mod = (const float*)(p.ws + OFF_MOD) + (size_t)layer * 9 * 6144;
  float* ctxbuf = (float*)(p.ws + OFF_CTXBUF);
  const int ntm = (layer ? TX : TT) / 256, ntn = 4;
  for (int tbase = 0; tbase < ntm * ntn; tbase += gridDim.x) {
    const int tile = xcd_item(tbase);
    if (tile >= ntm * ntn) continue;
    const int tm = tile / ntn, tn = tile % ntn;
    const int m0 = tm * 256, n0 = tn * 256;
    const int mb = row_mb(m0);
    const float* g = mod + (size_t)mb * 6144 + 2 * 1024;
    acc256_t acc;
    gemm256<3>(A + (size_t)m0 * D, D, Bt + (size_t)n0 * D, D, D, smem, wave_, acc);
    int t = TIDX; asm volatile("" : "+v"(t));
    const int lane = t & 63, wid = t >> 6, wr = wid >> 2, wc = wid & 3, fr = lane & 15, fq = lane >> 4;
    const bool isx = m0 < TX;
    const float* resb = layer ? p.out : (isx ? p.x : p.ctx - (size_t)TX * D);
    float* outb = isx ? p.out : ctxbuf - (size_t)TX * D;
    const float* csc = mod + (size_t)mb * 6144 + 4 * 1024;
    const float* gn2 = p.norm2 + layer * 1024;
    bf16_t* apr = (bf16_t*)(p.ws + OFF_Q);
    float ssl[2][4];
#pragma unroll
    for (int ai = 0; ai < 2; ++ai)
#pragma unroll
      for (int m = 0; m < 4; ++m) ssl[ai][m] = 0.f;
#pragma unroll
    for (int bj = 0; bj < 2; ++bj) {
      const int col = n0 + bj * 128 + wc * 32 + fq * 4;
      const float4 gg0 = *(const float4*)(g + col), gg1 = *(const float4*)(g + col + 16);
      const float4 ca = *(const float4*)(csc + col), cb = *(const float4*)(csc + col + 16);
      const float4 na = *(const float4*)(gn2 + col), nb = *(const float4*)(gn2 + col + 16);
      const f32x4 cc0 = {na.x * (1.f + ca.x), na.y * (1.f + ca.y), na.z * (1.f + ca.z), na.w * (1.f + ca.w)};
      const f32x4 cc1 = {nb.x * (1.f + cb.x), nb.y * (1.f + cb.y), nb.z * (1.f + cb.z), nb.w * (1.f + cb.w)};
#pragma unroll
      for (int ai = 0; ai < 2; ++ai)
#pragma unroll
        for (int m = 0; m < 4; ++m) {
          const size_t rowoff = (size_t)(m0 + ai * 128 + wr * 64 + m * 16 + fr) * D;
          const float4 r0_ = *(const float4*)(resb + rowoff + col), r1_ = *(const float4*)(resb + rowoff + col + 16);
          const f32x4 v0 = acc[ai][bj][m][0], v1 = acc[ai][bj][m][1];
          const f32x4 x0 = {r0_.x + gg0.x * v0[0], r0_.y + gg0.y * v0[1], r0_.z + gg0.z * v0[2], r0_.w + gg0.w * v0[3]};
          const f32x4 x1 = {r1_.x + gg1.x * v1[0], r1_.y + gg1.y * v1[1], r1_.z + gg1.z * v1[2], r1_.w + gg1.w * v1[3]};
          *(float4*)(outb + rowoff + col) = make_float4(x0[0], x0[1], x0[2], x0[3]);
          *(float4*)(outb + rowoff + col + 16) = make_float4(x1[0], x1[1], x1[2], x1[3]);
          ssl[ai][m] += x0[0] * x0[0] + x0[1] * x0[1] + x0[2] * x0[2] + x0[3] * x0[3] + x1[0] * x1[0] + x1[1] * x1[1] + x1[2] * x1[2] + x1[3] * x1[3];
          store_bf16x8_pair(apr + rowoff + n0 + bj * 128 + wc * 32, x0 * cc0, x1 * cc1, fq);
        }
    }
    float* red = (float*)(smem + G8_LDS);
#pragma unroll
    for (int ai = 0; ai < 2; ++ai)
#pragma unroll
      for (int m = 0; m < 4; ++m) {
        float ss = ssl[ai][m];
        ss += __shfl_xor(ss, 16);
        ss += __shfl_xor(ss, 32);
        if (fq == 0) red[(ai * 128 + wr * 64 + m * 16 + fr) * 4 + wc] = ss;
      }
    __syncthreads();
    if (t < 256) {
      const float4 v = *(const float4*)(red + t * 4);
      ((float*)(p.ws + OFF_SSQ2))[(size_t)(m0 + t) * 4 + tn] = (v.x + v.y) + (v.z + v.w);
    }
  }
}

DI unsigned f2ord(float f) { unsigned u = __float_as_uint(f); return (u & 0x80000000u) ? ~u : (u | 0x80000000u); }
DI float ord2f(unsigned u) { return __uint_as_float((u & 0x80000000u) ? (u & 0x7fffffffu) : ~u); }
#define CE_DESC(a, b) { unsigned mx_ = max(a, b), mn_ = min(a, b); a = mx_; b = mn_; }

DI void bitonic_merge16(unsigned (&v)[16]) {
#pragma unroll
  for (int j = 8; j > 0; j >>= 1)
#pragma unroll
    for (int i = 0; i < 16; ++i)
      if ((i & j) == 0) CE_DESC(v[i], v[i | j]);
}
DI void sort16_desc(unsigned (&v)[16]) {
#define S_(i, j) CE_DESC(v[i], v[j]);
  S_(0, 13) S_(1, 12) S_(2, 15) S_(3, 14) S_(4, 8) S_(5, 6) S_(7, 11) S_(9, 10)
  S_(0, 5) S_(1, 7) S_(2, 9) S_(3, 4) S_(6, 13) S_(8, 14) S_(10, 15) S_(11, 12)
  S_(0, 1) S_(2, 3) S_(4, 5) S_(6, 8) S_(7, 9) S_(10, 11) S_(12, 13) S_(14, 15)
  S_(0, 2) S_(1, 3) S_(4, 10) S_(5, 11) S_(6, 7) S_(8, 9) S_(12, 14) S_(13, 15)
  S_(1, 2) S_(3, 12) S_(4, 6) S_(5, 7) S_(8, 10) S_(9, 11) S_(13, 14)
  S_(1, 4) S_(2, 6) S_(5, 8) S_(7, 10) S_(9, 13) S_(11, 14)
  S_(2, 4) S_(3, 6) S_(9, 12) S_(11, 13)
  S_(3, 5) S_(6, 8) S_(7, 9) S_(10, 12)
  S_(3, 4) S_(5, 6) S_(7, 8) S_(9, 10) S_(11, 12)
  S_(6, 7) S_(8, 9)
#undef S_
}
DI void merge_top16(unsigned (&a)[16], const unsigned (&b)[16]) {
#pragma unroll
  for (int i = 0; i < 16; ++i) a[i] = max(a[i], b[15 - i]);
  bitonic_merge16(a);
}
DI void top16_of_64(unsigned (&g0)[16], unsigned (&g1)[16], unsigned (&g2)[16], unsigned (&g3)[16]) {
  sort16_desc(g0); sort16_desc(g1); sort16_desc(g2); sort16_desc(g3);
  merge_top16(g0, g1);
  merge_top16(g2, g3);
  merge_top16(g0, g2);
}
DI void top16set_of_64(unsigned (&g0)[16], unsigned (&g1)[16], unsigned (&g2)[16], unsigned (&g3)[16]) {
  sort16_desc(g0); sort16_desc(g1); sort16_desc(g2); sort16_desc(g3);
  merge_top16(g0, g1);
  merge_top16(g2, g3);
#pragma unroll
  for (int i = 0; i < 16; ++i) g0[i] = max(g0[i], g2[15 - i]);
}


__constant__ unsigned char CAND_AB[64] = {
    0x00, 0x01, 0x02, 0x03, 0x04, 0x05, 0x06, 0x07, 0x08, 0x09, 0x0A, 0x0B, 0x0C, 0x0D, 0x0E, 0x0F,
    0x10, 0x11, 0x12, 0x13, 0x14, 0x15, 0x16, 0x17,
    0x20, 0x21, 0x22, 0x23, 0x24,
    0x30, 0x31, 0x32, 0x33,
    0x40, 0x41, 0x42,
    0x50, 0x51, 0x60, 0x61, 0x70, 0x71,
    0x80, 0x90, 0xA0, 0xB0, 0xC0, 0xD0, 0xE0, 0xF0,
    0, 0, 0, 0, 0, 0, 0, 0, 0, 0, 0, 0, 0, 0};
constexpr int cand_index(int a, int b) {
  int c = 0;
  for (int aa = 0; aa < 16; ++aa)
    for (int bb = 0; bb < 16; ++bb) {
      if (aa == a && bb == b) return c;
      if ((aa + 1) * (bb + 1) <= 16) ++c;
    }
  return c;
}

constexpr int cand_ab(int ci) {
  int c = 0;
  for (int aa = 0; aa < 16; ++aa)
    for (int bb = 0; bb < 16; ++bb)
      if ((aa + 1) * (bb + 1) <= 16) { if (c == ci) return (aa << 4) | bb; ++c; }
  return 0;
}
template <int S>
DI unsigned cand_key(const float (&v1)[16], const float (&v2)[16], int h) {
  constexpr int abA = cand_ab(2 * S), abB = cand_ab(2 * S + 1);
  const float sA = v1[abA >> 4] + v2[abA & 15], sB = v1[abB >> 4] + v2[abB & 15];
  return (f2ord(h ? sB : sA) & ~63u) | (unsigned)(2 * S) | (unsigned)h;
}

DI void phase_peerq(const Params& p, char* smem, int layer, const int wave_) {
  const int tid0 = TIDX;
  const bf16_t* A = (const bf16_t*)(p.ws + OFF_Q);
  const bf16_t* Bt = (const bf16_t*)(p.ws + OFF_WT_PQ) + (size_t)layer * 1024 * 1024;
  const bf16_t* keys = (const bf16_t*)(p.ws + OFF_KEYS) + (size_t)layer * 8 * 2 * 128 * 64;
  int* seli = (int*)(p.ws + OFF_SELI);
  float* selg = (float*)(p.ws + OFF_SELG);
  float* selu = (float*)(p.ws + OFF_SELU);
  const float* tsc = (const float*)(p.ws + (layer ? OFF_TSC1 : OFF_TSC));
  bf16_t* qs = (bf16_t*)smem;
  unsigned char* isc = (unsigned char*)(smem + 135168);
  const int ntm = (layer ? TX : TT) / 256;
  for (int tbase = 0; tbase < ntm * 4; tbase += gridDim.x) {
    const int tile = xcd_item(tbase);
    if (tile >= ntm * 4) continue;
    const int tm = tile >> 2, tn = tile & 3;
    const int m0 = tm * 256, n0 = tn * 256;
    {
      acc256_t acc;
      gemm256<3>(A + (size_t)m0 * D, D, Bt + (size_t)n0 * D, D, D, smem, wave_, acc);
      int t = tid0; asm volatile("" : "+v"(t));
      const int lane = t & 63, wid = t >> 6, wr = wid >> 2, wc = wid & 3, fr = lane & 15, fq = lane >> 4;
      const float* pqb = (const float*)(p.ws + OFF_PQB) + (size_t)(layer * 9 + row_mb(m0)) * 1024 + n0 + wc * 32 + fq * 4;
      float4 bias[2][2];
#pragma unroll
      for (int bj = 0; bj < 2; ++bj)
#pragma unroll
        for (int n = 0; n < 2; ++n) bias[bj][n] = *(const float4*)(pqb + bj * 128 + n * 16);
#pragma unroll
      for (int ai = 0; ai < 2; ++ai)
#pragma unroll
        for (int m = 0; m < 4; ++m) {
          const int rl = ai * 128 + wr * 64 + m * 16 + fr;
          const float4 sq = *(const float4*)((const float*)(p.ws + OFF_SSQ2) + (size_t)(m0 + rl) * 4);
          const float rr = rsqrtf(((sq.x + sq.y) + (sq.z + sq.w)) * (1.f / 1024.f) + EPS);
          bf16_t* qd = qs + rl * 264 + wc * 32 + fq * 4;
#pragma unroll
          for (int bj = 0; bj < 2; ++bj)
#pragma unroll
            for (int n = 0; n < 2; ++n) {
              const f32x4 v = acc[ai][bj][m][n];
              const float4 bb = bias[bj][n];
              *(uint2*)(qd + bj * 128 + n * 16) = make_uint2(pack2(v[0] * rr + bb.x, v[1] * rr + bb.y), pack2(v[2] * rr + bb.z, v[3] * rr + bb.w));
            }
        }
    }
    __syncthreads();
#pragma unroll 1
    for (int hb = 0; hb < 2; ++hb) {
    int t = tid0;
    asm volatile("" : "+v"(t));
    const int lane = t & 63, wv = t >> 6, r = lane & 31, h = lane >> 5;
    const int hd = tn * 2 + hb;
    unsigned top0[16], top1[16];
#pragma unroll
    for (int half = 0; half < 2; ++half) {
      f32x16 acc[4];
#pragma unroll
      for (int m = 0; m < 4; ++m)
#pragma unroll
        for (int e = 0; e < 16; ++e) acc[m][e] = 0.f;
      const bf16_t* kb = keys + (size_t)((hd * 2 + half) * 128) * 64;
#pragma unroll
      for (int kk = 0; kk < 4; ++kk) {
        bf16x8 bq = *(const bf16x8*)(qs + (wv * 32 + r) * 264 + hb * 128 + half * 64 + 16 * kk + 8 * h);
#pragma unroll
        for (int m = 0; m < 4; ++m) {
          bf16x8 ak = *(const bf16x8*)(kb + (m * 32 + r) * 64 + 16 * kk + 8 * h);
          acc[m] = MFMA32(ak, bq, acc[m]);
        }
      }
      unsigned g0[16], g1[16], g2[16], g3[16];
#pragma unroll
      for (int e = 0; e < 16; ++e) {
        g0[e] = (f2ord(acc[0][e]) & ~127u) | (unsigned)(0 + crow32(e, h));
        g1[e] = (f2ord(acc[1][e]) & ~127u) | (unsigned)(32 + crow32(e, h));
        g2[e] = (f2ord(acc[2][e]) & ~127u) | (unsigned)(64 + crow32(e, h));
        g3[e] = (f2ord(acc[3][e]) & ~127u) | (unsigned)(96 + crow32(e, h));
      }
      top16_of_64(g0, g1, g2, g3);
      unsigned pp[16];
#pragma unroll
      for (int i = 0; i < 16; ++i) pp[i] = __shfl_xor(g0[i], 32);
      merge_top16(g0, pp);
      if (half == 0) {
#pragma unroll
        for (int i = 0; i < 16; ++i) top0[i] = g0[i];
      } else {
#pragma unroll
        for (int i = 0; i < 16; ++i) top1[i] = g0[i];
      }
    }
#pragma unroll
    for (int i = 0; i < 16; ++i) {
      isc[t * 32 + i] = (unsigned char)(top0[i] & 127u);
      isc[t * 32 + 16 + i] = (unsigned char)(top1[i] & 127u);
    }
    float v1[16], v2[16];
#pragma unroll
    for (int i = 0; i < 16; ++i) { v1[i] = ord2f(top0[i] & ~127u); v2[i] = ord2f(top1[i] & ~127u); }
    unsigned c0[16], c1[16];
    c0[0] = cand_key<0>(v1, v2, h); c0[1] = cand_key<1>(v1, v2, h); c0[2] = cand_key<2>(v1, v2, h); c0[3] = cand_key<3>(v1, v2, h);
    c0[4] = cand_key<4>(v1, v2, h); c0[5] = cand_key<5>(v1, v2, h); c0[6] = cand_key<6>(v1, v2, h); c0[7] = cand_key<7>(v1, v2, h);
    c0[8] = cand_key<8>(v1, v2, h); c0[9] = cand_key<9>(v1, v2, h); c0[10] = cand_key<10>(v1, v2, h); c0[11] = cand_key<11>(v1, v2, h);
    c0[12] = cand_key<12>(v1, v2, h); c0[13] = cand_key<13>(v1, v2, h); c0[14] = cand_key<14>(v1, v2, h); c0[15] = cand_key<15>(v1, v2, h);
    c1[0] = cand_key<16>(v1, v2, h); c1[1] = cand_key<17>(v1, v2, h); c1[2] = cand_key<18>(v1, v2, h); c1[3] = cand_key<19>(v1, v2, h);
    c1[4] = cand_key<20>(v1, v2, h); c1[5] = cand_key<21>(v1, v2, h); c1[6] = cand_key<22>(v1, v2, h); c1[7] = cand_key<23>(v1, v2, h);
    c1[8] = cand_key<24>(v1, v2, h);
#pragma unroll
    for (int i = 9; i < 16; ++i) c1[i] = 0u;
    sort16_desc(c0); sort16_desc(c1);
    merge_top16(c0, c1);
    {
      unsigned pq[16];
#pragma unroll
      for (int i = 0; i < 16; ++i) pq[i] = __shfl_xor(c0[i], 32);
#pragma unroll
      for (int i = 0; i < 16; ++i) c0[i] = max(c0[i], pq[15 - i]);
    }
    unsigned umx = c0[0];
#pragma unroll
    for (int i = 1; i < 16; ++i) umx = max(umx, c0[i]);
    float sc[16], mx = ord2f(umx & ~63u), sum = 0.f;
#pragma unroll
    for (int i = 0; i < 16; ++i) { sc[i] = __expf(ord2f(c0[i] & ~63u) - mx); sum += sc[i]; }
    float inv = 1.f / sum;
    const int row = m0 + wv * 32 + r;
    int* di = seli + ((size_t)row * 8 + hd) * 16 + 8 * h;
    float* dg = selg + ((size_t)row * 8 + hd) * 16 + 8 * h;
    float* du = selu + ((size_t)row * 8 + hd) * 16 + 8 * h;
    int exv[8];
    float uuv[8], ggv[8];
#pragma unroll
    for (int i = 0; i < 8; ++i) {
      const unsigned s_ = c0[i];
      const float g_ = sc[i] * inv;
      unsigned ab = CAND_AB[s_ & 63u];
      int i1 = isc[t * 32 + (ab >> 4)], i2 = isc[t * 32 + 16 + (ab & 15)];
      const int ex = i1 * 128 + i2;
      exv[i] = ex;
      uuv[i] = tsc[ex];
      ggv[i] = g_ * tsc[16384 + ex];
    }
    *(int4*)di = make_int4(exv[0], exv[1], exv[2], exv[3]); *(int4*)(di + 4) = make_int4(exv[4], exv[5], exv[6], exv[7]);
    *(float4*)du = make_float4(uuv[0], uuv[1], uuv[2], uuv[3]); *(float4*)(du + 4) = make_float4(uuv[4], uuv[5], uuv[6], uuv[7]);
    *(float4*)dg = make_float4(ggv[0], ggv[1], ggv[2], ggv[3]); *(float4*)(dg + 4) = make_float4(ggv[4], ggv[5], ggv[6], ggv[7]);
    }
    __syncthreads();
  }
}

DI float gelu_exact(float x) { return 0.5f * x * (1.f + erff(x * 0.7071067811865476f)); }
DI float blendf(float a, float b, unsigned m) {
  unsigned ua = __float_as_uint(a), ub = __float_as_uint(b);
  return __uint_as_float(ua ^ ((ua ^ ub) & m));
}
DI float wave_max(float v) {
#pragma unroll
  for (int o = 32; o > 0; o >>= 1) v = fmaxf(v, __shfl_xor(v, o));
  return v;
}

typedef float f32x32v __attribute__((ext_vector_type(32)));
typedef unsigned u32x6v __attribute__((ext_vector_type(6)));
constexpr int TROW = 768;
constexpr int TVOFF = TROW;
constexpr int TPAIR = 2 * TROW;
DI void convert_tables(const Params& p, int layer, int part, int nparts, const int wave_) {
  const int wv = wave_;
  char* tab = p.ws + (layer ? OFF_TAB1 : OFF_TAB);
  float* tsc = (float*)(p.ws + (layer ? OFF_TSC1 : OFF_TSC));
  for (int pr2 = part * 8 + wv; pr2 < 16384; pr2 += nparts * 8) {
    int lane = TIDX & 63;
    asm volatile("" : "+v"(lane));
    const int l31 = lane & 31, rr = pr2 * 2 + (lane >> 5);
    const float* src = ((rr >> 14) ? p.p_v : p.p_u) + (size_t)layer * 16384 * 1024 + (size_t)(rr & 16383) * 1024 + 32 * l31;
    float v[32];
    float m = 0.f;
#pragma unroll
    for (int j = 0; j < 8; ++j) {
      float4 a = *(const float4*)(src + 4 * j);
      v[4 * j] = a.x; v[4 * j + 1] = a.y; v[4 * j + 2] = a.z; v[4 * j + 3] = a.w;
      m = fmaxf(m, fmaxf(fmaxf(fabsf(a.x), fabsf(a.y)), fmaxf(fabsf(a.z), fabsf(a.w))));
    }
#pragma unroll
    for (int o = 16; o > 0; o >>= 1) m = fmaxf(m, __shfl_xor(m, o));
    const float scale = m > 0.f ? m * (1.f / 7.5f) : 1.f;
    const float inv = 1.f / scale;
    unsigned w[7] = {0u, 0u, 0u, 0u, 0u, 0u, 0u};
#pragma unroll
    for (int i = 0; i < 32; ++i) {
      const float a = fminf(fabsf(v[i]) * inv, 7.5f);
      const float c = a < 2.f ? __builtin_rintf(a * 8.f) : (a < 4.f ? __builtin_rintf(a * 4.f) + 8.f : __builtin_rintf(a * 2.f) + 16.f);
      unsigned code = (unsigned)c;
      code = code > 31u ? 31u : code;
      code |= (__float_as_uint(v[i]) >> 31) << 5;
      const int bit = 6 * i, d = bit >> 5, sh = bit & 31;
      w[d] |= code << sh;
      if (sh > 26) w[d + 1] |= code >> (32 - sh);
    }
    char* dst = tab + (size_t)(rr & 16383) * TPAIR + (rr >> 14) * TROW + l31 * 24;
    *(uint2*)(dst) = make_uint2(w[0], w[1]);
    *(uint2*)(dst + 8) = make_uint2(w[2], w[3]);
    *(uint2*)(dst + 16) = make_uint2(w[4], w[5]);
    if (l31 == 0) tsc[rr] = scale;
  }
}

struct Row6 { uint2 a, b, c; };
DI Row6 row6_load(const __amdgpu_buffer_rsrc_t trs, int voff, int soff) {
  Row6 r;
  typedef unsigned u32x2v __attribute__((ext_vector_type(2)));
  u32x2v x0 = __builtin_amdgcn_raw_buffer_load_b64(trs, voff, soff, 0);
  u32x2v x1 = __builtin_amdgcn_raw_buffer_load_b64(trs, voff + 8, soff, 0);
  u32x2v x2 = __builtin_amdgcn_raw_buffer_load_b64(trs, voff + 16, soff, 0);
  r.a = make_uint2(x0[0], x0[1]); r.b = make_uint2(x1[0], x1[1]); r.c = make_uint2(x2[0], x2[1]);
  return r;
}
typedef __bf16 bf16x32v __attribute__((ext_vector_type(32)));
DI float row6_dot(const Row6& r, const unsigned (&hp)[16]) {
  u32x6v q = {r.a.x, r.a.y, r.b.x, r.b.y, r.c.x, r.c.y};
  const bf16x32v y = __builtin_amdgcn_cvt_scalef32_pk32_bf16_fp6(q, 1.0f);
  float s0 = 0.f, s1 = 0.f;
#pragma unroll
  for (int i = 0; i < 8; ++i) {
    s0 = __builtin_amdgcn_fdot2_f32_bf16(__builtin_bit_cast(bf16x2v, hp[2 * i]), bf16x2v{y[4 * i], y[4 * i + 1]}, s0, false);
    s1 = __builtin_amdgcn_fdot2_f32_bf16(__builtin_bit_cast(bf16x2v, hp[2 * i + 1]), bf16x2v{y[4 * i + 2], y[4 * i + 3]}, s1, false);
  }
  return s0 + s1;
}
DI f32x32v row6_decode(const Row6& r) {
  u32x6v q = {r.a.x, r.a.y, r.b.x, r.b.y, r.c.x, r.c.y};
  return __builtin_amdgcn_cvt_scalef32_pk32_f32_fp6(q, 1.0f);
}
DI int pick_voff(int ids, int k, int half, int l31) {
  const int ea = __builtin_amdgcn_readlane(ids, k & 63), eb = __builtin_amdgcn_readlane(ids, (k + 1) & 63);
  return (half ? eb : ea) * TPAIR + l31 * 24;
}

DI void convert_in_tail(const Params& p, int layer, int ntiles, const int wave_) {
  const int g = gridDim.x, rem = ntiles % g;
  const int pos = (blockIdx.x & 7) * (g >> 3) + (blockIdx.x >> 3);
  if (rem == 0) convert_tables(p, layer, blockIdx.x, g, wave_);
  else if (pos >= rem) convert_tables(p, layer, pos - rem, g - rem, wave_);
}

DI void phase_gather(const Params& p, int layer, const int wave_) {
  const int wv = wave_;
  const float* mod = (const float*)(p.ws + OFF_MOD) + (size_t)layer * 9 * 6144;
  const float* mod1 = (const float*)(p.ws + OFF_MOD) + (size_t)9 * 6144;
  const __amdgpu_buffer_rsrc_t trs = __builtin_amdgcn_make_buffer_rsrc((void*)(p.ws + (layer ? OFF_TAB1 : OFF_TAB)), 0, 16384 * TPAIR, 0x00020000);
  const int* seli = (const int*)(p.ws + OFF_SELI);
  const float* selg = (const float*)(p.ws + OFF_SELG);
  const float* selu = (const float*)(p.ws + OFF_SELU);
  bf16_t* hbuf = (bf16_t*)(p.ws + OFF_HBUF);
  const int nrows = layer ? TX : TT;
  unsigned* qhead = (unsigned*)(p.ws + OFF_BAR) + 3584 + 64 * layer;
  const int nstatic = gridDim.x * 8;
  for (int row = blockIdx.x * 8 + wv; row < nrows;) {
    int lane = TIDX & 63;
    asm volatile("" : "+v"(lane));
    const int l31 = lane & 31, half = lane >> 5;
    const int pidx = 2 * (((lane >> 4) & 1) * 2 + ((lane >> 3) & 1)) + half;
    float* xr = (row < TX ? p.out + (size_t)row * D : (float*)(p.ws + OFF_CTXBUF) + (size_t)(row - TX) * D) + 32 * l31;
    const int mb = row_mb(row);
    const float* mrow = mod + (size_t)mb * 6144 + 32 * l31;
    unsigned hp[16];
    f32x32v acc;
    {
      float xv[32];
      float ss = 0.f;
#pragma unroll
      for (int j = 0; j < 8; ++j) {
        float4 a = *(const float4*)(xr + 4 * j);
        xv[4 * j] = a.x; xv[4 * j + 1] = a.y; xv[4 * j + 2] = a.z; xv[4 * j + 3] = a.w;
        ss += a.x * a.x + a.y * a.y + a.z * a.z + a.w * a.w;
      }
      ss = wave_sum(ss) * 0.5f;
      const float rr = rsqrtf(ss * (1.f / 1024.f) + EPS);
      const float* gn = p.norm2 + layer * 1024 + 32 * l31;
#pragma unroll
      for (int i = 0; i < 16; ++i)
        hp[i] = pack2(xv[2 * i] * rr * gn[2 * i] * (1.f + mrow[4 * 1024 + 2 * i]) + mrow[3 * 1024 + 2 * i],
                      xv[2 * i + 1] * rr * gn[2 * i + 1] * (1.f + mrow[4 * 1024 + 2 * i + 1]) + mrow[3 * 1024 + 2 * i + 1]);
    }
#pragma unroll
    for (int i = 0; i < 32; ++i) acc[i] = 0.f;
    const int* si = seli + (size_t)row * 128;
    const float* sg = selg + (size_t)row * 128 + pidx;
    const float* su = selu + (size_t)row * 128 + pidx;
    asm volatile("" ::: "memory");
    const int ia = si[lane], ib = si[64 + lane];
    Row6 UU[4], VV[4];
#pragma unroll
    for (int j = 0; j < 4; ++j) {
      const int vo = pick_voff(ia, 2 * j, half, l31);
      UU[j] = row6_load(trs, vo, 0);
      VV[j] = row6_load(trs, vo, TVOFF);
    }
    const unsigned m4 = (lane & 16) ? ~0u : 0u, m3 = (lane & 8) ? ~0u : 0u;
#define GATHER_GROUP(g_, MORE) { \
      const int isn = ((g_) + 1) < 8 ? ia : ib; \
      const int kb = ((g_) + 1) << 3; \
      const float su_g = su[(g_) * 8], sg_g = sg[(g_) * 8]; \
      float d[4]; \
      _Pragma("unroll") for (int j = 0; j < 4; ++j) { \
        d[j] = row6_dot(UU[j], hp); \
        if (MORE) UU[j] = row6_load(trs, pick_voff(isn, kb + 2 * j, half, l31), 0); \
        __builtin_amdgcn_sched_barrier(0); \
      } \
      float e2[2], e1; \
      _Pragma("unroll") for (int q = 0; q < 2; ++q) { \
        float keep = blendf(d[q], d[q + 2], m4), send = blendf(d[q + 2], d[q], m4); \
        e2[q] = keep + __shfl_xor(send, 16); \
      } \
      { float keep = blendf(e2[0], e2[1], m3), send = blendf(e2[1], e2[0], m3); e1 = keep + __shfl_xor(send, 8); } \
      e1 += __shfl_xor(e1, 4); e1 += __shfl_xor(e1, 2); e1 += __shfl_xor(e1, 1); \
      const int ai = __float_as_int(sg_g * gelu_exact(su_g * e1)); \
      _Pragma("unroll") for (int j = 0; j < 4; ++j) { \
        const int sl = 16 * (j >> 1) + 8 * (j & 1); \
        const int ca = __builtin_amdgcn_readlane(ai, sl), cb = __builtin_amdgcn_readlane(ai, 32 + sl); \
        const float cq = __int_as_float(half ? cb : ca); \
        const f32x32v y = row6_decode(VV[j]); \
        if (MORE) VV[j] = row6_load(trs, pick_voff(isn, kb + 2 * j, half, l31), TVOFF); \
        acc += y * cq; \
        __builtin_amdgcn_sched_barrier(0); \
      } }
#pragma unroll 1
    for (int g = 0; g < 15; ++g) GATHER_GROUP(g, true)
    unsigned ticket = 0u;
    if (lane == 0) ticket = __hip_atomic_fetch_add(qhead, 1u, __ATOMIC_RELAXED, __HIP_MEMORY_SCOPE_AGENT);
    GATHER_GROUP(15, false)
#undef GATHER_GROUP
    const int next_row = nstatic + (int)__builtin_amdgcn_readfirstlane(ticket);
    asm volatile("" ::: "memory");
    float xn[16];
    {
      float tot[16];
#pragma unroll
      for (int i = 0; i < 16; ++i) {
        const float lo = acc[i], hi = acc[16 + i];
        const float mine = half ? hi : lo, other = half ? lo : hi;
        tot[i] = mine + __shfl_xor(other, 32);
      }
      const float* xq = xr + 16 * half;
      const float* mq = mrow + 5 * 1024 + 16 * half;
#pragma unroll
      for (int j = 0; j < 4; ++j) {
        float4 a = *(const float4*)(xq + 4 * j);
        xn[4 * j] = a.x + mq[4 * j] * tot[4 * j]; xn[4 * j + 1] = a.y + mq[4 * j + 1] * tot[4 * j + 1];
        xn[4 * j + 2] = a.z + mq[4 * j + 2] * tot[4 * j + 2]; xn[4 * j + 3] = a.w + mq[4 * j + 3] * tot[4 * j + 3];
      }
    }
    const int c0 = 32 * l31 + 16 * half;
    float s2 = 0.f;
#pragma unroll
    for (int i = 0; i < 16; ++i) s2 += xn[i] * xn[i];
    s2 = wave_sum(s2);
    const float rr = rsqrtf(s2 * (1.f / 1024.f) + EPS);
    float* xo = xr + 16 * half;
    if (layer == 0) {
#pragma unroll
      for (int j = 0; j < 4; ++j) *(float4*)(xo + 4 * j) = make_float4(xn[4 * j], xn[4 * j + 1], xn[4 * j + 2], xn[4 * j + 3]);
      const float* gn = p.norm1 + 1024 + c0;
      const float* m1 = mod1 + (size_t)mb * 6144 + c0;
      unsigned o[8];
#pragma unroll
      for (int i = 0; i < 8; ++i)
        o[i] = pack2(xn[2 * i] * rr * gn[2 * i] * (1.f + m1[1024 + 2 * i]) + m1[2 * i],
                     xn[2 * i + 1] * rr * gn[2 * i + 1] * (1.f + m1[1024 + 2 * i + 1]) + m1[2 * i + 1]);
      bf16_t* hd = hbuf + (size_t)row * D + c0;
      *(uint4*)hd = make_uint4(o[0], o[1], o[2], o[3]);
      *(uint4*)(hd + 8) = make_uint4(o[4], o[5], o[6], o[7]);
    } else {
      const float* gn = p.norm_f + c0;
#pragma unroll
      for (int j = 0; j < 4; ++j)
        *(float4*)(xo + 4 * j) = make_float4(xn[4 * j] * rr * gn[4 * j], xn[4 * j + 1] * rr * gn[4 * j + 1], xn[4 * j + 2] * rr * gn[4 * j + 2], xn[4 * j + 3] * rr * gn[4 * j + 3]);
    }
    row = next_row;
  }
}

DI void phase_inproj1(const Params& p, char* smem, const int wave_) {
  const bf16_t* A = (const bf16_t*)(p.ws + OFF_HBUF);
  const bf16_t* Bt = (const bf16_t*)(p.ws + OFF_WT_IN1);
  bf16_t* pr = (bf16_t*)(p.ws + OFF_PROJ1);
  const int ntn = 3, ntm = TT / 256;
  for (int tbase = 0; tbase < ntm * ntn; tbase += gridDim.x) {
    const int tile = xcd_item(tbase);
    if (tile >= ntm * ntn) continue;
    const int tm = tile / ntn, tn = tile % ntn;
    const int m0 = tm * 256, n0 = tn * 256;
    acc256_t acc;
    gemm256<3>(A + (size_t)m0 * D, D, Bt + (size_t)n0 * D, D, D, smem, wave_, acc);
    int t = TIDX; asm volatile("" : "+v"(t));
    const int lane = t & 63, wid = t >> 6, wr = wid >> 2, wc = wid & 3, fr = lane & 15, fq = lane >> 4;
    float* red = (float*)(smem + G8_LDS);
#pragma unroll
    for (int ai = 0; ai < 2; ++ai)
#pragma unroll
      for (int m = 0; m < 4; ++m) {
        const int rl = ai * 128 + wr * 64 + m * 16 + fr;
        bf16_t* drow = pr + (size_t)(m0 + rl) * 768 + n0 + wc * 32;
#pragma unroll
        for (int bj = 0; bj < 2; ++bj) {
          const f32x4 a = acc[ai][bj][m][0], c = acc[ai][bj][m][1];
          float ss = a[0] * a[0] + a[1] * a[1] + a[2] * a[2] + a[3] * a[3] + c[0] * c[0] + c[1] * c[1] + c[2] * c[2] + c[3] * c[3];
          ss += __shfl_xor(ss, 16);
          ss += __shfl_xor(ss, 32);
          if (fq == 0) red[(rl * 2 + bj) * 4 + wc] = ss;
          store_bf16x8_pair(drow + bj * 128, a, c, fq);
        }
      }
    __syncthreads();
    {
      const int row = t >> 1, bj = t & 1;
      const float4 v = *(const float4*)(red + (row * 2 + bj) * 4);
      const int slot = tn == 0 ? (bj ? 4 : 0) : (tn == 1 ? (bj ? 2 : 1) : (bj ? -1 : 3));
      if (slot >= 0) ((float*)(p.ws + OFF_SSQ))[(size_t)(m0 + row) * 8 + slot] = (v.x + v.y) + (v.z + v.w);
    }
  }
}

DI void phase_upproj_q(const Params& p, char* smem, const int wave_) {
  const bf16_t* pr = (const bf16_t*)(p.ws + OFF_PROJ1);
  const bf16_t* wq = (const bf16_t*)(p.ws + OFF_WT_UQ);
  bf16_t* Qb = (bf16_t*)(p.ws + OFF_Q);
  const float* ropec = (const float*)(p.ws + OFF_ROPE);
  float* rs = (float*)(smem + G8_LDS);
  float* rtab = rs + 256;
  { const int t0_ = TIDX; for (int i = t0_; i < 2048; i += NT) rtab[i] = ropec[i]; }
  const int nq = (TX / 256) * 6;
  for (int tbase = 0; tbase < nq; tbase += gridDim.x) {
    const int tile = xcd_item(tbase);
    if (tile >= nq) continue;
    const int tm = tile / 6, tn = tile % 6;
    const int m0 = tm * 256, n0 = tn * 256;
    __syncthreads();
    {
      const int t_ = TIDX;
      if (t_ < 256) { const float* sq = (const float*)(p.ws + OFF_SSQ) + (size_t)(m0 + t_) * 8; rs[t_] = rsqrtf((sq[0] + sq[4] + sq[1]) * (1.f / 384.f) + EPS); }
    }
    acc256_t acc;
    gemm256<3>(pr + (size_t)m0 * 768, 768, wq + (size_t)n0 * 384, 384, 384, smem, wave_, acc);
    int t = TIDX; asm volatile("" : "+v"(t));
    const int lane = t & 63, wid = t >> 6, wr = wid >> 2, wc = wid & 3, fr = lane & 15, fq = lane >> 4;
    const int b = m0 >> 12, t0 = m0 & 4095;
#pragma unroll
    for (int bj = 0; bj < 2; ++bj) {
      const int cg = n0 + bj * 128 + wc * 32;
      const int hd = cg / 192, d0 = cg % 192;
      const bool rope = d0 >= 128;
      const int seg = (d0 - 128) >> 5;
#pragma unroll
      for (int ai = 0; ai < 2; ++ai)
#pragma unroll
        for (int m = 0; m < 4; ++m) {
          const int rl = ai * 128 + wr * 64 + m * 16 + fr;
          const float sc = rs[rl];
          f32x4 x1 = acc[ai][bj][m][0], x2 = acc[ai][bj][m][1];
#pragma unroll
          for (int j = 0; j < 4; ++j) { x1[j] *= sc; x2[j] *= sc; }
          if (rope) {
            const int tok = t0 + rl;
            const int pos = seg == 0 ? (tok >> 6) : (tok & 63);
            const float4 cs = *(const float4*)(rtab + pos * 16 + fq * 4);
            const float4 sn = *(const float4*)(rtab + 1024 + pos * 16 + fq * 4);
            const float c_[4] = {cs.x, cs.y, cs.z, cs.w}, s_[4] = {sn.x, sn.y, sn.z, sn.w};
#pragma unroll
            for (int j = 0; j < 4; ++j) {
              const float a1 = x1[j], a2 = x2[j];
              x1[j] = a1 * c_[j] - a2 * s_[j];
              x2[j] = a2 * c_[j] + a1 * s_[j];
            }
          }
          bf16_t* qd = Qb + ((size_t)(b * 8 + hd) * 4096 + t0 + rl) * 192 + d0;
          store_bf16x8_pair(qd, x1, x2, fq);
        }
    }
  }
}

DI void phase_upproj_kv(const Params& p, char* smem, const int wave_) {
  const bf16_t* pr = (const bf16_t*)(p.ws + OFF_PROJ1);
  const bf16_t* wkv = (const bf16_t*)(p.ws + OFF_WT_UKV);
  bf16_t* Kb = (bf16_t*)(p.ws + OFF_K);
  bf16_t* VTb = (bf16_t*)(p.ws + OFF_VT);
  const float* ropec = (const float*)(p.ws + OFF_ROPE);
  const float* ropes = ropec + 1024;
  float* rs = (float*)(smem + G8_LDS);
  const int nkv = (TT / 256) * 8;
  for (int tbase = 0; tbase < nkv; tbase += gridDim.x) {
    const int tile = xcd_item(tbase);
    if (tile >= nkv) continue;
    const int tm = tile >> 3, hd = tile & 7;
    const int m0 = tm * 256, n0 = hd * 256;
    __syncthreads();
    {
      const int t_ = TIDX;
      if (t_ < 256) { const float* sq = (const float*)(p.ws + OFF_SSQ) + (size_t)(m0 + t_) * 8; rs[t_] = rsqrtf((sq[2] + sq[3]) * (1.f / 256.f) + EPS); }
    }
    acc256_t acc;
    gemm256<1>(pr + (size_t)m0 * 768 + 384, 768, wkv + (size_t)n0 * 256, 256, 256, smem, wave_, acc);
    int t = TIDX; asm volatile("" : "+v"(t));
    const int lane = t & 63, wid = t >> 6, wr = wid >> 2, wc = wid & 3, fr = lane & 15, fq = lane >> 4;
    const bool isx = m0 < TX;
    const int b = isx ? (m0 >> 12) : ((m0 - TX) >> 8);
    const int key0 = isx ? (m0 & 4095) : 4096;
    const size_t bh = (size_t)(b * 8 + hd);
#pragma unroll
    for (int ai = 0; ai < 2; ++ai)
#pragma unroll
      for (int m = 0; m < 4; ++m) {
        const int rl = ai * 128 + wr * 64 + m * 16 + fr;
        const float sc = rs[rl];
        bf16_t* kd = Kb + (bh * NKEY + key0 + rl) * 192 + wc * 32;
        store_bf16x8_pair(kd, acc[ai][0][m][0] * sc, acc[ai][0][m][1] * sc, fq);
      }
#pragma unroll
    for (int ai = 0; ai < 2; ++ai)
#pragma unroll
      for (int m = 0; m < 4; ++m) {
        const int rl0 = ai * 128 + wr * 64 + m * 16 + fq * 4;
        const int rl0p = ai * 128 + wr * 64 + m * 16 + (fq & 1) * 8 + (fq >> 1) * 4;
        const float4 sc = *(const float4*)(rs + rl0);
        const f32x4 va = acc[ai][1][m][0], vb = acc[ai][1][m][1];
        const unsigned x0 = pack2(va[0] * sc.x, va[1] * sc.y), x1 = pack2(va[2] * sc.z, va[3] * sc.w);
        const unsigned y0 = pack2(vb[0] * sc.x, vb[1] * sc.y), y1 = pack2(vb[2] * sc.z, vb[3] * sc.w);
        const auto s0 = __builtin_amdgcn_permlane32_swap(x0, y0, false, false);
        const auto s1 = __builtin_amdgcn_permlane32_swap(x1, y1, false, false);
        const int rl0q = ai * 128 + wr * 64 + m * 16 + (fq & 1) * 8;
        bf16_t* vd = VTb + (bh * 128 + wc * 32 + (fq >> 1) * 16 + fr) * NKEY + key0 + rl0q;
        *(uint4*)vd = make_uint4(s0[0], s1[0], s0[1], s1[1]);
      }
    {
      const int tok = t >> 1, seg = t & 1;
      const bf16_t* src = pr + (size_t)(m0 + tok) * 768 + 640 + seg * 32;
      const uint4 i0 = *(const uint4*)(src), i1 = *(const uint4*)(src + 8), i2 = *(const uint4*)(src + 16), i3 = *(const uint4*)(src + 24);
      const unsigned ua[8] = {i0.x, i0.y, i0.z, i0.w, i1.x, i1.y, i1.z, i1.w};
      const unsigned ub[8] = {i2.x, i2.y, i2.z, i2.w, i3.x, i3.y, i3.z, i3.w};
      float a[16], bq[16];
#pragma unroll
      for (int e = 0; e < 8; ++e) { a[2 * e] = bflo(ua[e]); a[2 * e + 1] = bfhi(ua[e]); bq[2 * e] = bflo(ub[e]); bq[2 * e + 1] = bfhi(ub[e]); }
      if (isx) {
        const int tt = key0 + tok;
        const int pos = seg == 0 ? (tt >> 6) : (tt & 63);
#pragma unroll
        for (int i = 0; i < 16; ++i) {
          float cs = ropec[pos * 16 + i], sn = ropes[pos * 16 + i];
          float na = a[i] * cs - bq[i] * sn, nb = bq[i] * cs + a[i] * sn;
          a[i] = na; bq[i] = nb;
        }
      }
      bf16_t* dst = Kb + (bh * NKEY + key0 + tok) * 192 + 128 + seg * 32;
      *(uint4*)(dst) = make_uint4(pack2(a[0], a[1]), pack2(a[2], a[3]), pack2(a[4], a[5]), pack2(a[6], a[7]));
      *(uint4*)(dst + 8) = make_uint4(pack2(a[8], a[9]), pack2(a[10], a[11]), pack2(a[12], a[13]), pack2(a[14], a[15]));
      *(uint4*)(dst + 16) = make_uint4(pack2(bq[0], bq[1]), pack2(bq[2], bq[3]), pack2(bq[4], bq[5]), pack2(bq[6], bq[7]));
      *(uint4*)(dst + 24) = make_uint4(pack2(bq[8], bq[9]), pack2(bq[10], bq[11]), pack2(bq[12], bq[13]), pack2(bq[14], bq[15]));
    }
  }
}

constexpr int AT_KS = 64 * 384;
constexpr int AT_VS = 128 * 128;
constexpr int AT_RD = 6;
template <int OFF>
DI void lds_rd128(bf16x8& d, unsigned addr) {
  asm volatile("ds_read_b128 %0, %1 offset:%2" : "=v"(d) : "v"(addr), "n"(OFF) : "memory");
}
template <int N>
DI void lgkm_wait(bf16x8& d) {
  asm volatile("s_waitcnt lgkmcnt(%1)" : "+v"(d) : "n"(N) : "memory");
}
template <int J, int OFF, int NS>
DI void att_issue(bf16x8& d, const unsigned (&kb)[4], const unsigned (&vb)[4]) {
  if constexpr (J < NS) {
    constexpr int G = (J + OFF) % 40;
    if constexpr (G < 24) {
      constexpr int kk = G >> 1, m = G & 1;
      lds_rd128<m * (32 * 384) + (kk >> 2) * 128>(d, kb[kk & 3]);
    } else {
      constexpr int j = G - 24;
      lds_rd128<(j & 3) * (32 * 128)>(d, vb[j >> 2]);
    }
  }
}
DI void phase_attn(const Params& p, char* smem, const int wave_) {
  int t = TIDX;
  asm volatile("" : "+v"(t));
  const int lane = t & 63, wv = t >> 6, r = lane & 31, h = lane >> 5;
  const bf16_t* Qb = (const bf16_t*)(p.ws + OFF_Q);
  const bf16_t* Kb = (const bf16_t*)(p.ws + OFF_K);
  const bf16_t* VTb = (const bf16_t*)(p.ws + OFF_VT);
  bf16_t* ob = (bf16_t*)(p.ws + OFF_HBUF);
  LAS char* lds = (LAS char*)smem;
  const unsigned ldsaddr = (unsigned)(size_t)lds;
  int kvo[3], vvo[2];
#pragma unroll
  for (int e = 0; e < 3; ++e) {
    const int L = (wv * 3 + e) * 1024 + lane * 16, row = L / 384, cs = (L % 384) >> 4;
    kvo[e] = row * 384 + ((cs ^ ((row >> 1) & 7)) << 4);
  }
#pragma unroll
  for (int e = 0; e < 2; ++e) {
    const int L = (wv * 2 + e) * 1024 + lane * 16, row = L >> 7, cs = (L & 127) >> 4;
    vvo[e] = row * (NKEY * 2) + ((cs ^ ((row >> 1) & 7)) << 4);
  }
  const int gh = ((r >> 1) & 7) ^ h;
  const int kro0 = r * 384 + (gh << 4), vro0 = r * 128 + (gh << 4);
  const f32x16 zero16 = {0.f, 0.f, 0.f, 0.f, 0.f, 0.f, 0.f, 0.f, 0.f, 0.f, 0.f, 0.f, 0.f, 0.f, 0.f, 0.f};
  for (int ibase = 0; ibase < 1024; ibase += gridDim.x) {
    const int item = xcd_item(ibase);
    if (item >= 1024) continue;
    const int bh = item >> 4, qb = item & 15;
    const int b = bh >> 3, hd = bh & 7;
    const __amdgpu_buffer_rsrc_t krs = __builtin_amdgcn_make_buffer_rsrc((void*)(Kb + (size_t)bh * NKEY * 192), 0, NKEY * 192 * 2, 0x00020000);
    const __amdgpu_buffer_rsrc_t vrs = __builtin_amdgcn_make_buffer_rsrc((void*)(VTb + (size_t)bh * 128 * NKEY), 0, 128 * NKEY * 2, 0x00020000);
    bf16x8 qf[12];
    {
      const bf16_t* qrow = Qb + ((size_t)bh * 4096 + qb * 256 + wv * 32 + r) * 192 + 8 * h;
#pragma unroll
      for (int kk = 0; kk < 12; ++kk) qf[kk] = *(const bf16x8*)(qrow + 16 * kk);
    }
    f32x16 O[4];
#pragma unroll
    for (int m = 0; m < 4; ++m)
#pragma unroll
      for (int e = 0; e < 16; ++e) O[m][e] = 0.f;
    float mrun = 0.f, lsum = 0.f;
    f32x16 negm = zero16;
#define AT_DMA_K(tile_, st_) { _Pragma("unroll") for (int e = 0; e < 3; ++e) \
      __builtin_amdgcn_raw_ptr_buffer_load_lds(krs, (LAS void*)(lds + (st_) * AT_KS + (wave_ * 3 + e) * 1024), 16, kvo[e], (tile_) * AT_KS, 0, 0); }
#define AT_DMA_V(tile_, st_) { _Pragma("unroll") for (int e = 0; e < 2; ++e) \
      __builtin_amdgcn_raw_ptr_buffer_load_lds(vrs, (LAS void*)(lds + 3 * AT_KS + (st_) * AT_VS + (wave_ * 2 + e) * 1024), 16, vvo[e], (tile_) * 128, 0, 0); }
    asm volatile("s_waitcnt vmcnt(0) lgkmcnt(0)" ::: "memory");
    __builtin_amdgcn_s_barrier();
    AT_DMA_K(0, 0); AT_DMA_V(0, 0);
    AT_DMA_K(1, 1); AT_DMA_V(1, 1);
    asm volatile("s_waitcnt vmcnt(0)" ::: "memory");
    __builtin_amdgcn_s_barrier();
    f32x16 S[2];
    bf16x8 fr[AT_RD];
    unsigned pw[16];
    int ksc = 0, ksn = 2, vsc = 0;
#define AT_STEP(j, OFF, NS) { \
      lgkm_wait<((j) + AT_RD - 1 < (NS) ? AT_RD - 1 : (NS) - 1 - (j))>(fr[(j) % AT_RD]); \
      if ((((j) + (OFF)) % 40) < 24) S[((j) + (OFF)) & 1] = MFMA32(fr[(j) % AT_RD], qf[((((j) + (OFF)) % 40) >> 1) % 12], (((j) + (OFF)) % 40) < 2 ? negm : S[((j) + (OFF)) & 1]); \
      else { const u32x4 pq_ = {pw[4 * ((((((j) + (OFF)) % 40) - 24) >> 2) & 3)], pw[4 * ((((((j) + (OFF)) % 40) - 24) >> 2) & 3) + 1], \
                                pw[4 * ((((((j) + (OFF)) % 40) - 24) >> 2) & 3) + 2], pw[4 * ((((((j) + (OFF)) % 40) - 24) >> 2) & 3) + 3]}; \
             O[((j) + (OFF)) & 3] = MFMA32(fr[(j) % AT_RD], __builtin_bit_cast(bf16x8, pq_), O[((j) + (OFF)) & 3]); } \
      att_issue<(j) + AT_RD, OFF, NS>(fr[(j) % AT_RD], kb, vb); }
#define AT_STEP8(j, OFF, NS) AT_STEP(j, OFF, NS) AT_STEP((j) + 1, OFF, NS) AT_STEP((j) + 2, OFF, NS) AT_STEP((j) + 3, OFF, NS) \
      AT_STEP((j) + 4, OFF, NS) AT_STEP((j) + 5, OFF, NS) AT_STEP((j) + 6, OFF, NS) AT_STEP((j) + 7, OFF, NS)
#define AT_FIRST(OFF, NS) { att_issue<0, OFF, NS>(fr[0], kb, vb); att_issue<1, OFF, NS>(fr[1], kb, vb); att_issue<2, OFF, NS>(fr[2], kb, vb); \
      att_issue<3, OFF, NS>(fr[3], kb, vb); att_issue<4, OFF, NS>(fr[4], kb, vb); att_issue<5, OFF, NS>(fr[5], kb, vb); }
#define AT_BASES(ks_, vs_) \
      unsigned kb[4], vb[4]; \
      { const unsigned kbase_ = ldsaddr + (ks_) * AT_KS, vbase_ = ldsaddr + 3 * AT_KS + (vs_) * AT_VS; \
        _Pragma("unroll") for (int x = 0; x < 4; ++x) { kb[x] = kbase_ + (kro0 ^ (x << 5)); vb[x] = vbase_ + (vro0 ^ (x << 5)); } }
#define AT_SM(FIRST) { \
      float mx = S[0][0]; \
      _Pragma("unroll") for (int m = 0; m < 2; ++m) _Pragma("unroll") for (int e = 0; e < 16; ++e) mx = fmaxf(mx, S[m][e]); \
      { const auto sw_ = __builtin_amdgcn_permlane32_swap(__float_as_uint(mx), __float_as_uint(mx), false, false); \
        mx = fmaxf(__uint_as_float(sw_[0]), __uint_as_float(sw_[1])); } \
      if ((FIRST) || __builtin_amdgcn_ballot_w64(mx > 8.f) != 0ull) { \
        const float d_ = (FIRST) ? mx : fmaxf(mx, 0.f);            \
        const float alpha = (FIRST) ? 0.f : __builtin_amdgcn_exp2f(-d_); \
        mrun += d_; \
        lsum *= alpha; \
        _Pragma("unroll") for (int m = 0; m < 4; ++m) _Pragma("unroll") for (int e = 0; e < 16; ++e) O[m][e] *= alpha; \
        _Pragma("unroll") for (int m = 0; m < 2; ++m) _Pragma("unroll") for (int e = 0; e < 16; ++e) S[m][e] -= d_; \
        _Pragma("unroll") for (int e = 0; e < 16; ++e) negm[e] = -mrun; \
      } \
      float ps = 0.f; \
      _Pragma("unroll") for (int i = 0; i < 16; ++i) { \
        const float p0_ = __builtin_amdgcn_exp2f(S[i >> 3][(2 * i) & 15]), p1_ = __builtin_amdgcn_exp2f(S[i >> 3][((2 * i) & 15) + 1]); \
        pw[i] = pack2(p0_, p1_); \
        ps = __builtin_amdgcn_fdot2_f32_bf16(__builtin_bit_cast(bf16x2v, pw[i]), __builtin_bit_cast(bf16x2v, 0x3F803F80u), ps, false); } \
      lsum += ps; }
#define AT_HEAD(kt_) { AT_DMA_K((kt_) + 2, ksn); AT_DMA_V((kt_) + 2, (vsc + 2) & 3); }
#define AT_TAIL() { \
      asm volatile("s_waitcnt vmcnt(5) lgkmcnt(0)" ::: "memory"); \
      __builtin_amdgcn_s_barrier(); \
      ksn = ksc; ksc = (ksc == 2) ? 0 : ksc + 1; \
      vsc = (vsc + 1) & 3; }
    if (wave_ < 4) {
#pragma unroll 1
      for (int kt = 0; kt < NCH; ++kt) {
        AT_BASES(ksc, vsc)
        AT_FIRST(0, 40)
        AT_HEAD(kt)
        AT_STEP8(0, 0, 40) AT_STEP8(8, 0, 40) AT_STEP8(16, 0, 40)
        AT_SM(kt == 0)
        AT_STEP8(24, 0, 40) AT_STEP8(32, 0, 40)
        AT_TAIL()
      }
    } else {
      {
        AT_BASES(ksc, vsc)
        AT_FIRST(0, 24)
        AT_HEAD(0)
        AT_STEP8(0, 0, 24) AT_STEP8(8, 0, 24) AT_STEP8(16, 0, 24)
        AT_TAIL()
      }
#pragma unroll 1
      for (int kt = 1; kt < NCH; ++kt) {
        AT_BASES(ksc, (vsc + 3) & 3)
        AT_FIRST(24, 40)
        AT_HEAD(kt)
        AT_SM(kt == 1)
        AT_STEP8(0, 24, 40) AT_STEP8(8, 24, 40) AT_STEP8(16, 24, 40) AT_STEP8(24, 24, 40) AT_STEP8(32, 24, 40)
        AT_TAIL()
      }
      {
        AT_BASES(ksc, (vsc + 3) & 3)
        AT_FIRST(24, 16)
        AT_SM(false)
        AT_STEP8(0, 24, 16) AT_STEP8(8, 24, 16)
      }
    }
    {
      const auto sw_ = __builtin_amdgcn_permlane32_swap(__float_as_uint(lsum), __float_as_uint(lsum), false, false);
      lsum = __uint_as_float(sw_[0]) + __uint_as_float(sw_[1]);
    }
    const float inv = 1.f / lsum;
    bf16_t* orow = ob + ((size_t)b * 4096 + qb * 256 + wv * 32 + r) * 1024 + hd * 128;
#pragma unroll
    for (int mo = 0; mo < 4; ++mo)
#pragma unroll
      for (int k = 0; k < 2; ++k) {
        const unsigned x0 = pack2(O[mo][8 * k] * inv, O[mo][8 * k + 1] * inv), x1 = pack2(O[mo][8 * k + 2] * inv, O[mo][8 * k + 3] * inv);
        const unsigned y0 = pack2(O[mo][8 * k + 4] * inv, O[mo][8 * k + 5] * inv), y1 = pack2(O[mo][8 * k + 6] * inv, O[mo][8 * k + 7] * inv);
        const auto s0 = __builtin_amdgcn_permlane32_swap(x0, y0, false, false);
        const auto s1 = __builtin_amdgcn_permlane32_swap(x1, y1, false, false);
        *(uint4*)(orow + mo * 32 + 16 * k + 8 * h) = make_uint4(s0[0], s1[0], s0[1], s1[1]);
      }
  }
  asm volatile("s_waitcnt vmcnt(0)" ::: "memory");
  __syncthreads();
#undef AT_DMA_K
#undef AT_DMA_V
#undef AT_STEP
#undef AT_STEP8
#undef AT_FIRST
#undef AT_BASES
#undef AT_SM
#undef AT_HEAD
#undef AT_TAIL
}

constexpr int SMEM_BYTES = 163840 - 16;


#define XB_TMO      128
#define XB_XCNT(j)  (256  + 64 * (j))
#define XB_XSUB(j)  (1280 + 64 * (j))
#define XB_XGEN(j)  (2304 + 64 * (j))
#define XB_TOP      3328
#define XB_TOPGEN   3392
#define XCD_BAR_WORDS 3456
#define XB_SPIN_CAP (1u << 22)
DI unsigned xb_ld(unsigned* p) { return __hip_atomic_load(p, __ATOMIC_RELAXED, __HIP_MEMORY_SCOPE_AGENT); }
DI unsigned xb_add(unsigned* p, unsigned v) { return __hip_atomic_fetch_add(p, v, __ATOMIC_RELAXED, __HIP_MEMORY_SCOPE_AGENT); }
DI unsigned xb_xcc_id() { return (unsigned)__builtin_amdgcn_s_getreg((3 << 11) | 20) & 0xFu; }
#define XB_SPIN(cond, bar) do { unsigned _sp = 0; while (cond) { __builtin_amdgcn_s_sleep(1); \
    if ((++_sp & 255u) == 0u) { if (xb_ld(&(bar)[XB_TMO])) break; if (_sp > XB_SPIN_CAP) { atomicAdd(&(bar)[XB_TMO], 1u); break; } } } } while (0)
struct XcdBarrier { unsigned* bar; unsigned x; volatile LAS unsigned* st; };
DI XcdBarrier xcd_barrier_post(unsigned* bar, volatile LAS unsigned* st, int tid) {
  XcdBarrier b; b.bar = bar; b.x = xb_xcc_id(); b.st = st;
  if (tid == 0) st[3] = xb_add(&bar[XB_XCNT(b.x)], 1u);
  return b;
}
DI void xcd_barrier_complete(unsigned* bar, unsigned x, unsigned& nloc, unsigned& nx, unsigned& dense) {
  const unsigned G = gridDim.x * gridDim.y * gridDim.z;
  unsigned sum, cnt, mine, below, sp = 0u;
  for (;;) {
    sum = 0u; cnt = 0u; mine = 0u; below = 0u;
#pragma unroll
    for (unsigned j = 0; j < 16; ++j) { const unsigned c = xb_ld(&bar[XB_XCNT(j)]); sum += c; cnt += (c > 0u) ? 1u : 0u; mine = (j == x) ? c : mine; below += (j < x && c > 0u) ? 1u : 0u; }
    if (sum == G) break;
    __builtin_amdgcn_s_sleep(1);
    if ((++sp & 255u) == 0u) { if (xb_ld(&bar[XB_TMO])) break; if (sp > XB_SPIN_CAP) { atomicAdd(&bar[XB_TMO], 1u); break; } }
  }
  nloc = mine > 0u ? mine : 1u; nx = cnt > 0u ? cnt : 1u; dense = below;
}
DI void xcd_barrier(const XcdBarrier& b, int tid) {
  asm volatile("s_waitcnt vmcnt(0)" ::: "memory");
  __syncthreads();
  if (tid == 0) {
    unsigned* bar = b.bar;
    __builtin_amdgcn_s_waitcnt(0);
    unsigned nloc = b.st[0], nx = b.st[1];
    if (nloc == 0u) { unsigned dense; xcd_barrier_complete(bar, b.x, nloc, nx, dense); b.st[0] = nloc; b.st[1] = nx; b.st[2] = dense; }
    const unsigned old = xb_add(&bar[XB_XSUB(b.x)], 1u);
    const unsigned gen = old / nloc;
    if (old + 1u == (gen + 1u) * nloc) {
      __builtin_amdgcn_fence(__ATOMIC_RELEASE, "agent");
      asm volatile("s_waitcnt vmcnt(0)" ::: "memory");
      const unsigned og = xb_add(&bar[XB_TOP], 1u);
      const unsigned tg = og / nx;
      if (og + 1u == (tg + 1u) * nx) xb_add(&bar[XB_TOPGEN], 1u);
      else XB_SPIN(xb_ld(&bar[XB_TOPGEN]) == tg, bar);
      __builtin_amdgcn_fence(__ATOMIC_ACQUIRE, "agent");
      xb_add(&bar[XB_XGEN(b.x)], 1u);
      asm volatile("s_waitcnt vmcnt(0)" ::: "memory");
    } else {
      XB_SPIN(xb_ld(&bar[XB_XGEN(b.x)]) == gen, bar);
      __builtin_amdgcn_fence(__ATOMIC_ACQUIRE, "agent");
      asm volatile("s_waitcnt vmcnt(0)" ::: "memory");
    }
  }
  __syncthreads();
}

#ifndef DUP_MASK
#define DUP_MASK 0
#endif
#define RUNP(ph, call) { call; if ((DUP_MASK >> (ph)) & 1) { call; } }
#define GATHER_SEQ(L) phase_gather(p, L, wave_);
#define PHASE_LIST(SYNC) \
  RUNP(0, phase_prep(p, smem, wave_)); SYNC; \
  RUNP(1, phase_h0(p, smem, wave_)); SYNC; \
  RUNP(2, phase_inproj0(p, smem, wave_)); SYNC; \
  RUNP(3, phase_g1(p, smem, wave_)); SYNC; \
  RUNP(4, phase_g2(p, smem, wave_)); SYNC; \
  RUNP(5, phase_yb(p, wave_)); SYNC; \
  RUNP(6, phase_outproj(p, smem, 0, wave_)); convert_in_tail(p, 0, (TT / 256) * 4, wave_); SYNC; \
  RUNP(8, phase_peerq(p, smem, 0, wave_)); convert_in_tail(p, 1, (TT / 256) * 4, wave_); SYNC; \
  GATHER_SEQ(0) SYNC; \
  RUNP(10, phase_inproj1(p, smem, wave_)); SYNC; \
  RUNP(11, phase_upproj_q(p, smem, wave_); phase_upproj_kv(p, smem, wave_)); SYNC; \
  RUNP(12, phase_attn(p, smem, wave_)); SYNC; \
  phase_outproj(p, smem, 1, wave_); SYNC; \
  RUNP(15, phase_peerq(p, smem, 1, wave_)); SYNC; \
  GATHER_SEQ(1)

#if MEGA
__global__ void __launch_bounds__(NT) mega_kernel(Params p) {
  __shared__ __attribute__((aligned(16))) char smem[SMEM_BYTES + 16];
  cg::grid_group grid = cg::this_grid();
  const int wave_ = __builtin_amdgcn_readfirstlane((int)(__builtin_amdgcn_workitem_id_x() >> 6));
  volatile LAS unsigned* xst = (volatile LAS unsigned*)(smem + SMEM_BYTES);
  if (TIDX == 0) { xst[0] = 0u; xst[1] = 0u; xst[2] = 0u; xst[3] = 0u; }
  __syncthreads();
  const XcdBarrier xb = xcd_barrier_post((unsigned*)(p.ws + OFF_BAR), xst, TIDX);
  if (gridDim.z == 3) grid.sync();
#define SEAM { xcd_barrier(xb, TIDX); }
  PHASE_LIST(SEAM)
#undef SEAM
}
#else
template <int PH>
__global__ void __launch_bounds__(NT) phase_kernel(Params p) {
  __shared__ __attribute__((aligned(16))) char smem[SMEM_BYTES];
  const int wave_ = __builtin_amdgcn_readfirstlane((int)(__builtin_amdgcn_workitem_id_x() >> 6));
  switch (PH) {
    case 0: phase_prep(p, smem, wave_); break;
    case 1: phase_h0(p, smem, wave_); break;
    case 2: phase_inproj0(p, smem, wave_); break;
    case 3: phase_g1(p, smem, wave_); break;
    case 4: phase_g2(p, smem, wave_); break;
    case 5: phase_yb(p, wave_); break;
    case 6: phase_outproj(p, smem, 0, wave_); break;
    case 7: phase_hnorm(p, p.norm2, 0, 3, TT, wave_); convert_tables(p, 0, blockIdx.x, gridDim.x, wave_); convert_tables(p, 1, blockIdx.x, gridDim.x, wave_); break;
    case 8: phase_peerq(p, smem, 0, wave_); break;
    case 9: phase_gather(p, 0, wave_); break;
    case 10: phase_inproj1(p, smem, wave_); break;
    case 11: phase_upproj_q(p, smem, wave_); phase_upproj_kv(p, smem, wave_); break;
    case 12: phase_attn(p, smem, wave_); break;
    case 13: phase_outproj(p, smem, 1, wave_); break;
    case 14: phase_hnorm(p, p.norm2 + 1024, 1, 3, TX, wave_); break;
    case 15: phase_peerq(p, smem, 1, wave_); break;
    case 16: phase_gather(p, 1, wave_); break;
  }
}
#endif

extern "C" void kernel_launch(void* const* d_in, const int* in_sizes, int n_in, void* d_out, int out_size, void* d_ws,
                              size_t ws_size, hipStream_t stream) {
  (void)in_sizes; (void)n_in; (void)out_size; (void)ws_size;
  Params p{};
  const float** f = (const float**)&p;
  for (int i = 0; i < 26; ++i) f[i] = (const float*)d_in[i];
  p.out = (float*)d_out;
  p.ws = (char*)d_ws;
#if MEGA
  static int grid_blocks = 0;
  if (!grid_blocks) {
    int dev = 0, cus = 0, per_cu = 0;
    hipGetDevice(&dev);
    hipDeviceGetAttribute(&cus, hipDeviceAttributeMultiprocessorCount, dev);
    hipOccupancyMaxActiveBlocksPerMultiprocessor(&per_cu, mega_kernel, NT, 0);
    if (per_cu > 1) per_cu = 1;
    grid_blocks = cus * per_cu;
  }
  hipMemsetAsync((char*)d_ws + OFF_BAR, 0, 16384, stream);
  void* args[] = {&p};
  hipLaunchCooperativeKernel((void*)mega_kernel, dim3(grid_blocks), dim3(NT), args, 0, stream);
#else
  const dim3 g(256), b(NT);
  phase_kernel<0><<<g, b, 0, stream>>>(p);
  phase_kernel<1><<<g, b, 0, stream>>>(p);
  phase_kernel<2><<<g, b, 0, stream>>>(p);
  phase_kernel<3><<<g, b, 0, stream>>>(p);
  phase_kernel<4><<<g, b, 0, stream>>>(p);
  phase_kernel<5><<<g, b, 0, stream>>>(p);
  phase_kernel<6><<<g, b, 0, stream>>>(p);
  phase_kernel<7><<<g, b, 0, stream>>>(p);
  phase_kernel<8><<<g, b, 0, stream>>>(p);
  phase_kernel<9><<<g, b, 0, stream>>>(p);
  phase_kernel<10><<<g, b, 0, stream>>>(p);
  phase_kernel<11><<<g, b, 0, stream>>>(p);
  phase_kernel<12><<<g, b, 0, stream>>>(p);
  phase_kernel<13><<<g, b, 0, stream>>>(p);
  phase_kernel<14><<<g, b, 0, stream>>>(p);
  phase_kernel<15><<<g, b, 0, stream>>>(p);
  phase_kernel<16><<<g, b, 0, stream>>>(p);
#endif
}
```

```cpp
#include <hip/hip_runtime.h>
#include <hip/hip_cooperative_groups.h>
#include <stdint.h>
namespace cg = cooperative_groups;

#ifndef MEGA
#define MEGA 1
#endif


typedef unsigned short bf16_t;
using bf16x8 = __attribute__((ext_vector_type(8))) short;
using f32x16 = __attribute__((ext_vector_type(16))) float;
using f32x4 = __attribute__((ext_vector_type(4))) float;
typedef unsigned u32x4 __attribute__((ext_vector_type(4)));
#define DI __device__ __forceinline__
#define LAS __attribute__((address_space(3)))
#define NT 512
__device__ __forceinline__ int lane_id_fresh() {
  unsigned z = 0u;
  asm volatile("" : "+v"(z));
  return (int)__builtin_amdgcn_mbcnt_hi(~0u, __builtin_amdgcn_mbcnt_lo(~0u, z));
}
#define TIDX (wave_ * 64 + lane_id_fresh())

constexpr int D = 1024;
constexpr int NB = 8;
constexpr int SEQ = 4096;
constexpr int CTXL = 256;
constexpr int TX = NB * SEQ;
constexpr int TC = NB * CTXL;
constexpr int TT = TX + TC;
constexpr int NKEY = SEQ + CTXL;
constexpr int NCH = 68;
constexpr int NITEM = NB * 4 * NCH;
constexpr float EPS = 1e-6f;

constexpr size_t OFF_MOD = 0;
constexpr size_t OFF_ROPE = OFF_MOD + 442368;
constexpr size_t OFF_WAB = OFF_ROPE + 8192;
constexpr size_t OFF_WT_IN0 = OFF_WAB + 65536;
constexpr size_t OFF_WT_OUT0 = OFF_WT_IN0 + 7340032;
constexpr size_t OFF_WT_IN1 = OFF_WT_OUT0 + 2097152;
constexpr size_t OFF_WT_UQ = OFF_WT_IN1 + 1572864;
constexpr size_t OFF_WT_UKV = OFF_WT_UQ + 1179648;
constexpr size_t OFF_WT_OUT1 = OFF_WT_UKV + 1048576;
constexpr size_t OFF_WT_PQ = OFF_WT_OUT1 + 2097152;
constexpr size_t OFF_KEYS = OFF_WT_PQ + 4194304;
constexpr size_t OFF_CTXBUF = OFF_KEYS + 524288;
constexpr size_t OFF_HBUF = OFF_CTXBUF + 8388608;
constexpr size_t OFF_AB = OFF_HBUF + 71303168;
constexpr size_t OFF_SCR = OFF_AB + 2228224;
constexpr size_t OFF_GATE = OFF_SCR;
constexpr size_t OFF_Z = OFF_GATE + 106954752;
constexpr size_t OFF_QN = OFF_Z + 35651584;
constexpr size_t OFF_KT = OFF_QN + 35651584;
constexpr size_t OFF_W = OFF_KT + 35651584;
constexpr size_t OFF_UT = OFF_W + 71303168;
constexpr size_t OFF_INTRA = OFF_UT + 71303168;
constexpr size_t OFF_SC = OFF_INTRA + 35651584;
constexpr size_t END_L0 = OFF_SC + 4456448;
constexpr size_t OFF_SELI = OFF_SCR;
constexpr size_t OFF_SELG = OFF_SELI + 17825792;
constexpr size_t OFF_PROJ1 = OFF_SELG + 17825792;
constexpr size_t OFF_Q = OFF_PROJ1 + 53477376;
constexpr size_t OFF_K = OFF_Q + 100663296;
constexpr size_t OFF_VT = OFF_K + 106954752;
constexpr size_t OFF_SELU = OFF_VT + 71303168;
constexpr size_t OFF_TSC = OFF_SELU + 17825792;
constexpr size_t OFF_SSQ = OFF_TSC + 131072;
constexpr size_t OFF_SSQ2 = OFF_SSQ + (size_t)TT * 32;
constexpr size_t END_L1 = OFF_SSQ2 + (size_t)TT * 16;
constexpr size_t OFF_TAB = OFF_PROJ1;
constexpr size_t OFF_BAR = (END_L0 > END_L1 ? END_L0 : END_L1);
constexpr size_t OFF_TAB1 = OFF_BAR + 16384;
constexpr size_t OFF_TSC1 = OFF_TAB1 + 25165824;
constexpr size_t OFF_PQB = OFF_TSC1 + 131072;
constexpr size_t WS_NEED = OFF_PQB + 2 * 9 * 1024 * 4;
constexpr size_t DO_QKV = 0;
constexpr size_t DO_OF = 0;
constexpr size_t DO_OB = 35651584;

struct Params {
  const float *x, *c, *ctx, *c_ctx, *w_mod, *b_mod, *norm1, *norm2, *ev_w_in, *ev_a_conv, *ev_qkv_conv, *ev_a_log,
      *ev_dt_bias, *ev_o_norm, *ev_w_out, *od_w_in, *od_q_norm, *od_kv_norm, *od_w_uq, *od_w_ukv, *od_w_out, *p_w_q,
      *p_keys, *p_u, *p_v, *norm_f;
  float* out;
  char* ws;
};

DI bf16_t f2bf(float x) {
  unsigned u = __float_as_uint(x);
  u += 0x7fffu + ((u >> 16) & 1u);
  return (bf16_t)(u >> 16);
}
DI float bf2f(bf16_t b) { return __uint_as_float(((unsigned)b) << 16); }
typedef float float2v __attribute__((ext_vector_type(2)));
typedef __bf16 bf16x2v __attribute__((ext_vector_type(2)));
DI unsigned pack2(float a, float b) {
  float2v f = {a, b};
  bf16x2v h = __builtin_convertvector(f, bf16x2v);
  return __builtin_bit_cast(unsigned, h);
}
DI float bflo(unsigned u) { return __uint_as_float(u << 16); }
DI float bfhi(unsigned u) { return __uint_as_float(u & 0xffff0000u); }
DI float wave_sum(float v) {
#pragma unroll
  for (int o = 32; o > 0; o >>= 1) v += __shfl_xor(v, o);
  return v;
}
DI float siluf(float x) { return x / (1.f + __expf(-x)); }
DI float softplusf(float x) { return x > 20.f ? x : log1pf(expf(x)); }
DI float sigmoidf(float x) { return 1.f / (1.f + expf(-x)); }
DI int row_mb(int row) { return row < TX ? (row >> 12) : 8; }
#define MFMA32(a, b, c) __builtin_amdgcn_mfma_f32_32x32x16_bf16((a), (b), (c), 0, 0, 0)
#define MFMA16(a, b, c) __builtin_amdgcn_mfma_f32_16x16x32_bf16((a), (b), (c), 0, 0, 0)
DI int crow32(int reg, int h) { return (reg & 3) + 8 * (reg >> 2) + 4 * h; }
DI int xcd_item(int base) { const int b = blockIdx.x, g8 = gridDim.x >> 3; return base + (b & 7) * g8 + (b >> 3); }

DI int g8_lds_byte(int r, int c) {
  int st = (r >> 4) * 2 + (c >> 5), rr = r & 15, cc = c & 31, ob = rr * 64 + cc * 2;
  return st * 1024 + (ob ^ (((ob >> 9) & 1) << 5));
}
DI void g8_stage_rc(int b, int& R, int& C) {
  int st = b / 1024, sb = b % 1024, swz = sb ^ (((sb >> 9) & 1) << 5);
  R = (st >> 1) * 16 + swz / 64; C = (st & 1) * 32 + (swz % 64) / 2;
}
constexpr int G8_HT = 16384;
constexpr int G8_LDS = 8 * G8_HT;
typedef f32x4 acc256_t[2][2][4][2];

template <int SWAPMASK>
DI void gemm256(const bf16_t* __restrict__ A, int lda, const bf16_t* __restrict__ Bt, int ldb, int K, char* smem, const int wave_, acc256_t& acc) {
  int t = TIDX;
  asm volatile("" : "+v"(t));
  const int lane = t & 63, wid = t >> 6, wr = wid >> 2, wc = wid & 3, fr = lane & 15, fq = lane >> 4;
#pragma unroll
  for (int a = 0; a < 2; ++a)
#pragma unroll
    for (int b = 0; b < 2; ++b)
#pragma unroll
      for (int m = 0; m < 4; ++m)
#pragma unroll
        for (int n = 0; n < 2; ++n) acc[a][b][m][n] = f32x4{0.f, 0.f, 0.f, 0.f};
  const __amdgpu_buffer_rsrc_t ars = __builtin_amdgcn_make_buffer_rsrc((void*)A, 0, 256 * lda * 2, 0x00020000);
  const __amdgpu_buffer_rsrc_t brs = __builtin_amdgcn_make_buffer_rsrc((void*)Bt, 0, 256 * ldb * 2, 0x00020000);
  int r0, c0, r1, c1;
  g8_stage_rc(t * 16, r0, c0);
  g8_stage_rc(t * 16 + 8192, r1, c1);
  const int avo0 = (r0 * lda + c0) * 2, avo1 = (r1 * lda + c1) * 2, bvo0 = (r0 * ldb + c0) * 2, bvo1 = (r1 * ldb + c1) * 2;
  const int ahalf = 128 * lda * 2, bhalf = 128 * ldb * 2;
  LAS char* lds = (LAS char*)smem;
#define G8_SA(b, h) (lds + ((b) * 2 + (h)) * G8_HT)
#define G8_SB(b, h) (lds + (4 + (b) * 2 + (h)) * G8_HT)
#define G8_STAGE_A(b, h, kt) { \
    __builtin_amdgcn_raw_ptr_buffer_load_lds(ars, (LAS void*)(G8_SA(b, h) + t * 16), 16, avo0, (h) * ahalf + (kt) * 128, 0, 0); \
    __builtin_amdgcn_raw_ptr_buffer_load_lds(ars, (LAS void*)(G8_SA(b, h) + t * 16 + 8192), 16, avo1, (h) * ahalf + (kt) * 128, 0, 0); }
#define G8_STAGE_B(b, h, kt) { \
    __builtin_amdgcn_raw_ptr_buffer_load_lds(brs, (LAS void*)(G8_SB(b, h) + t * 16), 16, bvo0, (h) * bhalf + (kt) * 128, 0, 0); \
    __builtin_amdgcn_raw_ptr_buffer_load_lds(brs, (LAS void*)(G8_SB(b, h) + t * 16 + 8192), 16, bvo1, (h) * bhalf + (kt) * 128, 0, 0); }
  const int fro = (fr * 64 + fq * 16) ^ ((fr >> 3) << 5);
  const int aoff = wr * 8 * 1024 + fro, boff = wc * 4 * 1024 + fro;
#define G8_LDA(dst, b, h) { _Pragma("unroll") for (int m = 0; m < 4; ++m) _Pragma("unroll") for (int k = 0; k < 2; ++k) \
    dst[m][k] = *(const LAS bf16x8*)(G8_SA(b, h) + aoff + (m * 2 + k) * 1024); }
#define G8_LDB(dst, b, h) { _Pragma("unroll") for (int n = 0; n < 2; ++n) _Pragma("unroll") for (int k = 0; k < 2; ++k) \
    dst[n][k] = *(const LAS bf16x8*)(G8_SB(b, h) + boff + (n * 2 + k) * 1024); }
#define G8_MMA(ai, bj, At_, Bt_) { __builtin_amdgcn_s_setprio(1); \
    _Pragma("unroll") for (int m = 0; m < 4; ++m) _Pragma("unroll") for (int n = 0; n < 2; ++n) _Pragma("unroll") for (int k = 0; k < 2; ++k) \
      acc[ai][bj][m][n] = ((SWAPMASK >> (bj)) & 1) ? MFMA16(Bt_[n][k], At_[m][k], acc[ai][bj][m][n]) : MFMA16(At_[m][k], Bt_[n][k], acc[ai][bj][m][n]); \
    __builtin_amdgcn_s_setprio(0); }
#define G8_WAIT_V(n) asm volatile("s_waitcnt vmcnt(" #n ")" ::: "memory")
#define G8_WAIT_L(n) asm volatile("s_waitcnt lgkmcnt(" #n ")" ::: "memory")
#define G8_BAR __builtin_amdgcn_s_barrier()
#define G8_SCHED __builtin_amdgcn_sched_barrier(0)
  bf16x8 At[4][2], B0[2][2], B1[2][2];
  const int nt = K >> 6;
  G8_STAGE_B(0, 0, 0); G8_STAGE_A(0, 0, 0);
  G8_STAGE_B(0, 1, 0); G8_STAGE_A(0, 1, 0);
  if (wr == 1) G8_BAR;
  G8_WAIT_V(4); G8_BAR;
  G8_STAGE_B(1, 0, 1); G8_STAGE_A(1, 0, 1); G8_STAGE_B(1, 1, 1);
  G8_WAIT_V(6); G8_BAR;
  for (int tt = 0; tt < nt - 2; tt += 2) {
    G8_LDB(B0, 0, 0); G8_SCHED; G8_LDA(At, 0, 0); G8_STAGE_A(1, 1, tt + 1);
    G8_WAIT_L(8); G8_BAR; G8_WAIT_L(0); G8_MMA(0, 0, At, B0); G8_BAR; G8_SCHED;
    G8_LDB(B1, 0, 1); G8_STAGE_B(0, 0, tt + 2);
    G8_BAR; G8_WAIT_L(0); G8_MMA(0, 1, At, B1); G8_BAR;
    G8_LDA(At, 0, 1); G8_STAGE_A(0, 0, tt + 2);
    G8_BAR; G8_WAIT_L(0); G8_MMA(1, 0, At, B0); G8_BAR; G8_SCHED;
    G8_STAGE_B(0, 1, tt + 2);
    G8_WAIT_V(6); G8_BAR; G8_MMA(1, 1, At, B1); G8_BAR;
    G8_LDB(B0, 1, 0); G8_SCHED; G8_LDA(At, 1, 0); G8_STAGE_A(0, 1, tt + 2);
    G8_WAIT_L(8); G8_BAR; G8_WAIT_L(0); G8_MMA(0, 0, At, B0); G8_BAR; G8_SCHED;
    G8_LDB(B1, 1, 1); G8_STAGE_B(1, 0, tt + 3);
    G8_BAR; G8_WAIT_L(0); G8_MMA(0, 1, At, B1); G8_BAR;
    G8_LDA(At, 1, 1); G8_STAGE_A(1, 0, tt + 3);
    G8_BAR; G8_WAIT_L(0); G8_MMA(1, 0, At, B0); G8_BAR; G8_SCHED;
    G8_STAGE_B(1, 1, tt + 3);
    G8_WAIT_V(6); G8_BAR; G8_MMA(1, 1, At, B1); G8_BAR;
  }
  { G8_LDB(B0, 0, 0); G8_LDA(At, 0, 0); G8_STAGE_A(1, 1, nt - 1);
    G8_BAR; G8_WAIT_L(0); G8_MMA(0, 0, At, B0); G8_BAR;
    G8_LDB(B1, 0, 1); G8_BAR; G8_WAIT_L(0); G8_MMA(0, 1, At, B1); G8_BAR;
    G8_LDA(At, 0, 1); G8_WAIT_V(4); G8_BAR; G8_WAIT_L(0); G8_MMA(1, 0, At, B0); G8_MMA(1, 1, At, B1); G8_BAR; }
  { G8_LDB(B0, 1, 0); G8_LDA(At, 1, 0); G8_WAIT_V(2); G8_BAR; G8_WAIT_L(0); G8_MMA(0, 0, At, B0); G8_BAR;
    G8_LDB(B1, 1, 1); G8_WAIT_V(0); G8_BAR; G8_WAIT_L(0); G8_MMA(0, 1, At, B1); G8_BAR;
    G8_LDA(At, 1, 1); G8_BAR; G8_WAIT_L(0); G8_MMA(1, 0, At, B0); G8_MMA(1, 1, At, B1); G8_BAR; }
  if (wr == 0) G8_BAR;
  __syncthreads();
}

DI void store_bf16x8_pair(bf16_t* rowp, const f32x4& v0, const f32x4& v1, int fq) {
  const unsigned a0 = pack2(v0[0], v0[1]), a1 = pack2(v0[2], v0[3]), b0 = pack2(v1[0], v1[1]), b1 = pack2(v1[2], v1[3]);
  const unsigned om = (fq & 1) ? ~0u : 0u;
  const unsigned s0 = b0 ^ ((b0 ^ a0) & om), s1 = b1 ^ ((b1 ^ a1) & om);
  const unsigned r0 = (unsigned)__shfl_xor((int)s0, 16), r1 = (unsigned)__shfl_xor((int)s1, 16);
  const unsigned o0 = a0 ^ ((a0 ^ r0) & om), o1 = a1 ^ ((a1 ^ r1) & om), o2 = r0 ^ ((r0 ^ b0) & om), o3 = r1 ^ ((r1 ^ b1) & om);
  bf16_t* dst = rowp + ((fq & 1) ? 16 + 4 * (fq - 1) : 4 * fq);
  *(uint4*)dst = make_uint4(o0, o1, o2, o3);
}

struct TJob { const float* src; const float* kgain; bf16_t* dst; int ldsrc, K, ntn, tile; float scal; };
DI void tjob_load(const TJob& jb, float* tl, int t) {
  const int kt = jb.tile / jb.ntn, nt = jb.tile % jb.ntn;
  const int k0 = kt * 64, n0 = nt * 64;
#pragma unroll
  for (int e = 0; e < 2; ++e) {
    int kk = (t >> 4) + e * 32, n4 = (t & 15) * 4;
    float4 v = *(const float4*)(jb.src + (size_t)(k0 + kk) * jb.ldsrc + n0 + n4);
    float g = jb.scal * (jb.kgain ? jb.kgain[k0 + kk] : 1.f);
    tl[kk * 65 + n4 + 0] = v.x * g;
    tl[kk * 65 + n4 + 1] = v.y * g;
    tl[kk * 65 + n4 + 2] = v.z * g;
    tl[kk * 65 + n4 + 3] = v.w * g;
  }
}
DI void tjob_store(const TJob& jb, const float* tl, int t) {
  const int kt = jb.tile / jb.ntn, nt = jb.tile % jb.ntn;
  const int k0 = kt * 64, n0 = nt * 64;
  int n = t >> 3, k8 = (t & 7) * 8;
  uint4 o;
  o.x = pack2(tl[(k8 + 0) * 65 + n], tl[(k8 + 1) * 65 + n]);
  o.y = pack2(tl[(k8 + 2) * 65 + n], tl[(k8 + 3) * 65 + n]);
  o.z = pack2(tl[(k8 + 4) * 65 + n], tl[(k8 + 5) * 65 + n]);
  o.w = pack2(tl[(k8 + 6) * 65 + n], tl[(k8 + 7) * 65 + n]);
  *(uint4*)(jb.dst + (size_t)(n0 + n) * jb.K + k0 + k8) = o;
}

DI void phase_prep(const Params& p, char* smem, const int wave_) {
  const int t = TIDX, nb = gridDim.x, bid = blockIdx.x;
  char* ws = p.ws;
  {
    float* sl = (float*)smem;
    float* red = sl + 9 * 1024;
    bool have = false;
    for (int job = bid; job < 192; job += nb) {
      if (!have) {
        for (int i = t; i < 9 * 1024; i += NT) {
          float v = i < 8192 ? p.c[i] : p.c_ctx[i - 8192];
          sl[i] = siluf(v);
        }
        have = true;
      }
      __syncthreads();
      int l = job / 96, ch = job % 96, col = t & 63, kg = t >> 6;
      const float* w = p.w_mod + (size_t)l * 1024 * 6144 + ch * 64 + col;
      float acc[9];
#pragma unroll
      for (int r = 0; r < 9; ++r) acc[r] = 0.f;
      for (int k = kg * 128; k < kg * 128 + 128; ++k) {
        float wv = w[(size_t)k * 6144];
#pragma unroll
        for (int r = 0; r < 9; ++r) acc[r] += sl[r * 1024 + k] * wv;
      }
#pragma unroll
      for (int r = 0; r < 9; ++r) red[(kg * 9 + r) * 64 + col] = acc[r];
      __syncthreads();
      for (int i = t; i < 9 * 64; i += NT) {
        int r = i >> 6, cc = i & 63;
        float s = 0.f;
#pragma unroll
        for (int g = 0; g < 8; ++g) s += red[(g * 9 + r) * 64 + cc];
        int n = ch * 64 + cc;
        ((float*)(ws + OFF_MOD))[((size_t)l * 9 + r) * 6144 + n] = s + p.b_mod[l * 6144 + n];
      }
    }
    __syncthreads();
  }
  {
    float* tl = (float*)smem;
    const float qscale = 0.07216878364870322f * 1.4426950408889634f;
    const int n0_ = 16 * 56, n1_ = 256, n2_ = 16 * 11, n3_ = 6 * 24, n4_ = 4 * 32, n5_ = 256, n6_ = 256, n7_ = 256;
    const int total = n0_ + n1_ + n2_ + n3_ + n4_ + n5_ + n6_ + n7_;
#define TJOB_DECODE(jb, job_) { int j = (job_); \
      if (j < n0_) jb = TJob{p.ev_w_in, nullptr, (bf16_t*)(ws + OFF_WT_IN0), 3600, 1024, 56, j, 1.f}; \
      else if ((j -= n0_) < n1_) jb = TJob{p.ev_w_out, nullptr, (bf16_t*)(ws + OFF_WT_OUT0), 1024, 1024, 16, j, 1.f}; \
      else if ((j -= n1_) < n2_) jb = TJob{p.od_w_in, nullptr, (bf16_t*)(ws + OFF_WT_IN1), 704, 1024, 11, j, 1.f}; \
      else if ((j -= n2_) < n3_) jb = TJob{p.od_w_uq, p.od_q_norm, (bf16_t*)(ws + OFF_WT_UQ), 1536, 384, 24, j, qscale}; \
      else if ((j -= n3_) < n4_) jb = TJob{p.od_w_ukv, p.od_kv_norm, (bf16_t*)(ws + OFF_WT_UKV), 2048, 256, 32, j, 1.f}; \
      else if ((j -= n4_) < n5_) jb = TJob{p.od_w_out, nullptr, (bf16_t*)(ws + OFF_WT_OUT1), 1024, 1024, 16, j, 1.f}; \
      else if ((j -= n5_) < n6_) jb = TJob{p.p_w_q, nullptr, (bf16_t*)(ws + OFF_WT_PQ), 1024, 1024, 16, j, 1.f}; \
      else { j -= n6_; jb = TJob{p.p_w_q + 1024 * 1024, nullptr, (bf16_t*)(ws + OFF_WT_PQ) + 1024 * 1024, 1024, 1024, 16, j, 1.f}; } }
    for (int base = bid * 4; base < total; base += nb * 4) {
      __syncthreads();
#pragma unroll
      for (int q = 0; q < 4; ++q)
        if (base + q < total) { TJob jb; TJOB_DECODE(jb, base + q) tjob_load(jb, tl + q * (64 * 65), t); }
      __syncthreads();
#pragma unroll
      for (int q = 0; q < 4; ++q)
        if (base + q < total) { TJob jb; TJOB_DECODE(jb, base + q) tjob_store(jb, tl + q * (64 * 65), t); }
    }
#undef TJOB_DECODE
  }
  const int gt = bid * NT + t, gs = nb * NT;
  for (int i = gt; i < 2 * 8 * 2 * 128 * 64; i += gs) ((bf16_t*)(ws + OFF_KEYS))[i] = f2bf(p.p_keys[i]);
  for (int i = gt; i < 16 * 1024; i += gs) {
    int n = i >> 10, k = i & 1023;
    ((float*)(ws + OFF_WAB))[i] = p.ev_w_in[(size_t)k * 3600 + 3584 + n];
  }
  for (int i = gt; i < 64 * 1024; i += gs) ((bf16_t*)(ws + OFF_WT_IN1))[704 * 1024 + i] = 0;
  for (int i = gt; i < 64 * 16; i += gs) {
    int pos = i >> 4, f = i & 15;
    float freq = powf(10000.f, -(float)f / 16.f);
    float ang = (float)pos * freq;
    ((float*)(ws + OFF_ROPE))[i] = cosf(ang);
    ((float*)(ws + OFF_ROPE))[1024 + i] = sinf(ang);
  }
}

DI void load_row(const float* __restrict__ row, int lane, float (&v)[16]) {
#pragma unroll
  for (int j = 0; j < 4; ++j) {
    float4 a = *(const float4*)(row + 256 * j + 4 * lane);
    v[4 * j] = a.x; v[4 * j + 1] = a.y; v[4 * j + 2] = a.z; v[4 * j + 3] = a.w;
  }
}
DI void norm_mod(const float (&xv)[16], const float* __restrict__ gain, const float* __restrict__ shift, const float* __restrict__ scale,
                 int lane, float (&hv)[16]) {
  float ss = 0.f;
#pragma unroll
  for (int i = 0; i < 16; ++i) ss += xv[i] * xv[i];
  ss = wave_sum(ss);
  float r = rsqrtf(ss * (1.f / 1024.f) + EPS);
#pragma unroll
  for (int j = 0; j < 4; ++j) {
    float4 g = *(const float4*)(gain + 256 * j + 4 * lane);
    float4 sh = *(const float4*)(shift + 256 * j + 4 * lane);
    float4 sc = *(const float4*)(scale + 256 * j + 4 * lane);
    hv[4 * j + 0] = xv[4 * j + 0] * r * g.x * (1.f + sc.x) + sh.x;
    hv[4 * j + 1] = xv[4 * j + 1] * r * g.y * (1.f + sc.y) + sh.y;
    hv[4 * j + 2] = xv[4 * j + 2] * r * g.z * (1.f + sc.z) + sh.z;
    hv[4 * j + 3] = xv[4 * j + 3] * r * g.w * (1.f + sc.w) + sh.w;
  }
}
DI void store_row_bf16(bf16_t* __restrict__ row, int lane, const float (&v)[16]) {
#pragma unroll
  for (int j = 0; j < 4; ++j) {
    uint2 o;
    o.x = pack2(v[4 * j], v[4 * j + 1]);
    o.y = pack2(v[4 * j + 2], v[4 * j + 3]);
    *(uint2*)(row + 256 * j + 4 * lane) = o;
  }
}

DI void phase_h0(const Params& p, char* smem, const int wave_) {
  const int t = TIDX, lane = t & 63, wv = t >> 6;
  float* wab = (float*)smem;
  for (int i = t; i < 16 * 1024; i += NT) wab[i] = ((const float*)(p.ws + OFF_WAB))[i];
  __syncthreads();
  const float* mod = (const float*)(p.ws + OFF_MOD);
  bf16_t* hbuf = (bf16_t*)(p.ws + OFF_HBUF);
  float* ab = (float*)(p.ws + OFF_AB);
  for (int row = blockIdx.x * 8 + wv; row < TT; row += gridDim.x * 8) {
    const float* xr = row < TX ? p.x + (size_t)row * D : p.ctx + (size_t)(row - TX) * D;
    int mb = row_mb(row);
    float xv[16], hv[16];
    load_row(xr, lane, xv);
    norm_mod(xv, p.norm1, mod + (size_t)mb * 6144, mod + (size_t)mb * 6144 + 1024, lane, hv);
    store_row_bf16(hbuf + (size_t)row * D, lane, hv);
    float sv[16];
#pragma unroll
    for (int n = 0; n < 16; ++n) {
      float s = 0.f;
#pragma unroll
      for (int j = 0; j < 4; ++j) {
        float4 w = *(const float4*)(wab + n * 1024 + 256 * j + 4 * lane);
        s += hv[4 * j] * w.x + hv[4 * j + 1] * w.y + hv[4 * j + 2] * w.z + hv[4 * j + 3] * w.w;
      }
      sv[n] = s;
      __builtin_amdgcn_sched_barrier(0);
    }
#define TR_(d, lo, hi, m, off) { const unsigned ul_ = __float_as_uint(lo), uh_ = __float_as_uint(hi); \
      d = __uint_as_float(ul_ ^ ((ul_ ^ uh_) & (m))) + __shfl_xor(__uint_as_float(uh_ ^ ((uh_ ^ ul_) & (m))), off); }
    {
      const unsigned m0_ = (lane & 1) ? ~0u : 0u, m1_ = (lane & 2) ? ~0u : 0u, m2_ = (lane & 4) ? ~0u : 0u, m3_ = (lane & 8) ? ~0u : 0u;
      float a0, a1, a2, a3, a4, a5, a6, a7, b0, b1, b2, b3, c0, c1;
      TR_(a0, sv[0], sv[1], m0_, 1) TR_(a1, sv[2], sv[3], m0_, 1) TR_(a2, sv[4], sv[5], m0_, 1) TR_(a3, sv[6], sv[7], m0_, 1)
      TR_(a4, sv[8], sv[9], m0_, 1) TR_(a5, sv[10], sv[11], m0_, 1) TR_(a6, sv[12], sv[13], m0_, 1) TR_(a7, sv[14], sv[15], m0_, 1)
      TR_(b0, a0, a1, m1_, 2) TR_(b1, a2, a3, m1_, 2) TR_(b2, a4, a5, m1_, 2) TR_(b3, a6, a7, m1_, 2)
      TR_(c0, b0, b1, m2_, 4) TR_(c1, b2, b3, m2_, 4)
      TR_(sv[0], c0, c1, m3_, 8)
    }
#undef TR_
    float myab = sv[0];
    myab += __shfl_xor(myab, 16);
    myab += __shfl_xor(myab, 32);
    if (lane < 16) ab[(size_t)row * 16 + lane] = myab;
  }
  {
    const bf16_t* wq = (const bf16_t*)(p.ws + OFF_WT_PQ);
    float* pqb = (float*)(p.ws + OFF_PQB);
    for (int j = blockIdx.x * 8 + wv; j < 2 * 9 * 1024; j += gridDim.x * 8) {
      const int layer = j / 9216, rem = j - layer * 9216, mb = rem >> 10, n = rem & 1023;
      const float* sh = mod + (size_t)(layer * 9 + mb) * 6144 + 3 * 1024 + 16 * lane;
      const bf16_t* wrow = wq + ((size_t)layer * 1024 + n) * 1024 + 16 * lane;
      const uint4 w0 = *(const uint4*)wrow, w1 = *(const uint4*)(wrow + 8);
      const unsigned wu[8] = {w0.x, w0.y, w0.z, w0.w, w1.x, w1.y, w1.z, w1.w};
      float sacc = 0.f;
#pragma unroll
      for (int i = 0; i < 8; ++i) sacc += sh[2 * i] * bflo(wu[i]) + sh[2 * i + 1] * bfhi(wu[i]);
      sacc = wave_sum(sacc);
      if (lane == 0) pqb[j] = sacc;
    }
  }
}

DI void phase_hnorm(const Params& p, const float* gain, int layer, int shift_idx, int nrows, const int wave_) {
  const int t = TIDX, lane = t & 63, wv = t >> 6;
  const float* mod = (const float*)(p.ws + OFF_MOD) + (size_t)layer * 9 * 6144;
  bf16_t* hbuf = (bf16_t*)(p.ws + OFF_HBUF);
  for (int row = blockIdx.x * 8 + wv; row < nrows; row += gridDim.x * 8) {
    const float* xr = row < TX ? p.out + (size_t)row * D : (const float*)(p.ws + OFF_CTXBUF) + (size_t)(row - TX) * D;
    int mb = row_mb(row);
    float xv[16], hv[16];
    load_row(xr, lane, xv);
    norm_mod(xv, gain, mod + (size_t)mb * 6144 + shift_idx * 1024, mod + (size_t)mb * 6144 + (shift_idx + 1) * 1024, lane, hv);
    store_row_bf16(hbuf + (size_t)row * D, lane, hv);
  }
}

DI void phase_inproj0(const Params& p, char* smem, const int wave_) {
  const bf16_t* A = (const bf16_t*)(p.ws + OFF_HBUF);
  const bf16_t* Bt = (const bf16_t*)(p.ws + OFF_WT_IN0);
  bf16_t* gate = (bf16_t*)(p.ws + OFF_GATE);
  bf16_t* qkv = (bf16_t*)((char*)p.out + DO_QKV);
  bf16_t* z = (bf16_t*)(p.ws + OFF_Z);
  const int ntn = 14, ntm = TT / 256;
  for (int tbase = 0; tbase < ntm * ntn; tbase += gridDim.x) {
    const int tile = xcd_item(tbase);
    if (tile >= ntm * ntn) continue;
    const int tm = tile / ntn, tn = tile % ntn;
    const int m0 = tm * 256, n0 = tn * 256;
    bf16_t* dst; int ld, nb;
    if (n0 < 1536) { dst = gate; ld = 1536; nb = n0; }
    else if (n0 < 3072) { dst = qkv; ld = 1536; nb = n0 - 1536; }
    else { dst = z; ld = 512; nb = n0 - 3072; }
    acc256_t acc;
    gemm256<3>(A + (size_t)m0 * D, D, Bt + (size_t)n0 * D, D, D, smem, wave_, acc);
    int t = TIDX; asm volatile("" : "+v"(t));
    const int lane = t & 63, wid = t >> 6, wr = wid >> 2, wc = wid & 3, fr = lane & 15, fq = lane >> 4;
#pragma unroll
    for (int ai = 0; ai < 2; ++ai)
#pragma unroll
      for (int m = 0; m < 4; ++m) {
        bf16_t* drow = dst + (size_t)(m0 + ai * 128 + wr * 64 + m * 16 + fr) * ld + nb + wc * 32;
#pragma unroll
        for (int bj = 0; bj < 2; ++bj) store_bf16x8_pair(drow + bj * 128, acc[ai][bj][m][0], acc[ai][bj][m][1], fq);
      }
  }
}

#define LA_(i, j) (UPPER ? A[(63 - (i)) * 68 + (63 - (j))] : A[(i) * 68 + (j)])
#define TI_(i, j) (UPPER ? ((63 - (i)) * 65 + (63 - (j))) : ((i) * 65 + (j)))
template <bool UPPER>
DI void tri_diag_wave(const float* __restrict__ A, float* __restrict__ T32, int lane) {
  int g = lane >> 4, c = lane & 15;
  asm volatile("" : "+v"(g), "+v"(c));
  float tv[16];
#pragma unroll
  for (int i = 0; i < 16; ++i) {
    float acc = (i == c) ? 1.f : 0.f;
#pragma unroll
    for (int j = 0; j < i; ++j) acc -= LA_(16 * g + i, 16 * g + j) * tv[j];
    tv[i] = acc;
  }
#pragma unroll
  for (int i = 0; i < 16; ++i) T32[TI_(16 * g + i, 16 * g + c)] = tv[i];
}
template <bool UPPER, int DD>
DI void tri_block_wave(const float* __restrict__ A, float* __restrict__ T32, int lane, int q) {
  int g = lane >> 4, c = lane & 15;
  asm volatile("" : "+v"(g), "+v"(c));
  const int pb = q + DD;
  f32x4 S = {0.f, 0.f, 0.f, 0.f};
#pragma unroll
  for (int kd = 0; kd < DD; ++kd) {
    const int k = q + kd;
#pragma unroll
    for (int ks = 0; ks < 4; ++ks) {
      float av = LA_(16 * pb + c, 16 * k + 4 * ks + g);
      float bv = T32[TI_(16 * k + 4 * ks + g, 16 * q + c)];
      S = __builtin_amdgcn_mfma_f32_16x16x4f32(av, bv, S, 0, 0, 0);
    }
  }
  f32x4 R = {0.f, 0.f, 0.f, 0.f};
#pragma unroll
  for (int ks = 0; ks < 4; ++ks) {
    float av = T32[TI_(16 * pb + c, 16 * pb + 4 * g + ks)];
    R = __builtin_amdgcn_mfma_f32_16x16x4f32(av, S[ks], R, 0, 0, 0);
  }
#pragma unroll
  for (int e = 0; e < 4; ++e) T32[TI_(16 * pb + 4 * g + e, 16 * q + c)] = -R[e];
}
#undef LA_
#undef TI_

DI int item_row0(int b, int gc) { return gc < 4 ? TX + b * CTXL + gc * 64 : b * SEQ + (gc - 4) * 64; }

DI void phase_g1(const Params& p, char* smem, const int wave_) {
  const int tid0 = TIDX;
  bf16_t* qn = (bf16_t*)smem;
  bf16_t* kn = qn + 64 * 136;
  bf16_t* vn = kn + 64 * 136;
  char* big = (char*)(vn + 64 * 136);
  float* KKs = (float*)big;
  float* QKs = KKs + 64 * 65;
  float* T32f = KKs;
  float* T32b = QKs;
  float* Af = (float*)(big + 33280);
  float* Ab = Af + 64 * 68;
  bf16_t* kbdT = (bf16_t*)big;
  bf16_t* vbT = kbdT + 128 * 72;
  bf16_t* Tf = (bf16_t*)(big + 68096);
  bf16_t* Tb = Tf + 64 * 72;
  float* sc = (float*)(Tb + 64 * 72);
  float *decf = sc, *decb = sc + 64, *betaf = sc + 128, *betab = sc + 192, *ckf = sc + 256, *ckb = sc + 320;
  float* cwq = sc + 384;
  float* cwa = cwq + 1152;

  const bf16_t* gate = (const bf16_t*)(p.ws + OFF_GATE);
  const bf16_t* qkv = (const bf16_t*)((const char*)p.out + DO_QKV);
  const float* ab = (const float*)(p.ws + OFF_AB);
  bf16_t* y = (bf16_t*)(p.ws + OFF_HBUF);
  const float scale = 0.08838834764831845f;

  for (int item = blockIdx.x; item < NITEM; item += gridDim.x) {
    int t = tid0;
    asm volatile("" : "+v"(t));
    const int lane = t & 63, wv = __builtin_amdgcn_readfirstlane(t >> 6), r = lane & 31, h2 = lane >> 5;
    const int b = item / (4 * NCH), hh = (item / NCH) & 3, gc = item % NCH;
    const int row0 = item_row0(b, gc);
    const int L = gc < 4 ? CTXL : SEQ;
    const int tpos0 = gc < 4 ? gc * 64 : (gc - 4) * 64;
    {
      float wst[3];
#pragma unroll
      for (int e = 0; e < 3; ++e) {
        const int idx = t + e * NT;
        const int ten = idx / 384, rem = idx - ten * 384, tap = rem >> 7, ch = rem & 127;
        const float* sp = idx < 1152 ? p.ev_qkv_conv + tap * 1536 + ten * 512 + hh * 128 + ch : p.ev_a_conv + tap * 512 + hh * 128 + ch;
        wst[e] = *sp;
      }
#pragma unroll
      for (int e = 0; e < 3; ++e) cwq[t + e * NT] = wst[e];
    }
    __syncthreads();
    float pre_af = 0.f, pre_abk = 0.f, pre_bfv = 0.f, pre_bbv = 0.f;
    if (wv == 0) {
      const float* abr = ab + (size_t)(row0 + lane) * 16;
      pre_af = abr[hh]; pre_abk = abr[4 + hh]; pre_bfv = abr[8 + hh]; pre_bbv = abr[12 + hh];
    }
    {
      const int i = t >> 3, part = t & 7;
      const int tp = tpos0 + i;
      const bool hasm = tp > 0, hasp = tp < L - 1;
      const int om = hasm ? 1536 : 0, op = hasp ? 1536 : 0;
      const unsigned mm = hasm ? ~0u : 0u, mp = hasp ? ~0u : 0u;
      const size_t rowc = (size_t)(row0 + i);
      const bf16_t* qsrc = qkv + rowc * 1536 + hh * 128 + part * 16;
      const bf16_t* gsrc = gate + rowc * 1536 + hh * 128 + part * 16;
      uint4 rc[3][2], rm[3][2], rp[3][2];
#pragma unroll
      for (int ten = 0; ten < 3; ++ten) {
        const bf16_t* src = qsrc + ten * 512;
        rc[ten][0] = *(const uint4*)(src); rc[ten][1] = *(const uint4*)(src + 8);
        rm[ten][0] = *(const uint4*)(src - om); rm[ten][1] = *(const uint4*)(src - om + 8);
        rp[ten][0] = *(const uint4*)(src + op); rp[ten][1] = *(const uint4*)(src + op + 8);
      }
      uint4 bg[2], cgm[2], cgc[2], cgp[2], xam[2], xac[2], xap[2];
      bg[0] = *(const uint4*)(gsrc); bg[1] = *(const uint4*)(gsrc + 8);
      cgc[0] = *(const uint4*)(gsrc + 512); cgc[1] = *(const uint4*)(gsrc + 512 + 8);
      xac[0] = *(const uint4*)(gsrc + 1024); xac[1] = *(const uint4*)(gsrc + 1024 + 8);
      cgm[0] = *(const uint4*)(gsrc - om + 512); cgm[1] = *(const uint4*)(gsrc - om + 512 + 8);
      xam[0] = *(const uint4*)(gsrc - om + 1024); xam[1] = *(const uint4*)(gsrc - om + 1024 + 8);
      cgp[0] = *(const uint4*)(gsrc + op + 512); cgp[1] = *(const uint4*)(gsrc + op + 512 + 8);
      xap[0] = *(const uint4*)(gsrc + op + 1024); xap[1] = *(const uint4*)(gsrc + op + 1024 + 8);
      __builtin_amdgcn_sched_barrier(0);
#pragma unroll
      for (int ten = 0; ten < 3; ++ten) {
        float v[16];
        const unsigned um[8] = {rm[ten][0].x & mm, rm[ten][0].y & mm, rm[ten][0].z & mm, rm[ten][0].w & mm, rm[ten][1].x & mm, rm[ten][1].y & mm, rm[ten][1].z & mm, rm[ten][1].w & mm};
        const unsigned uc[8] = {rc[ten][0].x, rc[ten][0].y, rc[ten][0].z, rc[ten][0].w, rc[ten][1].x, rc[ten][1].y, rc[ten][1].z, rc[ten][1].w};
        const unsigned up[8] = {rp[ten][0].x & mp, rp[ten][0].y & mp, rp[ten][0].z & mp, rp[ten][0].w & mp, rp[ten][1].x & mp, rp[ten][1].y & mp, rp[ten][1].z & mp, rp[ten][1].w & mp};
        const float* w0 = cwq + ten * 384 + part * 16; const float* w1 = w0 + 128; const float* w2 = w0 + 256;
        float ss = 0.f;
#pragma unroll
        for (int e = 0; e < 8; ++e) {
          float a0 = w0[2 * e] * bflo(um[e]) + w1[2 * e] * bflo(uc[e]) + w2[2 * e] * bflo(up[e]);
          float a1 = w0[2 * e + 1] * bfhi(um[e]) + w1[2 * e + 1] * bfhi(uc[e]) + w2[2 * e + 1] * bfhi(up[e]);
          a0 = siluf(a0); a1 = siluf(a1);
          v[2 * e] = a0; v[2 * e + 1] = a1;
          ss += a0 * a0 + a1 * a1;
        }
        float sc_ = 1.f;
        if (ten < 2) {
          ss += __shfl_xor(ss, 1); ss += __shfl_xor(ss, 2); ss += __shfl_xor(ss, 4);
          sc_ = rsqrtf(ss + EPS);
        }
        uint4 o0, o1;
        o0.x = pack2(v[0] * sc_, v[1] * sc_); o0.y = pack2(v[2] * sc_, v[3] * sc_); o0.z = pack2(v[4] * sc_, v[5] * sc_); o0.w = pack2(v[6] * sc_, v[7] * sc_);
        o1.x = pack2(v[8] * sc_, v[9] * sc_); o1.y = pack2(v[10] * sc_, v[11] * sc_); o1.z = pack2(v[12] * sc_, v[13] * sc_); o1.w = pack2(v[14] * sc_, v[15] * sc_);
        bf16_t* dstl = (ten == 0 ? qn : ten == 1 ? kn : vn) + i * 136 + part * 16;
        *(uint4*)dstl = o0; *(uint4*)(dstl + 8) = o1;
      }
      {
        const int ch0 = hh * 128 + part * 16;
        const unsigned ubg[8] = {bg[0].x, bg[0].y, bg[0].z, bg[0].w, bg[1].x, bg[1].y, bg[1].z, bg[1].w};
        const unsigned ucm[8] = {cgm[0].x & mm, cgm[0].y & mm, cgm[0].z & mm, cgm[0].w & mm, cgm[1].x & mm, cgm[1].y & mm, cgm[1].z & mm, cgm[1].w & mm};
        const unsigned ucc[8] = {cgc[0].x, cgc[0].y, cgc[0].z, cgc[0].w, cgc[1].x, cgc[1].y, cgc[1].z, cgc[1].w};
        const unsigned ucp[8] = {cgp[0].x & mp, cgp[0].y & mp, cgp[0].z & mp, cgp[0].w & mp, cgp[1].x & mp, cgp[1].y & mp, cgp[1].z & mp, cgp[1].w & mp};
        const unsigned uxm[8] = {xam[0].x, xam[0].y, xam[0].z, xam[0].w, xam[1].x, xam[1].y, xam[1].z, xam[1].w};
        const unsigned uxc[8] = {xac[0].x, xac[0].y, xac[0].z, xac[0].w, xac[1].x, xac[1].y, xac[1].z, xac[1].w};
        const unsigned uxp[8] = {xap[0].x, xap[0].y, xap[0].z, xap[0].w, xap[1].x, xap[1].y, xap[1].z, xap[1].w};
        const float* w0 = cwa + part * 16; const float* w1 = w0 + 128; const float* w2 = w0 + 256;
        unsigned o[8];
#pragma unroll
        for (int e = 0; e < 8; ++e) {
          float a0 = w0[2 * e] * bflo(ucm[e]) * bflo(uxm[e]) + w1[2 * e] * bflo(ucc[e]) * bflo(uxc[e]) + w2[2 * e] * bflo(ucp[e]) * bflo(uxp[e]);
          float a1 = w0[2 * e + 1] * bfhi(ucm[e]) * bfhi(uxm[e]) + w1[2 * e + 1] * bfhi(ucc[e]) * bfhi(uxc[e]) + w2[2 * e + 1] * bfhi(ucp[e]) * bfhi(uxp[e]);
          o[e] = pack2(bflo(ubg[e]) * a0, bfhi(ubg[e]) * a1);
        }
        bf16_t* yd = y + rowc * 1024 + ch0;
        *(uint4*)yd = make_uint4(o[0], o[1], o[2], o[3]);
        *(uint4*)(yd + 8) = make_uint4(o[4], o[5], o[6], o[7]);
      }
    }
    if (wv == 0) {
      const float af = pre_af, abk = pre_abk, bfv = pre_bfv, bbv = pre_bbv;
      float gf = -expf(p.ev_a_log[hh]) * softplusf(af + p.ev_dt_bias[hh]);
      float gb = -expf(p.ev_a_log[4 + hh]) * softplusf(abk + p.ev_dt_bias[4 + hh]);
      float bef = sigmoidf(bfv), beb = sigmoidf(bbv);
      float pf = gf, sb = gb;
#pragma unroll
      for (int o = 1; o < 64; o <<= 1) {
        float u = __shfl_up(pf, o);
        if (lane >= o) pf += u;
        float d = __shfl_down(sb, o);
        if (lane + o < 64) sb += d;
      }
      decf[lane] = pf; decb[lane] = sb; betaf[lane] = bef; betab[lane] = beb;
      ckf[lane] = bef * __expf(pf); ckb[lane] = beb * __expf(sb);
      float lastf = __shfl(pf, 63), lastb = __shfl(sb, 0);
      float* scg = (float*)(p.ws + OFF_SC) + (size_t)(item * 2) * 256;
      scg[lane] = scale * __expf(pf);
      scg[64 + lane] = __expf(lastf - pf);
      if (lane == 0) scg[128] = __expf(lastf);
      scg[256 + lane] = scale * __expf(sb);
      scg[256 + 64 + lane] = __expf(lastb - sb);
      if (lane == 0) scg[256 + 128] = __expf(lastb);
    }
    __syncthreads();
    {
      const int which = wv >> 2, mt = (wv >> 1) & 1, nt = wv & 1;
      const bf16_t* Asrc = which ? qn : kn;
      f32x16 acc;
#pragma unroll
      for (int e = 0; e < 16; ++e) acc[e] = 0.f;
#pragma unroll
      for (int kk = 0; kk < 8; ++kk) {
        bf16x8 a = *(const bf16x8*)(Asrc + (mt * 32 + r) * 136 + (2 * kk + h2) * 8);
        bf16x8 bb = *(const bf16x8*)(kn + (nt * 32 + r) * 136 + (2 * kk + h2) * 8);
        acc = MFMA32(a, bb, acc);
      }
      float* dstm = which ? QKs : KKs;
#pragma unroll
      for (int e = 0; e < 16; ++e) dstm[(mt * 32 + crow32(e, h2)) * 65 + nt * 32 + r] = acc[e];
    }
    __syncthreads();
    {
      bf16_t* qg = (bf16_t*)(p.ws + OFF_QN) + (size_t)item * 8192;
#pragma unroll
      for (int e = 0; e < 2; ++e) {
        int c = t + e * NT, row = c >> 4, cc = c & 15;
        *(uint4*)(qg + row * 128 + cc * 8) = *(const uint4*)(qn + row * 136 + cc * 8);
      }
      bf16_t* kg = (bf16_t*)(p.ws + OFF_KT) + (size_t)item * 8192;
      const int d = t >> 2, jg = t & 3;
      unsigned o[8];
#pragma unroll
      for (int e = 0; e < 8; ++e) {
        unsigned lo = kn[(jg * 16 + 2 * e) * 136 + d], hi = kn[(jg * 16 + 2 * e + 1) * 136 + d];
        o[e] = lo | (hi << 16);
      }
      *(uint4*)(kg + d * 64 + jg * 16) = make_uint4(o[0], o[1], o[2], o[3]);
      *(uint4*)(kg + d * 64 + jg * 16 + 8) = make_uint4(o[4], o[5], o[6], o[7]);
    }
    {
      bf16_t* inf_ = (bf16_t*)(p.ws + OFF_INTRA) + (size_t)(item * 2) * 4096;
      bf16_t* inb_ = inf_ + 4096;
      const int i = t >> 3, j8 = (t & 7) * 8;
      const float dfi = decf[i], dbi = decb[i], bfi = betaf[i], bbi = betab[i];
      float af_[8], ab_[8], if_[8], ib_[8];
#pragma unroll
      for (int e = 0; e < 8; ++e) {
        const int j = j8 + e;
        float kk = KKs[i * 65 + j], qk = QKs[i * 65 + j];
        float ef = __expf(fminf(dfi - decf[j], 0.f)), eb = __expf(fminf(dbi - decb[j], 0.f));
        af_[e] = (i > j) ? bfi * kk * ef : 0.f;
        ab_[e] = (i < j) ? bbi * kk * eb : 0.f;
        if_[e] = (i >= j) ? scale * qk * ef : 0.f;
        ib_[e] = (i <= j) ? scale * qk * eb : 0.f;
      }
      *(float4*)(Af + i * 68 + j8) = make_float4(af_[0], af_[1], af_[2], af_[3]);
      *(float4*)(Af + i * 68 + j8 + 4) = make_float4(af_[4], af_[5], af_[6], af_[7]);
      *(float4*)(Ab + i * 68 + j8) = make_float4(ab_[0], ab_[1], ab_[2], ab_[3]);
      *(float4*)(Ab + i * 68 + j8 + 4) = make_float4(ab_[4], ab_[5], ab_[6], ab_[7]);
      *(uint4*)(inf_ + i * 64 + j8) = make_uint4(pack2(if_[0], if_[1]), pack2(if_[2], if_[3]), pack2(if_[4], if_[5]), pack2(if_[6], if_[7]));
      *(uint4*)(inb_ + i * 64 + j8) = make_uint4(pack2(ib_[0], ib_[1]), pack2(ib_[2], ib_[3]), pack2(ib_[4], ib_[5]), pack2(ib_[6], ib_[7]));
    }
    __syncthreads();
    if (wv == 0) tri_diag_wave<false>(Af, T32f, lane);
    else if (wv == 1) tri_diag_wave<true>(Ab, T32b, lane);
    __syncthreads();
    if (wv < 6) { if (wv & 1) tri_block_wave<true, 1>(Ab, T32b, lane, wv >> 1); else tri_block_wave<false, 1>(Af, T32f, lane, wv >> 1); }
    __syncthreads();
    if (wv < 4) { if (wv & 1) tri_block_wave<true, 2>(Ab, T32b, lane, wv >> 1); else tri_block_wave<false, 2>(Af, T32f, lane, wv >> 1); }
    __syncthreads();
    if (wv < 2) { if (wv & 1) tri_block_wave<true, 3>(Ab, T32b, lane, 0); else tri_block_wave<false, 3>(Af, T32f, lane, 0); }
    __syncthreads();
#pragma unroll
    for (int e = 0; e < 8; ++e) {
      int idx = t + e * NT, i = idx >> 6, j = idx & 63;
      Tf[i * 72 + j] = f2bf(((i >> 4) >= (j >> 4)) ? T32f[i * 65 + j] : 0.f);
      Tb[i * 72 + j] = f2bf(((i >> 4) <= (j >> 4)) ? T32b[i * 65 + j] : 0.f);
    }
    __syncthreads();
#pragma unroll 1
    for (int dir = 0; dir < 2; ++dir) {
      const float* ck = dir ? ckb : ckf;
      const float* be = dir ? betab : betaf;
      {
        const int d = t >> 2, jg = t & 3;
        unsigned ok[8], ov[8];
#pragma unroll
        for (int e = 0; e < 8; ++e) {
          int j0 = jg * 16 + 2 * e, j1 = j0 + 1;
          ok[e] = pack2(bf2f(kn[j0 * 136 + d]) * ck[j0], bf2f(kn[j1 * 136 + d]) * ck[j1]);
          ov[e] = pack2(bf2f(vn[j0 * 136 + d]) * be[j0], bf2f(vn[j1 * 136 + d]) * be[j1]);
        }
        *(uint4*)(kbdT + d * 72 + jg * 16) = make_uint4(ok[0], ok[1], ok[2], ok[3]);
        *(uint4*)(kbdT + d * 72 + jg * 16 + 8) = make_uint4(ok[4], ok[5], ok[6], ok[7]);
        *(uint4*)(vbT + d * 72 + jg * 16) = make_uint4(ov[0], ov[1], ov[2], ov[3]);
        *(uint4*)(vbT + d * 72 + jg * 16 + 8) = make_uint4(ov[4], ov[5], ov[6], ov[7]);
      }
      __syncthreads();
      {
        const bf16_t* T = dir ? Tb : Tf;
        const int mt = wv >> 2, nt = wv & 3;
        f32x16 aw, au;
#pragma unroll
        for (int e = 0; e < 16; ++e) { aw[e] = 0.f; au[e] = 0.f; }
#pragma unroll
        for (int kk = 0; kk < 4; ++kk) {
          bf16x8 a = *(const bf16x8*)(T + (mt * 32 + r) * 72 + (2 * kk + h2) * 8);
          bf16x8 bk = *(const bf16x8*)(kbdT + (nt * 32 + r) * 72 + (2 * kk + h2) * 8);
          bf16x8 bv = *(const bf16x8*)(vbT + (nt * 32 + r) * 72 + (2 * kk + h2) * 8);
          aw = MFMA32(bk, a, aw);
          au = MFMA32(a, bv, au);
        }
        bf16_t* wg = (bf16_t*)(p.ws + OFF_W) + (size_t)(item * 2 + dir) * 8192;
        bf16_t* ug = (bf16_t*)(p.ws + OFF_UT) + (size_t)(item * 2 + dir) * 8192;
#pragma unroll
        for (int g = 0; g < 4; ++g) {
          uint2 o;
          o.x = pack2(aw[4 * g], aw[4 * g + 1]);
          o.y = pack2(aw[4 * g + 2], aw[4 * g + 3]);
          *(uint2*)(wg + (mt * 32 + r) * 128 + nt * 32 + 8 * g + 4 * h2) = o;
          o.x = pack2(au[4 * g], au[4 * g + 1]);
          o.y = pack2(au[4 * g + 2], au[4 * g + 3]);
          *(uint2*)(ug + (nt * 32 + r) * 64 + mt * 32 + 8 * g + 4 * h2) = o;
        }
      }
      __syncthreads();
    }
  }
}

DI void phase_g2(const Params& p, char* smem, const int wave_) {
  int t = TIDX;
  asm volatile("" : "+v"(t));
  const int lane = t & 63, wv = t >> 6, l15 = lane & 15, lg = lane >> 4;
  bf16_t* wS = (bf16_t*)smem;
  bf16_t* qS = wS + 64 * 136;
  bf16_t* kTS = qS + 64 * 136;
  bf16_t* inS = kTS + 128 * 72;
  bf16_t* Sbf = inS + 64 * 72;
  bf16_t* vnT = Sbf + 2 * 32 * 136;
  bf16_t* veT = vnT + 32 * 72;
  const int mt = wv >> 1, nt = wv & 1;

  for (int cbase = 0; cbase < 256; cbase += gridDim.x) {
    const int chain = xcd_item(cbase);
    if (chain >= 256) continue;
    const int b = chain >> 5, hh = (chain >> 3) & 3, dir = (chain >> 2) & 1, dvq = chain & 3;
    bf16_t* og = (bf16_t*)((char*)p.out + (dir ? DO_OB : DO_OF));
    __syncthreads();
    f32x4 Sacc[2];
#pragma unroll
    for (int n = 0; n < 2; ++n)
#pragma unroll
      for (int e = 0; e < 4; ++e) Sacc[n][e] = 0.f;
    for (int i = t; i < 32 * 136; i += NT) Sbf[i] = 0;
    int cur = 0;
    auto gc_of = [&](int n) { return dir == 0 ? n : (n < 4 ? 3 - n : 71 - n); };
    auto item_of = [&](int n) { return (b * 4 + hh) * NCH + gc_of(n); };
    uint4 rw0A, rw1A, rq0A, rq1A, rk0A, rk1A, riA, rw0B, rw1B, rq0B, rq1B, rk0B, rk1B, riB;
    uint2 ruA, ruB; float4 rs4A, re4A, rs4B, re4B; float rlastA, rlastB;
#define G2_LOAD_W(n_, S) { \
      const bf16_t* wg_ = (const bf16_t*)(p.ws + OFF_W) + (size_t)(item_of(n_) * 2 + dir) * 8192; \
      rw0##S = *(const uint4*)(wg_ + (size_t)t * 8); rw1##S = *(const uint4*)(wg_ + (size_t)(t + NT) * 8); }
#define G2_STORE_W(S) { \
      *(uint4*)(wS + (t >> 4) * 136 + (t & 15) * 8) = rw0##S; \
      *(uint4*)(wS + ((t + NT) >> 4) * 136 + (t & 15) * 8) = rw1##S; }
#define G2_LOAD_REST(n_, S) { \
      const int it_ = item_of(n_); \
      const bf16_t* qg_ = (const bf16_t*)(p.ws + OFF_QN) + (size_t)it_ * 8192; \
      const bf16_t* kg_ = (const bf16_t*)(p.ws + OFF_KT) + (size_t)it_ * 8192; \
      const bf16_t* ig_ = (const bf16_t*)(p.ws + OFF_INTRA) + (size_t)(it_ * 2 + dir) * 4096; \
      const bf16_t* ug_ = (const bf16_t*)(p.ws + OFF_UT) + (size_t)(it_ * 2 + dir) * 8192; \
      const float* scg_ = (const float*)(p.ws + OFF_SC) + (size_t)(it_ * 2 + dir) * 256; \
      rq0##S = *(const uint4*)(qg_ + (size_t)t * 8); rq1##S = *(const uint4*)(qg_ + (size_t)(t + NT) * 8); \
      rk0##S = *(const uint4*)(kg_ + (size_t)t * 8); rk1##S = *(const uint4*)(kg_ + (size_t)(t + NT) * 8); \
      ri##S = *(const uint4*)(ig_ + (size_t)t * 8); \
      ru##S = *(const uint2*)(ug_ + (dvq * 32 + nt * 16 + l15) * 64 + mt * 16 + 4 * lg); \
      rs4##S = *(const float4*)(scg_ + mt * 16 + 4 * lg); \
      re4##S = *(const float4*)(scg_ + 64 + mt * 16 + 4 * lg); \
      rlast##S = scg_[128]; }
#define G2_STORE_REST(S) { \
      *(uint4*)(qS + (t >> 4) * 136 + (t & 15) * 8) = rq0##S; \
      *(uint4*)(qS + ((t + NT) >> 4) * 136 + (t & 15) * 8) = rq1##S; \
      *(uint4*)(kTS + (t >> 3) * 72 + (t & 7) * 8) = rk0##S; \
      *(uint4*)(kTS + ((t + NT) >> 3) * 72 + (t & 7) * 8) = rk1##S; \
      *(uint4*)(inS + (t >> 3) * 72 + (t & 7) * 8) = ri##S; }
#define G2_STEP(n_, S, T) { \
      const uint2 u_cur = ru##S; const float4 s_cur = rs4##S, e_cur = re4##S; const float last_cur = rlast##S; \
      G2_STORE_REST(S); \
      if ((n_) + 2 < NCH) G2_LOAD_REST((n_) + 2, S); \
      { \
        f32x4 R = {0.f, 0.f, 0.f, 0.f}; \
        const bf16_t* Sb = Sbf + cur * 32 * 136; \
        _Pragma("unroll") for (int kk = 0; kk < 4; ++kk) { \
          bf16x8 a = *(const bf16x8*)(wS + (mt * 16 + l15) * 136 + (4 * kk + lg) * 8); \
          bf16x8 bb = *(const bf16x8*)(Sb + (nt * 16 + l15) * 136 + (4 * kk + lg) * 8); \
          R = MFMA16(a, bb, R); \
        } \
        float v0 = bflo(u_cur.x) - R[0], v1 = bfhi(u_cur.x) - R[1], v2 = bflo(u_cur.y) - R[2], v3 = bfhi(u_cur.y) - R[3]; \
        uint2 o, oe; \
        o.x = pack2(v0, v1); o.y = pack2(v2, v3); \
        oe.x = pack2(v0 * e_cur.x, v1 * e_cur.y); oe.y = pack2(v2 * e_cur.z, v3 * e_cur.w); \
        *(uint2*)(vnT + (nt * 16 + l15) * 72 + mt * 16 + 4 * lg) = o; \
        *(uint2*)(veT + (nt * 16 + l15) * 72 + mt * 16 + 4 * lg) = oe; \
      } \
      __syncthreads(); \
      { \
        const bf16_t* Sb = Sbf + cur * 32 * 136; \
        f32x4 O = {0.f, 0.f, 0.f, 0.f}; \
        _Pragma("unroll") for (int kk = 0; kk < 4; ++kk) { \
          bf16x8 a = *(const bf16x8*)(qS + (mt * 16 + l15) * 136 + (4 * kk + lg) * 8); \
          bf16x8 bb = *(const bf16x8*)(Sb + (nt * 16 + l15) * 136 + (4 * kk + lg) * 8); \
          O = MFMA16(a, bb, O); \
        } \
        O[0] *= s_cur.x; O[1] *= s_cur.y; O[2] *= s_cur.z; O[3] *= s_cur.w; \
        _Pragma("unroll") for (int kk = 0; kk < 2; ++kk) { \
          bf16x8 a = *(const bf16x8*)(inS + (mt * 16 + l15) * 72 + (4 * kk + lg) * 8); \
          bf16x8 bb = *(const bf16x8*)(vnT + (nt * 16 + l15) * 72 + (4 * kk + lg) * 8); \
          O = MFMA16(a, bb, O); \
        } \
        const int row0 = item_row0(b, gc_of(n_)); \
        _Pragma("unroll") for (int e = 0; e < 4; ++e) \
          og[(size_t)(row0 + mt * 16 + 4 * lg + e) * 512 + hh * 128 + dvq * 32 + nt * 16 + l15] = f2bf(O[e]); \
        bf16_t* Sn = Sbf + (cur ^ 1) * 32 * 136; \
        _Pragma("unroll") for (int n2 = 0; n2 < 2; ++n2) { \
          f32x4 sa = Sacc[n2]; \
          sa[0] *= last_cur; sa[1] *= last_cur; sa[2] *= last_cur; sa[3] *= last_cur; \
          _Pragma("unroll") for (int kk = 0; kk < 2; ++kk) { \
            bf16x8 a = *(const bf16x8*)(kTS + (wv * 16 + l15) * 72 + (4 * kk + lg) * 8); \
            bf16x8 bb = *(const bf16x8*)(veT + (n2 * 16 + l15) * 72 + (4 * kk + lg) * 8); \
            sa = MFMA16(a, bb, sa); \
          } \
          Sacc[n2] = sa; \
          uint2 o; \
          o.x = pack2(sa[0], sa[1]); o.y = pack2(sa[2], sa[3]); \
          *(uint2*)(Sn + (n2 * 16 + l15) * 136 + wv * 16 + 4 * lg) = o; \
        } \
      } \
      if ((n_) + 1 < NCH) G2_STORE_W(T); \
      if ((n_) + 3 < NCH) G2_LOAD_W((n_) + 3, T); \
      __syncthreads(); \
      cur ^= 1; }
    G2_LOAD_W(0, A); G2_STORE_W(A);
    G2_LOAD_REST(0, A);
    G2_LOAD_W(1, B); G2_LOAD_REST(1, B);
    G2_LOAD_W(2, A);
    __syncthreads();
#pragma unroll 1
    for (int n = 0; n < NCH; n += 2) {
      G2_STEP(n, A, B)
      G2_STEP(n + 1, B, A)
    }
#undef G2_STEP
  }
}

DI void phase_yb(const Params& p, const int wave_) {
  const int t = TIDX, lane = t & 63, wv = t >> 6;
  const bf16_t* of = (const bf16_t*)((const char*)p.out + DO_OF);
  const bf16_t* ob = (const bf16_t*)((const char*)p.out + DO_OB);
  const bf16_t* z = (const bf16_t*)(p.ws + OFF_Z);
  bf16_t* y = (bf16_t*)(p.ws + OFF_HBUF);
  for (int row = blockIdx.x * 8 + wv; row < TT; row += gridDim.x * 8) {
    uint4 a = *(const uint4*)(of + (size_t)row * 512 + lane * 8);
    uint4 b = *(const uint4*)(ob + (size_t)row * 512 + lane * 8);
    uint4 zz = *(const uint4*)(z + (size_t)row * 512 + lane * 8);
    const unsigned *ua = (const unsigned*)&a, *ub = (const unsigned*)&b, *uz = (const unsigned*)&zz;
    float o[8], ss = 0.f;
#pragma unroll
    for (int e = 0; e < 4; ++e) {
      o[2 * e] = bflo(ua[e]) + bflo(ub[e]);
      o[2 * e + 1] = bfhi(ua[e]) + bfhi(ub[e]);
      ss += o[2 * e] * o[2 * e] + o[2 * e + 1] * o[2 * e + 1];
    }
    ss += __shfl_xor(ss, 1); ss += __shfl_xor(ss, 2); ss += __shfl_xor(ss, 4); ss += __shfl_xor(ss, 8);
    float rr = rsqrtf(ss * (1.f / 128.f) + EPS);
    const float* gn = p.ev_o_norm + (lane & 15) * 8;
    unsigned oo[4];
#pragma unroll
    for (int e = 0; e < 4; ++e) {
      float z0 = bflo(uz[e]), z1 = bfhi(uz[e]);
      oo[e] = pack2(o[2 * e] * rr * gn[2 * e] * siluf(z0), o[2 * e + 1] * rr * gn[2 * e + 1] * siluf(z1));
    }
    *(uint4*)(y + (size_t)row * 1024 + 512 + lane * 8) = make_uint4(oo[0], oo[1], oo[2], oo[3]);
  }
}

DI void phase_outproj(const Params& p, char* smem, int layer, const int wave_) {
  const bf16_t* A = (const bf16_t*)(p.ws + OFF_HBUF);
  const bf16_t* Bt = (const bf16_t*)(p.ws + (layer ? OFF_WT_OUT1 : OFF_WT_OUT0));
  const float* mod = (const float*)(p.ws + OFF_MOD) + (size_t)layer * 9 * 6144;
  float* ctxbuf = (float*)(p.ws + OFF_CTXBUF);
  const int ntm = (layer ? TX : TT) / 256, ntn = 4;
  for (int tbase = 0; tbase < ntm * ntn; tbase += gridDim.x) {
    const int tile = xcd_item(tbase);
    if (tile >= ntm * ntn) continue;
    const int tm = tile / ntn, tn = tile % ntn;
    const int m0 = tm * 256, n0 = tn * 256;
    const int mb = row_mb(m0);
    const float* g = mod + (size_t)mb * 6144 + 2 * 1024;
    acc256_t acc;
    gemm256<3>(A + (size_t)m0 * D, D, Bt + (size_t)n0 * D, D, D, smem, wave_, acc);
    int t = TIDX; asm volatile("" : "+v"(t));
    const int lane = t & 63, wid = t >> 6, wr = wid >> 2, wc = wid & 3, fr = lane & 15, fq = lane >> 4;
    const bool isx = m0 < TX;
    const float* resb = layer ? p.out : (isx ? p.x : p.ctx - (size_t)TX * D);
    float* outb = isx ? p.out : ctxbuf - (size_t)TX * D;
    const float* csc = mod + (size_t)mb * 6144 + 4 * 1024;
    const float* gn2 = p.norm2 + layer * 1024;
    bf16_t* apr = (bf16_t*)(p.ws + OFF_Q);
    float ssl[2][4];
#pragma unroll
    for (int ai = 0; ai < 2; ++ai)
#pragma unroll
      for (int m = 0; m < 4; ++m) ssl[ai][m] = 0.f;
#pragma unroll
    for (int bj = 0; bj < 2; ++bj) {
      const int col = n0 + bj * 128 + wc * 32 + fq * 4;
      const float4 gg0 = *(const float4*)(g + col), gg1 = *(const float4*)(g + col + 16);
      const float4 ca = *(const float4*)(csc + col), cb = *(const float4*)(csc + col + 16);
      const float4 na = *(const float4*)(gn2 + col), nb = *(const float4*)(gn2 + col + 16);
      const f32x4 cc0 = {na.x * (1.f + ca.x), na.y * (1.f + ca.y), na.z * (1.f + ca.z), na.w * (1.f + ca.w)};
      const f32x4 cc1 = {nb.x * (1.f + cb.x), nb.y * (1.f + cb.y), nb.z * (1.f + cb.z), nb.w * (1.f + cb.w)};
#pragma unroll
      for (int ai = 0; ai < 2; ++ai)
#pragma unroll
        for (int m = 0; m < 4; ++m) {
          const size_t rowoff = (size_t)(m0 + ai * 128 + wr * 64 + m * 16 + fr) * D;
          const float4 r0_ = *(const float4*)(resb + rowoff + col), r1_ = *(const float4*)(resb + rowoff + col + 16);
          const f32x4 v0 = acc[ai][bj][m][0], v1 = acc[ai][bj][m][1];
          const f32x4 x0 = {r0_.x + gg0.x * v0[0], r0_.y + gg0.y * v0[1], r0_.z + gg0.z * v0[2], r0_.w + gg0.w * v0[3]};
          const f32x4 x1 = {r1_.x + gg1.x * v1[0], r1_.y + gg1.y * v1[1], r1_.z + gg1.z * v1[2], r1_.w + gg1.w * v1[3]};
          *(float4*)(outb + rowoff + col) = make_float4(x0[0], x0[1], x0[2], x0[3]);
          *(float4*)(outb + rowoff + col + 16) = make_float4(x1[0], x1[1], x1[2], x1[3]);
          ssl[ai][m] += x0[0] * x0[0] + x0[1] * x0[1] + x0[2] * x0[2] + x0[3] * x0[3] + x1[0] * x1[0] + x1[1] * x1[1] + x1[2] * x1[2] + x1[3] * x1[3];
          store_bf16x8_pair(apr + rowoff + n0 + bj * 128 + wc * 32, x0 * cc0, x1 * cc1, fq);
        }
    }
    float* red = (float*)(smem + G8_LDS);
#pragma unroll
    for (int ai = 0; ai < 2; ++ai)
#pragma unroll
      for (int m = 0; m < 4; ++m) {
        float ss = ssl[ai][m];
        ss += __shfl_xor(ss, 16);
        ss += __shfl_xor(ss, 32);
        if (fq == 0) red[(ai * 128 + wr * 64 + m * 16 + fr) * 4 + wc] = ss;
      }
    __syncthreads();
    if (t < 256) {
      const float4 v = *(const float4*)(red + t * 4);
      ((float*)(p.ws + OFF_SSQ2))[(size_t)(m0 + t) * 4 + tn] = (v.x + v.y) + (v.z + v.w);
    }
  }
}

DI unsigned f2ord(float f) { unsigned u = __float_as_uint(f); return (u & 0x80000000u) ? ~u : (u | 0x80000000u); }
DI float ord2f(unsigned u) { return __uint_as_float((u & 0x80000000u) ? (u & 0x7fffffffu) : ~u); }
#define CE_DESC(a, b) { unsigned mx_ = max(a, b), mn_ = min(a, b); a = mx_; b = mn_; }

DI void bitonic_merge16(unsigned (&v)[16]) {
#pragma unroll
  for (int j = 8; j > 0; j >>= 1)
#pragma unroll
    for (int i = 0; i < 16; ++i)
      if ((i & j) == 0) CE_DESC(v[i], v[i | j]);
}
DI void sort16_desc(unsigned (&v)[16]) {
#define S_(i, j) CE_DESC(v[i], v[j]);
  S_(0, 13) S_(1, 12) S_(2, 15) S_(3, 14) S_(4, 8) S_(5, 6) S_(7, 11) S_(9, 10)
  S_(0, 5) S_(1, 7) S_(2, 9) S_(3, 4) S_(6, 13) S_(8, 14) S_(10, 15) S_(11, 12)
  S_(0, 1) S_(2, 3) S_(4, 5) S_(6, 8) S_(7, 9) S_(10, 11) S_(12, 13) S_(14, 15)
  S_(0, 2) S_(1, 3) S_(4, 10) S_(5, 11) S_(6, 7) S_(8, 9) S_(12, 14) S_(13, 15)
  S_(1, 2) S_(3, 12) S_(4, 6) S_(5, 7) S_(8, 10) S_(9, 11) S_(13, 14)
  S_(1, 4) S_(2, 6) S_(5, 8) S_(7, 10) S_(9, 13) S_(11, 14)
  S_(2, 4) S_(3, 6) S_(9, 12) S_(11, 13)
  S_(3, 5) S_(6, 8) S_(7, 9) S_(10, 12)
  S_(3, 4) S_(5, 6) S_(7, 8) S_(9, 10) S_(11, 12)
  S_(6, 7) S_(8, 9)
#undef S_
}
DI void merge_top16(unsigned (&a)[16], const unsigned (&b)[16]) {
#pragma unroll
  for (int i = 0; i < 16; ++i) a[i] = max(a[i], b[15 - i]);
  bitonic_merge16(a);
}
DI void top16_of_64(unsigned (&g0)[16], unsigned (&g1)[16], unsigned (&g2)[16], unsigned (&g3)[16]) {
  sort16_desc(g0); sort16_desc(g1); sort16_desc(g2); sort16_desc(g3);
  merge_top16(g0, g1);
  merge_top16(g2, g3);
  merge_top16(g0, g2);
}
DI void top16set_of_64(unsigned (&g0)[16], unsigned (&g1)[16], unsigned (&g2)[16], unsigned (&g3)[16]) {
  sort16_desc(g0); sort16_desc(g1); sort16_desc(g2); sort16_desc(g3);
  merge_top16(g0, g1);
  merge_top16(g2, g3);
#pragma unroll
  for (int i = 0; i < 16; ++i) g0[i] = max(g0[i], g2[15 - i]);
}


__constant__ unsigned char CAND_AB[64] = {
    0x00, 0x01, 0x02, 0x03, 0x04, 0x05, 0x06, 0x07, 0x08, 0x09, 0x0A, 0x0B, 0x0C, 0x0D, 0x0E, 0x0F,
    0x10, 0x11, 0x12, 0x13, 0x14, 0x15, 0x16, 0x17,
    0x20, 0x21, 0x22, 0x23, 0x24,
    0x30, 0x31, 0x32, 0x33,
    0x40, 0x41, 0x42,
    0x50, 0x51, 0x60, 0x61, 0x70, 0x71,
    0x80, 0x90, 0xA0, 0xB0, 0xC0, 0xD0, 0xE0, 0xF0,
    0, 0, 0, 0, 0, 0, 0, 0, 0, 0, 0, 0, 0, 0};
constexpr int cand_index(int a, int b) {
  int c = 0;
  for (int aa = 0; aa < 16; ++aa)
    for (int bb = 0; bb < 16; ++bb) {
      if (aa == a && bb == b) return c;
      if ((aa + 1) * (bb + 1) <= 16) ++c;
    }
  return c;
}

constexpr int cand_ab(int ci) {
  int c = 0;
  for (int aa = 0; aa < 16; ++aa)
    for (int bb = 0; bb < 16; ++bb)
      if ((aa + 1) * (bb + 1) <= 16) { if (c == ci) return (aa << 4) | bb; ++c; }
  return 0;
}
template <int S>
DI unsigned cand_key(const float (&v1)[16], const float (&v2)[16], int h) {
  constexpr int abA = cand_ab(2 * S), abB = cand_ab(2 * S + 1);
  const float sA = v1[abA >> 4] + v2[abA & 15], sB = v1[abB >> 4] + v2[abB & 15];
  return (f2ord(h ? sB : sA) & ~63u) | (unsigned)(2 * S) | (unsigned)h;
}

DI void phase_peerq(const Params& p, char* smem, int layer, const int wave_) {
  const int tid0 = TIDX;
  const bf16_t* A = (const bf16_t*)(p.ws + OFF_Q);
  const bf16_t* Bt = (const bf16_t*)(p.ws + OFF_WT_PQ) + (size_t)layer * 1024 * 1024;
  const bf16_t* keys = (const bf16_t*)(p.ws + OFF_KEYS) + (size_t)layer * 8 * 2 * 128 * 64;
  int* seli = (int*)(p.ws + OFF_SELI);
  float* selg = (float*)(p.ws + OFF_SELG);
  float* selu = (float*)(p.ws + OFF_SELU);
  const float* tsc = (const float*)(p.ws + (layer ? OFF_TSC1 : OFF_TSC));
  bf16_t* qs = (bf16_t*)smem;
  unsigned char* isc = (unsigned char*)(smem + 135168);
  const int ntm = (layer ? TX : TT) / 256;
  const int ntl = ntm * 4, gsz = gridDim.x, remt = ntl % gsz, fullt = ntl - remt;
  const bool split_tail = remt > 0 && 2 * remt <= gsz;
  for (int tbase = 0; tbase < ntl; tbase += gsz) {
    int tile, hb0 = 0, hb1 = 2;
    if (split_tail && tbase == fullt) {
      const int pos = xcd_item(0);
      if (pos >= 2 * remt) continue;
      tile = fullt + (pos >> 1); hb0 = pos & 1; hb1 = hb0 + 1;
    } else {
      tile = xcd_item(tbase);
      if (tile >= ntl) continue;
    }
    const int tm = tile >> 2, tn = tile & 3;
    const int m0 = tm * 256, n0 = tn * 256;
    {
      acc256_t acc;
      gemm256<3>(A + (size_t)m0 * D, D, Bt + (size_t)n0 * D, D, D, smem, wave_, acc);
      int t = tid0; asm volatile("" : "+v"(t));
      const int lane = t & 63, wid = t >> 6, wr = wid >> 2, wc = wid & 3, fr = lane & 15, fq = lane >> 4;
      const float* pqb = (const float*)(p.ws + OFF_PQB) + (size_t)(layer * 9 + row_mb(m0)) * 1024 + n0 + wc * 32 + fq * 4;
      float4 bias[2][2];
#pragma unroll
      for (int bj = 0; bj < 2; ++bj)
#pragma unroll
        for (int n = 0; n < 2; ++n) bias[bj][n] = *(const float4*)(pqb + bj * 128 + n * 16);
#pragma unroll
      for (int ai = 0; ai < 2; ++ai)
#pragma unroll
        for (int m = 0; m < 4; ++m) {
          const int rl = ai * 128 + wr * 64 + m * 16 + fr;
          const float4 sq = *(const float4*)((const float*)(p.ws + OFF_SSQ2) + (size_t)(m0 + rl) * 4);
          const float rr = rsqrtf(((sq.x + sq.y) + (sq.z + sq.w)) * (1.f / 1024.f) + EPS);
          bf16_t* qd = qs + rl * 264 + wc * 32 + fq * 4;
#pragma unroll
          for (int bj = 0; bj < 2; ++bj)
#pragma unroll
            for (int n = 0; n < 2; ++n) {
              const f32x4 v = acc[ai][bj][m][n];
              const float4 bb = bias[bj][n];
              *(uint2*)(qd + bj * 128 + n * 16) = make_uint2(pack2(v[0] * rr + bb.x, v[1] * rr + bb.y), pack2(v[2] * rr + bb.z, v[3] * rr + bb.w));
            }
        }
    }
    __syncthreads();
#pragma unroll 1
    for (int hb = hb0; hb < hb1; ++hb) {
    int t = tid0;
    asm volatile("" : "+v"(t));
    const int lane = t & 63, wv = t >> 6, r = lane & 31, h = lane >> 5;
    const int hd = tn * 2 + hb;
    unsigned top0[16], top1[16];
#pragma unroll
    for (int half = 0; half < 2; ++half) {
      f32x16 acc[4];
#pragma unroll
      for (int m = 0; m < 4; ++m)
#pragma unroll
        for (int e = 0; e < 16; ++e) acc[m][e] = 0.f;
      const bf16_t* kb = keys + (size_t)((hd * 2 + half) * 128) * 64;
#pragma unroll
      for (int kk = 0; kk < 4; ++kk) {
        bf16x8 bq = *(const bf16x8*)(qs + (wv * 32 + r) * 264 + hb * 128 + half * 64 + 16 * kk + 8 * h);
#pragma unroll
        for (int m = 0; m < 4; ++m) {
          bf16x8 ak = *(const bf16x8*)(kb + (m * 32 + r) * 64 + 16 * kk + 8 * h);
          acc[m] = MFMA32(ak, bq, acc[m]);
        }
      }
      unsigned g0[16], g1[16], g2[16], g3[16];
#pragma unroll
      for (int e = 0; e < 16; ++e) {
        g0[e] = (f2ord(acc[0][e]) & ~127u) | (unsigned)(0 + crow32(e, h));
        g1[e] = (f2ord(acc[1][e]) & ~127u) | (unsigned)(32 + crow32(e, h));
        g2[e] = (f2ord(acc[2][e]) & ~127u) | (unsigned)(64 + crow32(e, h));
        g3[e] = (f2ord(acc[3][e]) & ~127u) | (unsigned)(96 + crow32(e, h));
      }
      top16_of_64(g0, g1, g2, g3);
      unsigned pp[16];
#pragma unroll
      for (int i = 0; i < 16; ++i) pp[i] = __shfl_xor(g0[i], 32);
      merge_top16(g0, pp);
      if (half == 0) {
#pragma unroll
        for (int i = 0; i < 16; ++i) top0[i] = g0[i];
      } else {
#pragma unroll
        for (int i = 0; i < 16; ++i) top1[i] = g0[i];
      }
    }
#pragma unroll
    for (int i = 0; i < 16; ++i) {
      isc[t * 32 + i] = (unsigned char)(top0[i] & 127u);
      isc[t * 32 + 16 + i] = (unsigned char)(top1[i] & 127u);
    }
    float v1[16], v2[16];
#pragma unroll
    for (int i = 0; i < 16; ++i) { v1[i] = ord2f(top0[i] & ~127u); v2[i] = ord2f(top1[i] & ~127u); }
    unsigned c0[16], c1[16];
    c0[0] = cand_key<0>(v1, v2, h); c0[1] = cand_key<1>(v1, v2, h); c0[2] = cand_key<2>(v1, v2, h); c0[3] = cand_key<3>(v1, v2, h);
    c0[4] = cand_key<4>(v1, v2, h); c0[5] = cand_key<5>(v1, v2, h); c0[6] = cand_key<6>(v1, v2, h); c0[7] = cand_key<7>(v1, v2, h);
    c0[8] = cand_key<8>(v1, v2, h); c0[9] = cand_key<9>(v1, v2, h); c0[10] = cand_key<10>(v1, v2, h); c0[11] = cand_key<11>(v1, v2, h);
    c0[12] = cand_key<12>(v1, v2, h); c0[13] = cand_key<13>(v1, v2, h); c0[14] = cand_key<14>(v1, v2, h); c0[15] = cand_key<15>(v1, v2, h);
    c1[0] = cand_key<16>(v1, v2, h); c1[1] = cand_key<17>(v1, v2, h); c1[2] = cand_key<18>(v1, v2, h); c1[3] = cand_key<19>(v1, v2, h);
    c1[4] = cand_key<20>(v1, v2, h); c1[5] = cand_key<21>(v1, v2, h); c1[6] = cand_key<22>(v1, v2, h); c1[7] = cand_key<23>(v1, v2, h);
    c1[8] = cand_key<24>(v1, v2, h);
#pragma unroll
    for (int i = 9; i < 16; ++i) c1[i] = 0u;
    sort16_desc(c0); sort16_desc(c1);
    merge_top16(c0, c1);
    {
      unsigned pq[16];
#pragma unroll
      for (int i = 0; i < 16; ++i) pq[i] = __shfl_xor(c0[i], 32);
#pragma unroll
      for (int i = 0; i < 16; ++i) c0[i] = max(c0[i], pq[15 - i]);
    }
    unsigned umx = c0[0];
#pragma unroll
    for (int i = 1; i < 16; ++i) umx = max(umx, c0[i]);
    float sc[16], mx = ord2f(umx & ~63u), sum = 0.f;
#pragma unroll
    for (int i = 0; i < 16; ++i) { sc[i] = __expf(ord2f(c0[i] & ~63u) - mx); sum += sc[i]; }
    float inv = 1.f / sum;
    const int row = m0 + wv * 32 + r;
    int* di = seli + ((size_t)row * 8 + hd) * 16 + 8 * h;
    float* dg = selg + ((size_t)row * 8 + hd) * 16 + 8 * h;
    float* du = selu + ((size_t)row * 8 + hd) * 16 + 8 * h;
    int exv[8];
    float uuv[8], ggv[8];
#pragma unroll
    for (int i = 0; i < 8; ++i) {
      const unsigned s_ = c0[i];
      const float g_ = sc[i] * inv;
      unsigned ab = CAND_AB[s_ & 63u];
      int i1 = isc[t * 32 + (ab >> 4)], i2 = isc[t * 32 + 16 + (ab & 15)];
      const int ex = i1 * 128 + i2;
      exv[i] = ex;
      uuv[i] = tsc[ex];
      ggv[i] = g_ * tsc[16384 + ex];
    }
    *(int4*)di = make_int4(exv[0], exv[1], exv[2], exv[3]); *(int4*)(di + 4) = make_int4(exv[4], exv[5], exv[6], exv[7]);
    *(float4*)du = make_float4(uuv[0], uuv[1], uuv[2], uuv[3]); *(float4*)(du + 4) = make_float4(uuv[4], uuv[5], uuv[6], uuv[7]);
    *(float4*)dg = make_float4(ggv[0], ggv[1], ggv[2], ggv[3]); *(float4*)(dg + 4) = make_float4(ggv[4], ggv[5], ggv[6], ggv[7]);
    }
    __syncthreads();
  }
}

DI float gelu_exact(float x) { return 0.5f * x * (1.f + erff(x * 0.7071067811865476f)); }
DI float blendf(float a, float b, unsigned m) {
  unsigned ua = __float_as_uint(a), ub = __float_as_uint(b);
  return __uint_as_float(ua ^ ((ua ^ ub) & m));
}
DI float wave_max(float v) {
#pragma unroll
  for (int o = 32; o > 0; o >>= 1) v = fmaxf(v, __shfl_xor(v, o));
  return v;
}

typedef float f32x32v __attribute__((ext_vector_type(32)));
typedef unsigned u32x6v __attribute__((ext_vector_type(6)));
constexpr int TROW = 768;
constexpr int TVOFF = TROW;
constexpr int TPAIR = 2 * TROW;
DI void convert_tables(const Params& p, int layer, int part, int nparts, const int wave_) {
  const int wv = wave_;
  char* tab = p.ws + (layer ? OFF_TAB1 : OFF_TAB);
  float* tsc = (float*)(p.ws + (layer ? OFF_TSC1 : OFF_TSC));
  for (int pr2 = part * 8 + wv; pr2 < 16384; pr2 += nparts * 8) {
    int lane = TIDX & 63;
    asm volatile("" : "+v"(lane));
    const int l31 = lane & 31, rr = pr2 * 2 + (lane >> 5);
    const float* src = ((rr >> 14) ? p.p_v : p.p_u) + (size_t)layer * 16384 * 1024 + (size_t)(rr & 16383) * 1024 + 32 * l31;
    float v[32];
    float m = 0.f;
#pragma unroll
    for (int j = 0; j < 8; ++j) {
      float4 a = *(const float4*)(src + 4 * j);
      v[4 * j] = a.x; v[4 * j + 1] = a.y; v[4 * j + 2] = a.z; v[4 * j + 3] = a.w;
      m = fmaxf(m, fmaxf(fmaxf(fabsf(a.x), fabsf(a.y)), fmaxf(fabsf(a.z), fabsf(a.w))));
    }
#pragma unroll
    for (int o = 16; o > 0; o >>= 1) m = fmaxf(m, __shfl_xor(m, o));
    const float scale = m > 0.f ? m * (1.f / 7.5f) : 1.f;
    const float inv = 1.f / scale;
    unsigned w[7] = {0u, 0u, 0u, 0u, 0u, 0u, 0u};
#pragma unroll
    for (int i = 0; i < 32; ++i) {
      const float a = fminf(fabsf(v[i]) * inv, 7.5f);
      const float c = a < 2.f ? __builtin_rintf(a * 8.f) : (a < 4.f ? __builtin_rintf(a * 4.f) + 8.f : __builtin_rintf(a * 2.f) + 16.f);
      unsigned code = (unsigned)c;
      code = code > 31u ? 31u : code;
      code |= (__float_as_uint(v[i]) >> 31) << 5;
      const int bit = 6 * i, d = bit >> 5, sh = bit & 31;
      w[d] |= code << sh;
      if (sh > 26) w[d + 1] |= code >> (32 - sh);
    }
    char* dst = tab + (size_t)(rr & 16383) * TPAIR + (rr >> 14) * TROW + l31 * 24;
    *(uint2*)(dst) = make_uint2(w[0], w[1]);
    *(uint2*)(dst + 8) = make_uint2(w[2], w[3]);
    *(uint2*)(dst + 16) = make_uint2(w[4], w[5]);
    if (l31 == 0) tsc[rr] = scale;
  }
}

struct Row6 { uint2 a, b, c; };
DI Row6 row6_load(const __amdgpu_buffer_rsrc_t trs, int voff, int soff) {
  Row6 r;
  typedef unsigned u32x2v __attribute__((ext_vector_type(2)));
  u32x2v x0 = __builtin_amdgcn_raw_buffer_load_b64(trs, voff, soff, 0);
  u32x2v x1 = __builtin_amdgcn_raw_buffer_load_b64(trs, voff + 8, soff, 0);
  u32x2v x2 = __builtin_amdgcn_raw_buffer_load_b64(trs, voff + 16, soff, 0);
  r.a = make_uint2(x0[0], x0[1]); r.b = make_uint2(x1[0], x1[1]); r.c = make_uint2(x2[0], x2[1]);
  return r;
}
typedef __bf16 bf16x32v __attribute__((ext_vector_type(32)));
DI float row6_dot(const Row6& r, const unsigned (&hp)[16]) {
  u32x6v q = {r.a.x, r.a.y, r.b.x, r.b.y, r.c.x, r.c.y};
  const bf16x32v y = __builtin_amdgcn_cvt_scalef32_pk32_bf16_fp6(q, 1.0f);
  float s0 = 0.f, s1 = 0.f;
#pragma unroll
  for (int i = 0; i < 8; ++i) {
    s0 = __builtin_amdgcn_fdot2_f32_bf16(__builtin_bit_cast(bf16x2v, hp[2 * i]), bf16x2v{y[4 * i], y[4 * i + 1]}, s0, false);
    s1 = __builtin_amdgcn_fdot2_f32_bf16(__builtin_bit_cast(bf16x2v, hp[2 * i + 1]), bf16x2v{y[4 * i + 2], y[4 * i + 3]}, s1, false);
  }
  return s0 + s1;
}
DI f32x32v row6_decode(const Row6& r) {
  u32x6v q = {r.a.x, r.a.y, r.b.x, r.b.y, r.c.x, r.c.y};
  return __builtin_amdgcn_cvt_scalef32_pk32_f32_fp6(q, 1.0f);
}
DI int pick_voff(int ids, int k, int half, int l31) {
  const int ea = __builtin_amdgcn_readlane(ids, k & 63), eb = __builtin_amdgcn_readlane(ids, (k + 1) & 63);
  return (half ? eb : ea) * TPAIR + l31 * 24;
}

DI void convert_in_tail(const Params& p, int layer, int ntiles, const int wave_, int split = 1) {
  const int g = gridDim.x, rem0 = ntiles % g, rem = (split * rem0 <= g) ? split * rem0 : rem0;
  const int pos = (blockIdx.x & 7) * (g >> 3) + (blockIdx.x >> 3);
  if (rem == 0) convert_tables(p, layer, blockIdx.x, g, wave_);
  else if (pos >= rem) convert_tables(p, layer, pos - rem, g - rem, wave_);
}

DI void phase_gather(const Params& p, int layer, const int wave_) {
  const int wv = wave_;
  const float* mod = (const float*)(p.ws + OFF_MOD) + (size_t)layer * 9 * 6144;
  const float* mod1 = (const float*)(p.ws + OFF_MOD) + (size_t)9 * 6144;
  const __amdgpu_buffer_rsrc_t trs = __builtin_amdgcn_make_buffer_rsrc((void*)(p.ws + (layer ? OFF_TAB1 : OFF_TAB)), 0, 16384 * TPAIR, 0x00020000);
  const int* seli = (const int*)(p.ws + OFF_SELI);
  const float* selg = (const float*)(p.ws + OFF_SELG);
  const float* selu = (const float*)(p.ws + OFF_SELU);
  bf16_t* hbuf = (bf16_t*)(p.ws + OFF_HBUF);
  const int nrows = layer ? TX : TT;
  unsigned* qhead = (unsigned*)(p.ws + OFF_BAR) + 3584 + 64 * layer;
  const int nstatic = gridDim.x * 8;
  for (int row = blockIdx.x * 8 + wv; row < nrows;) {
    int lane = TIDX & 63;
    asm volatile("" : "+v"(lane));
    const int l31 = lane & 31, half = lane >> 5;
    const int pidx = 2 * (((lane >> 4) & 1) * 2 + ((lane >> 3) & 1)) + half;
    float* xr = (row < TX ? p.out + (size_t)row * D : (float*)(p.ws + OFF_CTXBUF) + (size_t)(row - TX) * D) + 32 * l31;
    const int mb = row_mb(row);
    const float* mrow = mod + (size_t)mb * 6144 + 32 * l31;
    unsigned hp[16];
    f32x32v acc;
    {
      float xv[32];
      float ss = 0.f;
#pragma unroll
      for (int j = 0; j < 8; ++j) {
        float4 a = *(const float4*)(xr + 4 * j);
        xv[4 * j] = a.x; xv[4 * j + 1] = a.y; xv[4 * j + 2] = a.z; xv[4 * j + 3] = a.w;
        ss += a.x * a.x + a.y * a.y + a.z * a.z + a.w * a.w;
      }
      ss = wave_sum(ss) * 0.5f;
      const float rr = rsqrtf(ss * (1.f / 1024.f) + EPS);
      const float* gn = p.norm2 + layer * 1024 + 32 * l31;
#pragma unroll
      for (int i = 0; i < 16; ++i)
        hp[i] = pack2(xv[2 * i] * rr * gn[2 * i] * (1.f + mrow[4 * 1024 + 2 * i]) + mrow[3 * 1024 + 2 * i],
                      xv[2 * i + 1] * rr * gn[2 * i + 1] * (1.f + mrow[4 * 1024 + 2 * i + 1]) + mrow[3 * 1024 + 2 * i + 1]);
    }
#pragma unroll
    for (int i = 0; i < 32; ++i) acc[i] = 0.f;
    const int* si = seli + (size_t)row * 128;
    const float* sg = selg + (size_t)row * 128 + pidx;
    const float* su = selu + (size_t)row * 128 + pidx;
    asm volatile("" ::: "memory");
    const int ia = si[lane], ib = si[64 + lane];
    Row6 UU[4], VV[4];
#pragma unroll
    for (int j = 0; j < 4; ++j) {
      const int vo = pick_voff(ia, 2 * j, half, l31);
      UU[j] = row6_load(trs, vo, 0);
      VV[j] = row6_load(trs, vo, TVOFF);
    }
    const unsigned m4 = (lane & 16) ? ~0u : 0u, m3 = (lane & 8) ? ~0u : 0u;
#define GATHER_GROUP(g_, MORE) { \
      const int isn = ((g_) + 1) < 8 ? ia : ib; \
      const int kb = ((g_) + 1) << 3; \
      const float su_g = su[(g_) * 8], sg_g = sg[(g_) * 8]; \
      float d[4]; \
      _Pragma("unroll") for (int j = 0; j < 4; ++j) { \
        d[j] = row6_dot(UU[j], hp); \
        if (MORE) UU[j] = row6_load(trs, pick_voff(isn, kb + 2 * j, half, l31), 0); \
        __builtin_amdgcn_sched_barrier(0); \
      } \
      float e2[2], e1; \
      _Pragma("unroll") for (int q = 0; q < 2; ++q) { \
        float keep = blendf(d[q], d[q + 2], m4), send = blendf(d[q + 2], d[q], m4); \
        e2[q] = keep + __shfl_xor(send, 16); \
      } \
      { float keep = blendf(e2[0], e2[1], m3), send = blendf(e2[1], e2[0], m3); e1 = keep + __shfl_xor(send, 8); } \
      e1 += __shfl_xor(e1, 4); e1 += __shfl_xor(e1, 2); e1 += __shfl_xor(e1, 1); \
      const int ai = __float_as_int(sg_g * gelu_exact(su_g * e1)); \
      _Pragma("unroll") for (int j = 0; j < 4; ++j) { \
        const int sl = 16 * (j >> 1) + 8 * (j & 1); \
        const int ca = __builtin_amdgcn_readlane(ai, sl), cb = __builtin_amdgcn_readlane(ai, 32 + sl); \
        const float cq = __int_as_float(half ? cb : ca); \
        const f32x32v y = row6_decode(VV[j]); \
        if (MORE) VV[j] = row6_load(trs, pick_voff(isn, kb + 2 * j, half, l31), TVOFF); \
        acc += y * cq; \
        __builtin_amdgcn_sched_barrier(0); \
      } }
#pragma unroll 1
    for (int g = 0; g < 15; ++g) GATHER_GROUP(g, true)
    unsigned ticket = 0u;
    if (lane == 0) ticket = __hip_atomic_fetch_add(qhead, 1u, __ATOMIC_RELAXED, __HIP_MEMORY_SCOPE_AGENT);
    GATHER_GROUP(15, false)
#undef GATHER_GROUP
    const int next_row = nstatic + (int)__builtin_amdgcn_readfirstlane(ticket);
    asm volatile("" ::: "memory");
    float xn[16];
    {
      float tot[16];
#pragma unroll
      for (int i = 0; i < 16; ++i) {
        const float lo = acc[i], hi = acc[16 + i];
        const float mine = half ? hi : lo, other = half ? lo : hi;
        tot[i] = mine + __shfl_xor(other, 32);
      }
      const float* xq = xr + 16 * half;
      const float* mq = mrow + 5 * 1024 + 16 * half;
#pragma unroll
      for (int j = 0; j < 4; ++j) {
        float4 a = *(const float4*)(xq + 4 * j);
        xn[4 * j] = a.x + mq[4 * j] * tot[4 * j]; xn[4 * j + 1] = a.y + mq[4 * j + 1] * tot[4 * j + 1];
        xn[4 * j + 2] = a.z + mq[4 * j + 2] * tot[4 * j + 2]; xn[4 * j + 3] = a.w + mq[4 * j + 3] * tot[4 * j + 3];
      }
    }
    const int c0 = 32 * l31 + 16 * half;
    float s2 = 0.f;
#pragma unroll
    for (int i = 0; i < 16; ++i) s2 += xn[i] * xn[i];
    s2 = wave_sum(s2);
    const float rr = rsqrtf(s2 * (1.f / 1024.f) + EPS);
    float* xo = xr + 16 * half;
    if (layer == 0) {
#pragma unroll
      for (int j = 0; j < 4; ++j) *(float4*)(xo + 4 * j) = make_float4(xn[4 * j], xn[4 * j + 1], xn[4 * j + 2], xn[4 * j + 3]);
      const float* gn = p.norm1 + 1024 + c0;
      const float* m1 = mod1 + (size_t)mb * 6144 + c0;
      unsigned o[8];
#pragma unroll
      for (int i = 0; i < 8; ++i)
        o[i] = pack2(xn[2 * i] * rr * gn[2 * i] * (1.f + m1[1024 + 2 * i]) + m1[2 * i],
                     xn[2 * i + 1] * rr * gn[2 * i + 1] * (1.f + m1[1024 + 2 * i + 1]) + m1[2 * i + 1]);
      bf16_t* hd = hbuf + (size_t)row * D + c0;
      *(uint4*)hd = make_uint4(o[0], o[1], o[2], o[3]);
      *(uint4*)(hd + 8) = make_uint4(o[4], o[5], o[6], o[7]);
    } else {
      const float* gn = p.norm_f + c0;
#pragma unroll
      for (int j = 0; j < 4; ++j)
        *(float4*)(xo + 4 * j) = make_float4(xn[4 * j] * rr * gn[4 * j], xn[4 * j + 1] * rr * gn[4 * j + 1], xn[4 * j + 2] * rr * gn[4 * j + 2], xn[4 * j + 3] * rr * gn[4 * j + 3]);
    }
    row = next_row;
  }
}

DI void phase_inproj1(const Params& p, char* smem, const int wave_) {
  const bf16_t* A = (const bf16_t*)(p.ws + OFF_HBUF);
  const bf16_t* Bt = (const bf16_t*)(p.ws + OFF_WT_IN1);
  bf16_t* pr = (bf16_t*)(p.ws + OFF_PROJ1);
  const int ntn = 3, ntm = TT / 256;
  for (int tbase = 0; tbase < ntm * ntn; tbase += gridDim.x) {
    const int tile = xcd_item(tbase);
    if (tile >= ntm * ntn) continue;
    const int tm = tile / ntn, tn = tile % ntn;
    const int m0 = tm * 256, n0 = tn * 256;
    acc256_t acc;
    gemm256<3>(A + (size_t)m0 * D, D, Bt + (size_t)n0 * D, D, D, smem, wave_, acc);
    int t = TIDX; asm volatile("" : "+v"(t));
    const int lane = t & 63, wid = t >> 6, wr = wid >> 2, wc = wid & 3, fr = lane & 15, fq = lane >> 4;
    float* red = (float*)(smem + G8_LDS);
#pragma unroll
    for (int ai = 0; ai < 2; ++ai)
#pragma unroll
      for (int m = 0; m < 4; ++m) {
        const int rl = ai * 128 + wr * 64 + m * 16 + fr;
        bf16_t* drow = pr + (size_t)(m0 + rl) * 768 + n0 + wc * 32;
#pragma unroll
        for (int bj = 0; bj < 2; ++bj) {
          const f32x4 a = acc[ai][bj][m][0], c = acc[ai][bj][m][1];
          float ss = a[0] * a[0] + a[1] * a[1] + a[2] * a[2] + a[3] * a[3] + c[0] * c[0] + c[1] * c[1] + c[2] * c[2] + c[3] * c[3];
          ss += __shfl_xor(ss, 16);
          ss += __shfl_xor(ss, 32);
          if (fq == 0) red[(rl * 2 + bj) * 4 + wc] = ss;
          store_bf16x8_pair(drow + bj * 128, a, c, fq);
        }
      }
    __syncthreads();
    {
      const int row = t >> 1, bj = t & 1;
      const float4 v = *(const float4*)(red + (row * 2 + bj) * 4);
      const int slot = tn == 0 ? (bj ? 4 : 0) : (tn == 1 ? (bj ? 2 : 1) : (bj ? -1 : 3));
      if (slot >= 0) ((float*)(p.ws + OFF_SSQ))[(size_t)(m0 + row) * 8 + slot] = (v.x + v.y) + (v.z + v.w);
    }
  }
}

DI void phase_upproj_q(const Params& p, char* smem, const int wave_) {
  const bf16_t* pr = (const bf16_t*)(p.ws + OFF_PROJ1);
  const bf16_t* wq = (const bf16_t*)(p.ws + OFF_WT_UQ);
  bf16_t* Qb = (bf16_t*)(p.ws + OFF_Q);
  const float* ropec = (const float*)(p.ws + OFF_ROPE);
  float* rs = (float*)(smem + G8_LDS);
  float* rtab = rs + 256;
  { const int t0_ = TIDX; for (int i = t0_; i < 2048; i += NT) rtab[i] = ropec[i]; }
  const int nq = (TX / 256) * 6;
  for (int tbase = 0; tbase < nq; tbase += gridDim.x) {
    const int tile = xcd_item(tbase);
    if (tile >= nq) continue;
    const int tm = tile / 6, tn = tile % 6;
    const int m0 = tm * 256, n0 = tn * 256;
    __syncthreads();
    {
      const int t_ = TIDX;
      if (t_ < 256) { const float* sq = (const float*)(p.ws + OFF_SSQ) + (size_t)(m0 + t_) * 8; rs[t_] = rsqrtf((sq[0] + sq[4] + sq[1]) * (1.f / 384.f) + EPS); }
    }
    acc256_t acc;
    gemm256<3>(pr + (size_t)m0 * 768, 768, wq + (size_t)n0 * 384, 384, 384, smem, wave_, acc);
    int t = TIDX; asm volatile("" : "+v"(t));
    const int lane = t & 63, wid = t >> 6, wr = wid >> 2, wc = wid & 3, fr = lane & 15, fq = lane >> 4;
    const int b = m0 >> 12, t0 = m0 & 4095;
#pragma unroll
    for (int bj = 0; bj < 2; ++bj) {
      const int cg = n0 + bj * 128 + wc * 32;
      const int hd = cg / 192, d0 = cg % 192;
      const bool rope = d0 >= 128;
      const int seg = (d0 - 128) >> 5;
#pragma unroll
      for (int ai = 0; ai < 2; ++ai)
#pragma unroll
        for (int m = 0; m < 4; ++m) {
          const int rl = ai * 128 + wr * 64 + m * 16 + fr;
          const float sc = rs[rl];
          f32x4 x1 = acc[ai][bj][m][0], x2 = acc[ai][bj][m][1];
#pragma unroll
          for (int j = 0; j < 4; ++j) { x1[j] *= sc; x2[j] *= sc; }
          if (rope) {
            const int tok = t0 + rl;
            const int pos = seg == 0 ? (tok >> 6) : (tok & 63);
            const float4 cs = *(const float4*)(rtab + pos * 16 + fq * 4);
            const float4 sn = *(const float4*)(rtab + 1024 + pos * 16 + fq * 4);
            const float c_[4] = {cs.x, cs.y, cs.z, cs.w}, s_[4] = {sn.x, sn.y, sn.z, sn.w};
#pragma unroll
            for (int j = 0; j < 4; ++j) {
              const float a1 = x1[j], a2 = x2[j];
              x1[j] = a1 * c_[j] - a2 * s_[j];
              x2[j] = a2 * c_[j] + a1 * s_[j];
            }
          }
          bf16_t* qd = Qb + ((size_t)(b * 8 + hd) * 4096 + t0 + rl) * 192 + d0;
          store_bf16x8_pair(qd, x1, x2, fq);
        }
    }
  }
}

DI void phase_upproj_kv(const Params& p, char* smem, const int wave_) {
  const bf16_t* pr = (const bf16_t*)(p.ws + OFF_PROJ1);
  const bf16_t* wkv = (const bf16_t*)(p.ws + OFF_WT_UKV);
  bf16_t* Kb = (bf16_t*)(p.ws + OFF_K);
  bf16_t* VTb = (bf16_t*)(p.ws + OFF_VT);
  const float* ropec = (const float*)(p.ws + OFF_ROPE);
  const float* ropes = ropec + 1024;
  float* rs = (float*)(smem + G8_LDS);
  const int nkv = (TT / 256) * 8;
  for (int tbase = 0; tbase < nkv; tbase += gridDim.x) {
    const int tile = xcd_item(tbase);
    if (tile >= nkv) continue;
    const int tm = tile >> 3, hd = tile & 7;
    const int m0 = tm * 256, n0 = hd * 256;
    __syncthreads();
    {
      const int t_ = TIDX;
      if (t_ < 256) { const float* sq = (const float*)(p.ws + OFF_SSQ) + (size_t)(m0 + t_) * 8; rs[t_] = rsqrtf((sq[2] + sq[3]) * (1.f / 256.f) + EPS); }
    }
    acc256_t acc;
    gemm256<1>(pr + (size_t)m0 * 768 + 384, 768, wkv + (size_t)n0 * 256, 256, 256, smem, wave_, acc);
    int t = TIDX; asm volatile("" : "+v"(t));
    const int lane = t & 63, wid = t >> 6, wr = wid >> 2, wc = wid & 3, fr = lane & 15, fq = lane >> 4;
    const bool isx = m0 < TX;
    const int b = isx ? (m0 >> 12) : ((m0 - TX) >> 8);
    const int key0 = isx ? (m0 & 4095) : 4096;
    const size_t bh = (size_t)(b * 8 + hd);
#pragma unroll
    for (int ai = 0; ai < 2; ++ai)
#pragma unroll
      for (int m = 0; m < 4; ++m) {
        const int rl = ai * 128 + wr * 64 + m * 16 + fr;
        const float sc = rs[rl];
        bf16_t* kd = Kb + (bh * NKEY + key0 + rl) * 192 + wc * 32;
        store_bf16x8_pair(kd, acc[ai][0][m][0] * sc, acc[ai][0][m][1] * sc, fq);
      }
#pragma unroll
    for (int ai = 0; ai < 2; ++ai)
#pragma unroll
      for (int m = 0; m < 4; ++m) {
        const int rl0 = ai * 128 + wr * 64 + m * 16 + fq * 4;
        const int rl0p = ai * 128 + wr * 64 + m * 16 + (fq & 1) * 8 + (fq >> 1) * 4;
        const float4 sc = *(const float4*)(rs + rl0);
        const f32x4 va = acc[ai][1][m][0], vb = acc[ai][1][m][1];
        const unsigned x0 = pack2(va[0] * sc.x, va[1] * sc.y), x1 = pack2(va[2] * sc.z, va[3] * sc.w);
        const unsigned y0 = pack2(vb[0] * sc.x, vb[1] * sc.y), y1 = pack2(vb[2] * sc.z, vb[3] * sc.w);
        const auto s0 = __builtin_amdgcn_permlane32_swap(x0, y0, false, false);
        const auto s1 = __builtin_amdgcn_permlane32_swap(x1, y1, false, false);
        const int rl0q = ai * 128 + wr * 64 + m * 16 + (fq & 1) * 8;
        bf16_t* vd = VTb + (bh * 128 + wc * 32 + (fq >> 1) * 16 + fr) * NKEY + key0 + rl0q;
        *(uint4*)vd = make_uint4(s0[0], s1[0], s0[1], s1[1]);
      }
    {
      const int tok = t >> 1, seg = t & 1;
      const bf16_t* src = pr + (size_t)(m0 + tok) * 768 + 640 + seg * 32;
      const uint4 i0 = *(const uint4*)(src), i1 = *(const uint4*)(src + 8), i2 = *(const uint4*)(src + 16), i3 = *(const uint4*)(src + 24);
      const unsigned ua[8] = {i0.x, i0.y, i0.z, i0.w, i1.x, i1.y, i1.z, i1.w};
      const unsigned ub[8] = {i2.x, i2.y, i2.z, i2.w, i3.x, i3.y, i3.z, i3.w};
      float a[16], bq[16];
#pragma unroll
      for (int e = 0; e < 8; ++e) { a[2 * e] = bflo(ua[e]); a[2 * e + 1] = bfhi(ua[e]); bq[2 * e] = bflo(ub[e]); bq[2 * e + 1] = bfhi(ub[e]); }
      if (isx) {
        const int tt = key0 + tok;
        const int pos = seg == 0 ? (tt >> 6) : (tt & 63);
#pragma unroll
        for (int i = 0; i < 16; ++i) {
          float cs = ropec[pos * 16 + i], sn = ropes[pos * 16 + i];
          float na = a[i] * cs - bq[i] * sn, nb = bq[i] * cs + a[i] * sn;
          a[i] = na; bq[i] = nb;
        }
      }
      bf16_t* dst = Kb + (bh * NKEY + key0 + tok) * 192 + 128 + seg * 32;
      *(uint4*)(dst) = make_uint4(pack2(a[0], a[1]), pack2(a[2], a[3]), pack2(a[4], a[5]), pack2(a[6], a[7]));
      *(uint4*)(dst + 8) = make_uint4(pack2(a[8], a[9]), pack2(a[10], a[11]), pack2(a[12], a[13]), pack2(a[14], a[15]));
      *(uint4*)(dst + 16) = make_uint4(pack2(bq[0], bq[1]), pack2(bq[2], bq[3]), pack2(bq[4], bq[5]), pack2(bq[6], bq[7]));
      *(uint4*)(dst + 24) = make_uint4(pack2(bq[8], bq[9]), pack2(bq[10], bq[11]), pack2(bq[12], bq[13]), pack2(bq[14], bq[15]));
    }
  }
}

constexpr int AT_KS = 64 * 384;
constexpr int AT_VS = 128 * 128;
constexpr int AT_RD = 6;
template <int OFF>
DI void lds_rd128(bf16x8& d, unsigned addr) {
  asm volatile("ds_read_b128 %0, %1 offset:%2" : "=v"(d) : "v"(addr), "n"(OFF) : "memory");
}
template <int N>
DI void lgkm_wait(bf16x8& d) {
  asm volatile("s_waitcnt lgkmcnt(%1)" : "+v"(d) : "n"(N) : "memory");
}
template <int J, int OFF, int NS>
DI void att_issue(bf16x8& d, const unsigned (&kb)[4], const unsigned (&vb)[4]) {
  if constexpr (J < NS) {
    constexpr int G = (J + OFF) % 40;
    if constexpr (G < 24) {
      constexpr int kk = G >> 1, m = G & 1;
      lds_rd128<m * (32 * 384) + (kk >> 2) * 128>(d, kb[kk & 3]);
    } else {
      constexpr int j = G - 24;
      lds_rd128<(j & 3) * (32 * 128)>(d, vb[j >> 2]);
    }
  }
}
DI void phase_attn(const Params& p, char* smem, const int wave_) {
  int t = TIDX;
  asm volatile("" : "+v"(t));
  const int lane = t & 63, wv = t >> 6, r = lane & 31, h = lane >> 5;
  const bf16_t* Qb = (const bf16_t*)(p.ws + OFF_Q);
  const bf16_t* Kb = (const bf16_t*)(p.ws + OFF_K);
  const bf16_t* VTb = (const bf16_t*)(p.ws + OFF_VT);
  bf16_t* ob = (bf16_t*)(p.ws + OFF_HBUF);
  LAS char* lds = (LAS char*)smem;
  const unsigned ldsaddr = (unsigned)(size_t)lds;
  int kvo[3], vvo[2];
#pragma unroll
  for (int e = 0; e < 3; ++e) {
    const int L = (wv * 3 + e) * 1024 + lane * 16, row = L / 384, cs = (L % 384) >> 4;
    kvo[e] = row * 384 + ((cs ^ ((row >> 1) & 7)) << 4);
  }
#pragma unroll
  for (int e = 0; e < 2; ++e) {
    const int L = (wv * 2 + e) * 1024 + lane * 16, row = L >> 7, cs = (L & 127) >> 4;
    vvo[e] = row * (NKEY * 2) + ((cs ^ ((row >> 1) & 7)) << 4);
  }
  const int gh = ((r >> 1) & 7) ^ h;
  const int kro0 = r * 384 + (gh << 4), vro0 = r * 128 + (gh << 4);
  const f32x16 zero16 = {0.f, 0.f, 0.f, 0.f, 0.f, 0.f, 0.f, 0.f, 0.f, 0.f, 0.f, 0.f, 0.f, 0.f, 0.f, 0.f};
  for (int ibase = 0; ibase < 1024; ibase += gridDim.x) {
    const int item = xcd_item(ibase);
    if (item >= 1024) continue;
    const int bh = item >> 4, qb = item & 15;
    const int b = bh >> 3, hd = bh & 7;
    const __amdgpu_buffer_rsrc_t krs = __builtin_amdgcn_make_buffer_rsrc((void*)(Kb + (size_t)bh * NKEY * 192), 0, NKEY * 192 * 2, 0x00020000);
    const __amdgpu_buffer_rsrc_t vrs = __builtin_amdgcn_make_buffer_rsrc((void*)(VTb + (size_t)bh * 128 * NKEY), 0, 128 * NKEY * 2, 0x00020000);
    bf16x8 qf[12];
    {
      const bf16_t* qrow = Qb + ((size_t)bh * 4096 + qb * 256 + wv * 32 + r) * 192 + 8 * h;
#pragma unroll
      for (int kk = 0; kk < 12; ++kk) qf[kk] = *(const bf16x8*)(qrow + 16 * kk);
    }
    f32x16 O[4];
#pragma unroll
    for (int m = 0; m < 4; ++m)
#pragma unroll
      for (int e = 0; e < 16; ++e) O[m][e] = 0.f;
    float mrun = 0.f, lsum = 0.f;
    f32x16 negm = zero16;
#define AT_DMA_K(tile_, st_) { _Pragma("unroll") for (int e = 0; e < 3; ++e) \
      __builtin_amdgcn_raw_ptr_buffer_load_lds(krs, (LAS void*)(lds + (st_) * AT_KS + (wave_ * 3 + e) * 1024), 16, kvo[e], (tile_) * AT_KS, 0, 0); }
#define AT_DMA_V(tile_, st_) { _Pragma("unroll") for (int e = 0; e < 2; ++e) \
      __builtin_amdgcn_raw_ptr_buffer_load_lds(vrs, (LAS void*)(lds + 3 * AT_KS + (st_) * AT_VS + (wave_ * 2 + e) * 1024), 16, vvo[e], (tile_) * 128, 0, 0); }
    asm volatile("s_waitcnt vmcnt(0) lgkmcnt(0)" ::: "memory");
    __builtin_amdgcn_s_barrier();
    AT_DMA_K(0, 0); AT_DMA_V(0, 0);
    AT_DMA_K(1, 1); AT_DMA_V(1, 1);
    asm volatile("s_waitcnt vmcnt(0)" ::: "memory");
    __builtin_amdgcn_s_barrier();
    f32x16 S[2];
    bf16x8 fr[AT_RD];
    unsigned pw[16];
    int ksc = 0, ksn = 2, vsc = 0;
#define AT_STEP(j, OFF, NS) { \
      lgkm_wait<((j) + AT_RD - 1 < (NS) ? AT_RD - 1 : (NS) - 1 - (j))>(fr[(j) % AT_RD]); \
      if ((((j) + (OFF)) % 40) < 24) S[((j) + (OFF)) & 1] = MFMA32(fr[(j) % AT_RD], qf[((((j) + (OFF)) % 40) >> 1) % 12], (((j) + (OFF)) % 40) < 2 ? negm : S[((j) + (OFF)) & 1]); \
      else { const u32x4 pq_ = {pw[4 * ((((((j) + (OFF)) % 40) - 24) >> 2) & 3)], pw[4 * ((((((j) + (OFF)) % 40) - 24) >> 2) & 3) + 1], \
                                pw[4 * ((((((j) + (OFF)) % 40) - 24) >> 2) & 3) + 2], pw[4 * ((((((j) + (OFF)) % 40) - 24) >> 2) & 3) + 3]}; \
             O[((j) + (OFF)) & 3] = MFMA32(fr[(j) % AT_RD], __builtin_bit_cast(bf16x8, pq_), O[((j) + (OFF)) & 3]); } \
      att_issue<(j) + AT_RD, OFF, NS>(fr[(j) % AT_RD], kb, vb); }
#define AT_STEP8(j, OFF, NS) AT_STEP(j, OFF, NS) AT_STEP((j) + 1, OFF, NS) AT_STEP((j) + 2, OFF, NS) AT_STEP((j) + 3, OFF, NS) \
      AT_STEP((j) + 4, OFF, NS) AT_STEP((j) + 5, OFF, NS) AT_STEP((j) + 6, OFF, NS) AT_STEP((j) + 7, OFF, NS)
#define AT_FIRST(OFF, NS) { att_issue<0, OFF, NS>(fr[0], kb, vb); att_issue<1, OFF, NS>(fr[1], kb, vb); att_issue<2, OFF, NS>(fr[2], kb, vb); \
      att_issue<3, OFF, NS>(fr[3], kb, vb); att_issue<4, OFF, NS>(fr[4], kb, vb); att_issue<5, OFF, NS>(fr[5], kb, vb); }
#define AT_BASES(ks_, vs_) \
      unsigned kb[4], vb[4]; \
      { const unsigned kbase_ = ldsaddr + (ks_) * AT_KS, vbase_ = ldsaddr + 3 * AT_KS + (vs_) * AT_VS; \
        _Pragma("unroll") for (int x = 0; x < 4; ++x) { kb[x] = kbase_ + (kro0 ^ (x << 5)); vb[x] = vbase_ + (vro0 ^ (x << 5)); } }
#define AT_SM(FIRST) { \
      float mx = S[0][0]; \
      _Pragma("unroll") for (int m = 0; m < 2; ++m) _Pragma("unroll") for (int e = 0; e < 16; ++e) mx = fmaxf(mx, S[m][e]); \
      { const auto sw_ = __builtin_amdgcn_permlane32_swap(__float_as_uint(mx), __float_as_uint(mx), false, false); \
        mx = fmaxf(__uint_as_float(sw_[0]), __uint_as_float(sw_[1])); } \
      if ((FIRST) || __builtin_amdgcn_ballot_w64(mx > 8.f) != 0ull) { \
        const float d_ = (FIRST) ? mx : fmaxf(mx, 0.f);            \
        const float alpha = (FIRST) ? 0.f : __builtin_amdgcn_exp2f(-d_); \
        mrun += d_; \
        lsum *= alpha; \
        _Pragma("unroll") for (int m = 0; m < 4; ++m) _Pragma("unroll") for (int e = 0; e < 16; ++e) O[m][e] *= alpha; \
        _Pragma("unroll") for (int m = 0; m < 2; ++m) _Pragma("unroll") for (int e = 0; e < 16; ++e) S[m][e] -= d_; \
        _Pragma("unroll") for (int e = 0; e < 16; ++e) negm[e] = -mrun; \
      } \
      float ps = 0.f; \
      _Pragma("unroll") for (int i = 0; i < 16; ++i) { \
        const float p0_ = __builtin_amdgcn_exp2f(S[i >> 3][(2 * i) & 15]), p1_ = __builtin_amdgcn_exp2f(S[i >> 3][((2 * i) & 15) + 1]); \
        pw[i] = pack2(p0_, p1_); \
        ps = __builtin_amdgcn_fdot2_f32_bf16(__builtin_bit_cast(bf16x2v, pw[i]), __builtin_bit_cast(bf16x2v, 0x3F803F80u), ps, false); } \
      lsum += ps; }
#define AT_HEAD(kt_) { AT_DMA_K((kt_) + 2, ksn); AT_DMA_V((kt_) + 2, (vsc + 2) & 3); }
#define AT_TAIL() { \
      asm volatile("s_waitcnt vmcnt(5) lgkmcnt(0)" ::: "memory"); \
      __builtin_amdgcn_s_barrier(); \
      ksn = ksc; ksc = (ksc == 2) ? 0 : ksc + 1; \
      vsc = (vsc + 1) & 3; }
    if (wave_ < 4) {
#pragma unroll 1
      for (int kt = 0; kt < NCH; ++kt) {
        AT_BASES(ksc, vsc)
        AT_FIRST(0, 40)
        AT_HEAD(kt)
        AT_STEP8(0, 0, 40) AT_STEP8(8, 0, 40) AT_STEP8(16, 0, 40)
        AT_SM(kt == 0)
        AT_STEP8(24, 0, 40) AT_STEP8(32, 0, 40)
        AT_TAIL()
      }
    } else {
      {
        AT_BASES(ksc, vsc)
        AT_FIRST(0, 24)
        AT_HEAD(0)
        AT_STEP8(0, 0, 24) AT_STEP8(8, 0, 24) AT_STEP8(16, 0, 24)
        AT_TAIL()
      }
#pragma unroll 1
      for (int kt = 1; kt < NCH; ++kt) {
        AT_BASES(ksc, (vsc + 3) & 3)
        AT_FIRST(24, 40)
        AT_HEAD(kt)
        AT_SM(kt == 1)
        AT_STEP8(0, 24, 40) AT_STEP8(8, 24, 40) AT_STEP8(16, 24, 40) AT_STEP8(24, 24, 40) AT_STEP8(32, 24, 40)
        AT_TAIL()
      }
      {
        AT_BASES(ksc, (vsc + 3) & 3)
        AT_FIRST(24, 16)
        AT_SM(false)
        AT_STEP8(0, 24, 16) AT_STEP8(8, 24, 16)
      }
    }
    {
      const auto sw_ = __builtin_amdgcn_permlane32_swap(__float_as_uint(lsum), __float_as_uint(lsum), false, false);
      lsum = __uint_as_float(sw_[0]) + __uint_as_float(sw_[1]);
    }
    const float inv = 1.f / lsum;
    bf16_t* orow = ob + ((size_t)b * 4096 + qb * 256 + wv * 32 + r) * 1024 + hd * 128;
#pragma unroll
    for (int mo = 0; mo < 4; ++mo)
#pragma unroll
      for (int k = 0; k < 2; ++k) {
        const unsigned x0 = pack2(O[mo][8 * k] * inv, O[mo][8 * k + 1] * inv), x1 = pack2(O[mo][8 * k + 2] * inv, O[mo][8 * k + 3] * inv);
        const unsigned y0 = pack2(O[mo][8 * k + 4] * inv, O[mo][8 * k + 5] * inv), y1 = pack2(O[mo][8 * k + 6] * inv, O[mo][8 * k + 7] * inv);
        const auto s0 = __builtin_amdgcn_permlane32_swap(x0, y0, false, false);
        const auto s1 = __builtin_amdgcn_permlane32_swap(x1, y1, false, false);
        *(uint4*)(orow + mo * 32 + 16 * k + 8 * h) = make_uint4(s0[0], s1[0], s0[1], s1[1]);
      }
  }
  asm volatile("s_waitcnt vmcnt(0)" ::: "memory");
  __syncthreads();
#undef AT_DMA_K
#undef AT_DMA_V
#undef AT_STEP
#undef AT_STEP8
#undef AT_FIRST
#undef AT_BASES
#undef AT_SM
#undef AT_HEAD
#undef AT_TAIL
}

constexpr int SMEM_BYTES = 163840 - 16;


#define XB_TMO      128
#define XB_XCNT(j)  (256  + 64 * (j))
#define XB_XSUB(j)  (1280 + 64 * (j))
#define XB_XGEN(j)  (2304 + 64 * (j))
#define XB_TOP      3328
#define XB_TOPGEN   3392
#define XCD_BAR_WORDS 3456
#define XB_SPIN_CAP (1u << 22)
DI unsigned xb_ld(unsigned* p) { return __hip_atomic_load(p, __ATOMIC_RELAXED, __HIP_MEMORY_SCOPE_AGENT); }
DI unsigned xb_add(unsigned* p, unsigned v) { return __hip_atomic_fetch_add(p, v, __ATOMIC_RELAXED, __HIP_MEMORY_SCOPE_AGENT); }
DI unsigned xb_xcc_id() { return (unsigned)__builtin_amdgcn_s_getreg((3 << 11) | 20) & 0xFu; }
#define XB_SPIN(cond, bar) do { unsigned _sp = 0; while (cond) { __builtin_amdgcn_s_sleep(1); \
    if ((++_sp & 255u) == 0u) { if (xb_ld(&(bar)[XB_TMO])) break; if (_sp > XB_SPIN_CAP) { atomicAdd(&(bar)[XB_TMO], 1u); break; } } } } while (0)
struct XcdBarrier { unsigned* bar; unsigned x; volatile LAS unsigned* st; };
DI XcdBarrier xcd_barrier_post(unsigned* bar, volatile LAS unsigned* st, int tid) {
  XcdBarrier b; b.bar = bar; b.x = xb_xcc_id(); b.st = st;
  if (tid == 0) st[3] = xb_add(&bar[XB_XCNT(b.x)], 1u);
  return b;
}
DI void xcd_barrier_complete(unsigned* bar, unsigned x, unsigned& nloc, unsigned& nx, unsigned& dense) {
  const unsigned G = gridDim.x * gridDim.y * gridDim.z;
  unsigned sum, cnt, mine, below, sp = 0u;
  for (;;) {
    sum = 0u; cnt = 0u; mine = 0u; below = 0u;
#pragma unroll
    for (unsigned j = 0; j < 16; ++j) { const unsigned c = xb_ld(&bar[XB_XCNT(j)]); sum += c; cnt += (c > 0u) ? 1u : 0u; mine = (j == x) ? c : mine; below += (j < x && c > 0u) ? 1u : 0u; }
    if (sum == G) break;
    __builtin_amdgcn_s_sleep(1);
    if ((++sp & 255u) == 0u) { if (xb_ld(&bar[XB_TMO])) break; if (sp > XB_SPIN_CAP) { atomicAdd(&bar[XB_TMO], 1u); break; } }
  }
  nloc = mine > 0u ? mine : 1u; nx = cnt > 0u ? cnt : 1u; dense = below;
}
DI void xcd_barrier(const XcdBarrier& b, int tid) {
  asm volatile("s_waitcnt vmcnt(0)" ::: "memory");
  __syncthreads();
  if (tid == 0) {
    unsigned* bar = b.bar;
    __builtin_amdgcn_s_waitcnt(0);
    unsigned nloc = b.st[0], nx = b.st[1];
    if (nloc == 0u) { unsigned dense; xcd_barrier_complete(bar, b.x, nloc, nx, dense); b.st[0] = nloc; b.st[1] = nx; b.st[2] = dense; }
    const unsigned old = xb_add(&bar[XB_XSUB(b.x)], 1u);
    const unsigned gen = old / nloc;
    if (old + 1u == (gen + 1u) * nloc) {
      __builtin_amdgcn_fence(__ATOMIC_RELEASE, "agent");
      asm volatile("s_waitcnt vmcnt(0)" ::: "memory");
      const unsigned og = xb_add(&bar[XB_TOP], 1u);
      const unsigned tg = og / nx;
      if (og + 1u == (tg + 1u) * nx) xb_add(&bar[XB_TOPGEN], 1u);
      else XB_SPIN(xb_ld(&bar[XB_TOPGEN]) == tg, bar);
      __builtin_amdgcn_fence(__ATOMIC_ACQUIRE, "agent");
      xb_add(&bar[XB_XGEN(b.x)], 1u);
      asm volatile("s_waitcnt vmcnt(0)" ::: "memory");
    } else {
      XB_SPIN(xb_ld(&bar[XB_XGEN(b.x)]) == gen, bar);
      __builtin_amdgcn_fence(__ATOMIC_ACQUIRE, "agent");
      asm volatile("s_waitcnt vmcnt(0)" ::: "memory");
    }
  }
  __syncthreads();
}

#ifndef DUP_MASK
#define DUP_MASK 0
#endif
#define RUNP(ph, call) { call; if ((DUP_MASK >> (ph)) & 1) { call; } }
#define GATHER_SEQ(L) phase_gather(p, L, wave_);
#define PHASE_LIST(SYNC) \
  RUNP(0, phase_prep(p, smem, wave_)); SYNC; \
  RUNP(1, phase_h0(p, smem, wave_)); SYNC; \
  RUNP(2, phase_inproj0(p, smem, wave_)); SYNC; \
  RUNP(3, phase_g1(p, smem, wave_)); SYNC; \
  RUNP(4, phase_g2(p, smem, wave_)); SYNC; \
  RUNP(5, phase_yb(p, wave_)); SYNC; \
  RUNP(6, phase_outproj(p, smem, 0, wave_)); convert_in_tail(p, 0, (TT / 256) * 4, wave_); SYNC; \
  RUNP(8, phase_peerq(p, smem, 0, wave_)); convert_in_tail(p, 1, (TT / 256) * 4, wave_, 2); SYNC; \
  GATHER_SEQ(0) SYNC; \
  RUNP(10, phase_inproj1(p, smem, wave_)); SYNC; \
  RUNP(11, phase_upproj_q(p, smem, wave_); phase_upproj_kv(p, smem, wave_)); SYNC; \
  RUNP(12, phase_attn(p, smem, wave_)); SYNC; \
  phase_outproj(p, smem, 1, wave_); SYNC; \
  RUNP(15, phase_peerq(p, smem, 1, wave_)); SYNC; \
  GATHER_SEQ(1)

#if MEGA
__global__ void __launch_bounds__(NT) mega_kernel(Params p) {
  __shared__ __attribute__((aligned(16))) char smem[SMEM_BYTES + 16];
  cg::grid_group grid = cg::this_grid();
  const int wave_ = __builtin_amdgcn_readfirstlane((int)(__builtin_amdgcn_workitem_id_x() >> 6));
  volatile LAS unsigned* xst = (volatile LAS unsigned*)(smem + SMEM_BYTES);
  if (TIDX == 0) { xst[0] = 0u; xst[1] = 0u; xst[2] = 0u; xst[3] = 0u; }
  __syncthreads();
  const XcdBarrier xb = xcd_barrier_post((unsigned*)(p.ws + OFF_BAR), xst, TIDX);
  if (gridDim.z == 3) grid.sync();
#define SEAM { xcd_barrier(xb, TIDX); }
  PHASE_LIST(SEAM)
#undef SEAM
}
#else
template <int PH>
__global__ void __launch_bounds__(NT) phase_kernel(Params p) {
  __shared__ __attribute__((aligned(16))) char smem[SMEM_BYTES];
  const int wave_ = __builtin_amdgcn_readfirstlane((int)(__builtin_amdgcn_workitem_id_x() >> 6));
  switch (PH) {
    case 0: phase_prep(p, smem, wave_); break;
    case 1: phase_h0(p, smem, wave_); break;
    case 2: phase_inproj0(p, smem, wave_); break;
    case 3: phase_g1(p, smem, wave_); break;
    case 4: phase_g2(p, smem, wave_); break;
    case 5: phase_yb(p, wave_); break;
    case 6: phase_outproj(p, smem, 0, wave_); break;
    case 7: phase_hnorm(p, p.norm2, 0, 3, TT, wave_); convert_tables(p, 0, blockIdx.x, gridDim.x, wave_); convert_tables(p, 1, blockIdx.x, gridDim.x, wave_); break;
    case 8: phase_peerq(p, smem, 0, wave_); break;
    case 9: phase_gather(p, 0, wave_); break;
    case 10: phase_inproj1(p, smem, wave_); break;
    case 11: phase_upproj_q(p, smem, wave_); phase_upproj_kv(p, smem, wave_); break;
    case 12: phase_attn(p, smem, wave_); break;
    case 13: phase_outproj(p, smem, 1, wave_); break;
    case 14: phase_hnorm(p, p.norm2 + 1024, 1, 3, TX, wave_); break;
    case 15: phase_peerq(p, smem, 1, wave_); break;
    case 16: phase_gather(p, 1, wave_); break;
  }
}
#endif

extern "C" void kernel_launch(void* const* d_in, const int* in_sizes, int n_in, void* d_out, int out_size, void* d_ws,
                              size_t ws_size, hipStream_t stream) {
  (void)in_sizes; (void)n_in; (void)out_size; (void)ws_size;
  Params p{};
  const float** f = (const float**)&p;
  for (int i = 0; i < 26; ++i) f[i] = (const float*)d_in[i];
  p.out = (float*)d_out;
  p.ws = (char*)d_ws;
#if MEGA
  static int grid_blocks = 0;
  if (!grid_blocks) {
    int dev = 0, cus = 0, per_cu = 0;
    hipGetDevice(&dev);
    hipDeviceGetAttribute(&cus, hipDeviceAttributeMultiprocessorCount, dev);
    hipOccupancyMaxActiveBlocksPerMultiprocessor(&per_cu, mega_kernel, NT, 0);
    if (per_cu > 1) per_cu = 1;
    grid_blocks = cus * per_cu;
  }
  hipMemsetAsync((char*)d_ws + OFF_BAR, 0, 16384, stream);
  void* args[] = {&p};
  hipLaunchCooperativeKernel((void*)mega_kernel, dim3(grid_blocks), dim3(NT), args, 0, stream);
#else
  const dim3 g(256), b(NT);
  phase_kernel<0><<<g, b, 0, stream>>>(p);
  phase_kernel<1><<<g, b, 0, stream>>>(p);
  phase_kernel<2><<<g, b, 0, stream>>>(p);
  phase_kernel<3><<<g, b, 0, stream>>>(p);
  phase_kernel<4><<<g, b, 0, stream>>>(p);
  phase_kernel<5><<<g, b, 0, stream>>>(p);
  phase_kernel<6><<<g, b, 0, stream>>>(p);
  phase_kernel<7><<<g, b, 0, stream>>>(p);
  phase_kernel<8><<<g, b, 0, stream>>>(p);
  phase_kernel<9><<<g, b, 0, stream>>>(p);
  phase_kernel<10><<<g, b, 0, stream>>>(p);
  phase_kernel<11><<<g, b, 0, stream>>>(p);
  phase_kernel<12><<<g, b, 0, stream>>>(p);
  phase_kernel<13><<<g, b, 0, stream>>>(p);
  phase_kernel<14><<<g, b, 0, stream>>>(p);
  phase_kernel<15><<<g, b, 0, stream>>>(p);
  phase_kernel<16><<<g, b, 0, stream>>>(p);
#endif
}
```

```cpp
#include <hip/hip_runtime.h>
#include <hip/hip_cooperative_groups.h>
#include <stdint.h>
namespace cg = cooperative_groups;

#ifndef MEGA
#define MEGA 1
#endif


typedef unsigned short bf16_t;
using bf16x8 = __attribute__((ext_vector_type(8))) short;
using f32x16 = __attribute__((ext_vector_type(16))) float;
using f32x4 = __attribute__((ext_vector_type(4))) float;
typedef unsigned u32x4 __attribute__((ext_vector_type(4)));
#define DI __device__ __forceinline__
#define LAS __attribute__((address_space(3)))
#define NT 512
__device__ __forceinline__ int lane_id_fresh() {
  unsigned z = 0u;
  asm volatile("" : "+v"(z));
  return (int)__builtin_amdgcn_mbcnt_hi(~0u, __builtin_amdgcn_mbcnt_lo(~0u, z));
}
#define TIDX (wave_ * 64 + lane_id_fresh())

constexpr int D = 1024;
constexpr int NB = 8;
constexpr int SEQ = 4096;
constexpr int CTXL = 256;
constexpr int TX = NB * SEQ;
constexpr int TC = NB * CTXL;
constexpr int TT = TX + TC;
constexpr int NKEY = SEQ + CTXL;
constexpr int NCH = 68;
constexpr int NITEM = NB * 4 * NCH;
constexpr float EPS = 1e-6f;

constexpr size_t OFF_MOD = 0;
constexpr size_t OFF_ROPE = OFF_MOD + 442368;
constexpr size_t OFF_WAB = OFF_ROPE + 8192;
constexpr size_t OFF_WT_IN0 = OFF_WAB + 65536;
constexpr size_t OFF_WT_OUT0 = OFF_WT_IN0 + 7340032;
constexpr size_t OFF_WT_IN1 = OFF_WT_OUT0 + 2097152;
constexpr size_t OFF_WT_UQ = OFF_WT_IN1 + 1572864;
constexpr size_t OFF_WT_UKV = OFF_WT_UQ + 1179648;
constexpr size_t OFF_WT_OUT1 = OFF_WT_UKV + 1048576;
constexpr size_t OFF_WT_PQ = OFF_WT_OUT1 + 2097152;
constexpr size_t OFF_KEYS = OFF_WT_PQ + 4194304;
constexpr size_t OFF_CTXBUF = OFF_KEYS + 524288;
constexpr size_t OFF_HBUF = OFF_CTXBUF + 8388608;
constexpr size_t OFF_AB = OFF_HBUF + 71303168;
constexpr size_t OFF_SCR = OFF_AB + 2228224;
constexpr size_t OFF_GATE = OFF_SCR;
constexpr size_t OFF_Z = OFF_GATE + 106954752;
constexpr size_t OFF_QN = OFF_Z + 35651584;
constexpr size_t OFF_KT = OFF_QN + 35651584;
constexpr size_t OFF_W = OFF_KT + 35651584;
constexpr size_t OFF_UT = OFF_W + 71303168;
constexpr size_t OFF_INTRA = OFF_UT + 71303168;
constexpr size_t OFF_SC = OFF_INTRA + 35651584;
constexpr size_t END_L0 = OFF_SC + 4456448;
constexpr size_t OFF_SELI = OFF_SCR;
constexpr size_t OFF_SELG = OFF_SELI + 17825792;
constexpr size_t OFF_PROJ1 = OFF_SELG + 17825792;
constexpr size_t OFF_Q = OFF_PROJ1 + 53477376;
constexpr size_t OFF_K = OFF_Q + 100663296;
constexpr size_t OFF_VT = OFF_K + 106954752;
constexpr size_t OFF_SELU = OFF_VT + 71303168;
constexpr size_t OFF_TSC = OFF_SELU + 17825792;
constexpr size_t OFF_SSQ = OFF_TSC + 131072;
constexpr size_t OFF_SSQ2 = OFF_SSQ + (size_t)TT * 32;
constexpr size_t END_L1 = OFF_SSQ2 + (size_t)TT * 16;
constexpr size_t OFF_TAB = OFF_PROJ1;
constexpr size_t OFF_BAR = (END_L0 > END_L1 ? END_L0 : END_L1);
constexpr size_t OFF_TAB1 = OFF_BAR + 16384;
constexpr size_t OFF_TSC1 = OFF_TAB1 + 25165824;
constexpr size_t OFF_PQB = OFF_TSC1 + 131072;
constexpr size_t WS_NEED = OFF_PQB + 2 * 9 * 1024 * 4;
constexpr size_t DO_QKV = 0;
constexpr size_t DO_OF = 0;
constexpr size_t DO_OB = 35651584;

struct Params {
  const float *x, *c, *ctx, *c_ctx, *w_mod, *b_mod, *norm1, *norm2, *ev_w_in, *ev_a_conv, *ev_qkv_conv, *ev_a_log,
      *ev_dt_bias, *ev_o_norm, *ev_w_out, *od_w_in, *od_q_norm, *od_kv_norm, *od_w_uq, *od_w_ukv, *od_w_out, *p_w_q,
      *p_keys, *p_u, *p_v, *norm_f;
  float* out;
  char* ws;
};

DI bf16_t f2bf(float x) {
  unsigned u = __float_as_uint(x);
  u += 0x7fffu + ((u >> 16) & 1u);
  return (bf16_t)(u >> 16);
}
DI float bf2f(bf16_t b) { return __uint_as_float(((unsigned)b) << 16); }
typedef float float2v __attribute__((ext_vector_type(2)));
typedef __bf16 bf16x2v __attribute__((ext_vector_type(2)));
DI unsigned pack2(float a, float b) {
  float2v f = {a, b};
  bf16x2v h = __builtin_convertvector(f, bf16x2v);
  return __builtin_bit_cast(unsigned, h);
}
DI float bflo(unsigned u) { return __uint_as_float(u << 16); }
DI float bfhi(unsigned u) { return __uint_as_float(u & 0xffff0000u); }
DI float wave_sum(float v) {
#pragma unroll
  for (int o = 32; o > 0; o >>= 1) v += __shfl_xor(v, o);
  return v;
}
DI float siluf(float x) { return x / (1.f + __expf(-x)); }
DI float softplusf(float x) { return x > 20.f ? x : log1pf(expf(x)); }
DI float sigmoidf(float x) { return 1.f / (1.f + expf(-x)); }
DI int row_mb(int row) { return row < TX ? (row >> 12) : 8; }
#define MFMA32(a, b, c) __builtin_amdgcn_mfma_f32_32x32x16_bf16((a), (b), (c), 0, 0, 0)
#define MFMA16(a, b, c) __builtin_amdgcn_mfma_f32_16x16x32_bf16((a), (b), (c), 0, 0, 0)
DI int crow32(int reg, int h) { return (reg & 3) + 8 * (reg >> 2) + 4 * h; }
DI int xcd_item(int base) { const int b = blockIdx.x, g8 = gridDim.x >> 3; return base + (b & 7) * g8 + (b >> 3); }

DI int g8_lds_byte(int r, int c) {
  int st = (r >> 4) * 2 + (c >> 5), rr = r & 15, cc = c & 31, ob = rr * 64 + cc * 2;
  return st * 1024 + (ob ^ (((ob >> 9) & 1) << 5));
}
DI void g8_stage_rc(int b, int& R, int& C) {
  int st = b / 1024, sb = b % 1024, swz = sb ^ (((sb >> 9) & 1) << 5);
  R = (st >> 1) * 16 + swz / 64; C = (st & 1) * 32 + (swz % 64) / 2;
}
constexpr int G8_HT = 16384;
constexpr int G8_LDS = 8 * G8_HT;
typedef f32x4 acc256_t[2][2][4][2];

template <int SWAPMASK, int BJMASK = 3>
DI void gemm256(const bf16_t* __restrict__ A, int lda, const bf16_t* __restrict__ Bt, int ldb, int K, char* smem, const int wave_, acc256_t& acc) {
  int t = TIDX;
  asm volatile("" : "+v"(t));
  const int lane = t & 63, wid = t >> 6, wr = wid >> 2, wc = wid & 3, fr = lane & 15, fq = lane >> 4;
#pragma unroll
  for (int a = 0; a < 2; ++a)
#pragma unroll
    for (int b = 0; b < 2; ++b)
#pragma unroll
      for (int m = 0; m < 4; ++m)
#pragma unroll
        for (int n = 0; n < 2; ++n) acc[a][b][m][n] = f32x4{0.f, 0.f, 0.f, 0.f};
  const __amdgpu_buffer_rsrc_t ars = __builtin_amdgcn_make_buffer_rsrc((void*)A, 0, 256 * lda * 2, 0x00020000);
  const __amdgpu_buffer_rsrc_t brs = __builtin_amdgcn_make_buffer_rsrc((void*)Bt, 0, 256 * ldb * 2, 0x00020000);
  int r0, c0, r1, c1;
  g8_stage_rc(t * 16, r0, c0);
  g8_stage_rc(t * 16 + 8192, r1, c1);
  const int avo0 = (r0 * lda + c0) * 2, avo1 = (r1 * lda + c1) * 2, bvo0 = (r0 * ldb + c0) * 2, bvo1 = (r1 * ldb + c1) * 2;
  const int ahalf = 128 * lda * 2, bhalf = 128 * ldb * 2;
  LAS char* lds = (LAS char*)smem;
#define G8_SA(b, h) (lds + ((b) * 2 + (h)) * G8_HT)
#define G8_SB(b, h) (lds + (4 + (b) * 2 + (h)) * G8_HT)
#define G8_STAGE_A(b, h, kt) { \
    __builtin_amdgcn_raw_ptr_buffer_load_lds(ars, (LAS void*)(G8_SA(b, h) + t * 16), 16, avo0, (h) * ahalf + (kt) * 128, 0, 0); \
    __builtin_amdgcn_raw_ptr_buffer_load_lds(ars, (LAS void*)(G8_SA(b, h) + t * 16 + 8192), 16, avo1, (h) * ahalf + (kt) * 128, 0, 0); }
#define G8_STAGE_B(b, h, kt) { \
    __builtin_amdgcn_raw_ptr_buffer_load_lds(brs, (LAS void*)(G8_SB(b, h) + t * 16), 16, bvo0, (h) * bhalf + (kt) * 128, 0, 0); \
    __builtin_amdgcn_raw_ptr_buffer_load_lds(brs, (LAS void*)(G8_SB(b, h) + t * 16 + 8192), 16, bvo1, (h) * bhalf + (kt) * 128, 0, 0); }
  const int fro = (fr * 64 + fq * 16) ^ ((fr >> 3) << 5);
  const int aoff = wr * 8 * 1024 + fro, boff = wc * 4 * 1024 + fro;
#define G8_LDA(dst, b, h) { _Pragma("unroll") for (int m = 0; m < 4; ++m) _Pragma("unroll") for (int k = 0; k < 2; ++k) \
    dst[m][k] = *(const LAS bf16x8*)(G8_SA(b, h) + aoff + (m * 2 + k) * 1024); }
#define G8_LDB(dst, b, h) { if ((BJMASK >> (h)) & 1) { _Pragma("unroll") for (int n = 0; n < 2; ++n) _Pragma("unroll") for (int k = 0; k < 2; ++k) \
    dst[n][k] = *(const LAS bf16x8*)(G8_SB(b, h) + boff + (n * 2 + k) * 1024); } }
#define G8_MMA(ai, bj, At_, Bt_) if ((BJMASK >> (bj)) & 1) { __builtin_amdgcn_s_setprio(1); \
    _Pragma("unroll") for (int m = 0; m < 4; ++m) _Pragma("unroll") for (int n = 0; n < 2; ++n) _Pragma("unroll") for (int k = 0; k < 2; ++k) \
      acc[ai][bj][m][n] = ((SWAPMASK >> (bj)) & 1) ? MFMA16(Bt_[n][k], At_[m][k], acc[ai][bj][m][n]) : MFMA16(At_[m][k], Bt_[n][k], acc[ai][bj][m][n]); \
    __builtin_amdgcn_s_setprio(0); }
#define G8_WAIT_V(n) asm volatile("s_waitcnt vmcnt(" #n ")" ::: "memory")
#define G8_WAIT_L(n) asm volatile("s_waitcnt lgkmcnt(" #n ")" ::: "memory")
#define G8_BAR __builtin_amdgcn_s_barrier()
#define G8_SCHED __builtin_amdgcn_sched_barrier(0)
  bf16x8 At[4][2], B0[2][2], B1[2][2];
  const int nt = K >> 6;
  G8_STAGE_B(0, 0, 0); G8_STAGE_A(0, 0, 0);
  G8_STAGE_B(0, 1, 0); G8_STAGE_A(0, 1, 0);
  if (wr == 1) G8_BAR;
  G8_WAIT_V(4); G8_BAR;
  G8_STAGE_B(1, 0, 1); G8_STAGE_A(1, 0, 1); G8_STAGE_B(1, 1, 1);
  G8_WAIT_V(6); G8_BAR;
  for (int tt = 0; tt < nt - 2; tt += 2) {
    G8_LDB(B0, 0, 0); G8_SCHED; G8_LDA(At, 0, 0); G8_STAGE_A(1, 1, tt + 1);
    G8_WAIT_L(8); G8_BAR; G8_WAIT_L(0); G8_MMA(0, 0, At, B0); G8_BAR; G8_SCHED;
    G8_LDB(B1, 0, 1); G8_STAGE_B(0, 0, tt + 2);
    G8_BAR; G8_WAIT_L(0); G8_MMA(0, 1, At, B1); G8_BAR;
    G8_LDA(At, 0, 1); G8_STAGE_A(0, 0, tt + 2);
    G8_BAR; G8_WAIT_L(0); G8_MMA(1, 0, At, B0); G8_BAR; G8_SCHED;
    G8_STAGE_B(0, 1, tt + 2);
    G8_WAIT_V(6); G8_BAR; G8_MMA(1, 1, At, B1); G8_BAR;
    G8_LDB(B0, 1, 0); G8_SCHED; G8_LDA(At, 1, 0); G8_STAGE_A(0, 1, tt + 2);
    G8_WAIT_L(8); G8_BAR; G8_WAIT_L(0); G8_MMA(0, 0, At, B0); G8_BAR; G8_SCHED;
    G8_LDB(B1, 1, 1); G8_STAGE_B(1, 0, tt + 3);
    G8_BAR; G8_WAIT_L(0); G8_MMA(0, 1, At, B1); G8_BAR;
    G8_LDA(At, 1, 1); G8_STAGE_A(1, 0, tt + 3);
    G8_BAR; G8_WAIT_L(0); G8_MMA(1, 0, At, B0); G8_BAR; G8_SCHED;
    G8_STAGE_B(1, 1, tt + 3);
    G8_WAIT_V(6); G8_BAR; G8_MMA(1, 1, At, B1); G8_BAR;
  }
  { G8_LDB(B0, 0, 0); G8_LDA(At, 0, 0); G8_STAGE_A(1, 1, nt - 1);
    G8_BAR; G8_WAIT_L(0); G8_MMA(0, 0, At, B0); G8_BAR;
    G8_LDB(B1, 0, 1); G8_BAR; G8_WAIT_L(0); G8_MMA(0, 1, At, B1); G8_BAR;
    G8_LDA(At, 0, 1); G8_WAIT_V(4); G8_BAR; G8_WAIT_L(0); G8_MMA(1, 0, At, B0); G8_MMA(1, 1, At, B1); G8_BAR; }
  { G8_LDB(B0, 1, 0); G8_LDA(At, 1, 0); G8_WAIT_V(2); G8_BAR; G8_WAIT_L(0); G8_MMA(0, 0, At, B0); G8_BAR;
    G8_LDB(B1, 1, 1); G8_WAIT_V(0); G8_BAR; G8_WAIT_L(0); G8_MMA(0, 1, At, B1); G8_BAR;
    G8_LDA(At, 1, 1); G8_BAR; G8_WAIT_L(0); G8_MMA(1, 0, At, B0); G8_MMA(1, 1, At, B1); G8_BAR; }
  if (wr == 0) G8_BAR;
  __syncthreads();
}

DI void store_bf16x8_pair(bf16_t* rowp, const f32x4& v0, const f32x4& v1, int fq) {
  const unsigned a0 = pack2(v0[0], v0[1]), a1 = pack2(v0[2], v0[3]), b0 = pack2(v1[0], v1[1]), b1 = pack2(v1[2], v1[3]);
  const unsigned om = (fq & 1) ? ~0u : 0u;
  const unsigned s0 = b0 ^ ((b0 ^ a0) & om), s1 = b1 ^ ((b1 ^ a1) & om);
  const unsigned r0 = (unsigned)__shfl_xor((int)s0, 16), r1 = (unsigned)__shfl_xor((int)s1, 16);
  const unsigned o0 = a0 ^ ((a0 ^ r0) & om), o1 = a1 ^ ((a1 ^ r1) & om), o2 = r0 ^ ((r0 ^ b0) & om), o3 = r1 ^ ((r1 ^ b1) & om);
  bf16_t* dst = rowp + ((fq & 1) ? 16 + 4 * (fq - 1) : 4 * fq);
  *(uint4*)dst = make_uint4(o0, o1, o2, o3);
}

struct TJob { const float* src; const float* kgain; bf16_t* dst; int ldsrc, K, ntn, tile; float scal; };
DI void tjob_load(const TJob& jb, float* tl, int t) {
  const int kt = jb.tile / jb.ntn, nt = jb.tile % jb.ntn;
  const int k0 = kt * 64, n0 = nt * 64;
#pragma unroll
  for (int e = 0; e < 2; ++e) {
    int kk = (t >> 4) + e * 32, n4 = (t & 15) * 4;
    float4 v = *(const float4*)(jb.src + (size_t)(k0 + kk) * jb.ldsrc + n0 + n4);
    float g = jb.scal * (jb.kgain ? jb.kgain[k0 + kk] : 1.f);
    tl[kk * 65 + n4 + 0] = v.x * g;
    tl[kk * 65 + n4 + 1] = v.y * g;
    tl[kk * 65 + n4 + 2] = v.z * g;
    tl[kk * 65 + n4 + 3] = v.w * g;
  }
}
DI void tjob_store(const TJob& jb, const float* tl, int t) {
  const int kt = jb.tile / jb.ntn, nt = jb.tile % jb.ntn;
  const int k0 = kt * 64, n0 = nt * 64;
  int n = t >> 3, k8 = (t & 7) * 8;
  uint4 o;
  o.x = pack2(tl[(k8 + 0) * 65 + n], tl[(k8 + 1) * 65 + n]);
  o.y = pack2(tl[(k8 + 2) * 65 + n], tl[(k8 + 3) * 65 + n]);
  o.z = pack2(tl[(k8 + 4) * 65 + n], tl[(k8 + 5) * 65 + n]);
  o.w = pack2(tl[(k8 + 6) * 65 + n], tl[(k8 + 7) * 65 + n]);
  *(uint4*)(jb.dst + (size_t)(n0 + n) * jb.K + k0 + k8) = o;
}

DI void phase_prep(const Params& p, char* smem, const int wave_) {
  const int t = TIDX, nb = gridDim.x, bid = blockIdx.x;
  char* ws = p.ws;
  {
    float* sl = (float*)smem;
    float* red = sl + 9 * 1024;
    bool have = false;
    for (int job = bid; job < 192; job += nb) {
      if (!have) {
        for (int i = t; i < 9 * 1024; i += NT) {
          float v = i < 8192 ? p.c[i] : p.c_ctx[i - 8192];
          sl[i] = siluf(v);
        }
        have = true;
      }
      __syncthreads();
      int l = job / 96, ch = job % 96, col = t & 63, kg = t >> 6;
      const float* w = p.w_mod + (size_t)l * 1024 * 6144 + ch * 64 + col;
      float acc[9];
#pragma unroll
      for (int r = 0; r < 9; ++r) acc[r] = 0.f;
      for (int k = kg * 128; k < kg * 128 + 128; ++k) {
        float wv = w[(size_t)k * 6144];
#pragma unroll
        for (int r = 0; r < 9; ++r) acc[r] += sl[r * 1024 + k] * wv;
      }
#pragma unroll
      for (int r = 0; r < 9; ++r) red[(kg * 9 + r) * 64 + col] = acc[r];
      __syncthreads();
      for (int i = t; i < 9 * 64; i += NT) {
        int r = i >> 6, cc = i & 63;
        float s = 0.f;
#pragma unroll
        for (int g = 0; g < 8; ++g) s += red[(g * 9 + r) * 64 + cc];
        int n = ch * 64 + cc;
        ((float*)(ws + OFF_MOD))[((size_t)l * 9 + r) * 6144 + n] = s + p.b_mod[l * 6144 + n];
      }
    }
    __syncthreads();
  }
  {
    float* tl = (float*)smem;
    const float qscale = 0.07216878364870322f * 1.4426950408889634f;
    const int n0_ = 16 * 56, n1_ = 256, n2_ = 16 * 11, n3_ = 6 * 24, n4_ = 4 * 32, n5_ = 256, n6_ = 256, n7_ = 256;
    const int total = n0_ + n1_ + n2_ + n3_ + n4_ + n5_ + n6_ + n7_;
#define TJOB_DECODE(jb, job_) { int j = (job_); \
      if (j < n0_) jb = TJob{p.ev_w_in, nullptr, (bf16_t*)(ws + OFF_WT_IN0), 3600, 1024, 56, j, 1.f}; \
      else if ((j -= n0_) < n1_) jb = TJob{p.ev_w_out, nullptr, (bf16_t*)(ws + OFF_WT_OUT0), 1024, 1024, 16, j, 1.f}; \
      else if ((j -= n1_) < n2_) jb = TJob{p.od_w_in, nullptr, (bf16_t*)(ws + OFF_WT_IN1), 704, 1024, 11, j, 1.f}; \
      else if ((j -= n2_) < n3_) jb = TJob{p.od_w_uq, p.od_q_norm, (bf16_t*)(ws + OFF_WT_UQ), 1536, 384, 24, j, qscale}; \
      else if ((j -= n3_) < n4_) jb = TJob{p.od_w_ukv, p.od_kv_norm, (bf16_t*)(ws + OFF_WT_UKV), 2048, 256, 32, j, 1.f}; \
      else if ((j -= n4_) < n5_) jb = TJob{p.od_w_out, nullptr, (bf16_t*)(ws + OFF_WT_OUT1), 1024, 1024, 16, j, 1.f}; \
      else if ((j -= n5_) < n6_) jb = TJob{p.p_w_q, nullptr, (bf16_t*)(ws + OFF_WT_PQ), 1024, 1024, 16, j, 1.f}; \
      else { j -= n6_; jb = TJob{p.p_w_q + 1024 * 1024, nullptr, (bf16_t*)(ws + OFF_WT_PQ) + 1024 * 1024, 1024, 1024, 16, j, 1.f}; } }
    for (int base = bid * 4; base < total; base += nb * 4) {
      __syncthreads();
#pragma unroll
      for (int q = 0; q < 4; ++q)
        if (base + q < total) { TJob jb; TJOB_DECODE(jb, base + q) tjob_load(jb, tl + q * (64 * 65), t); }
      __syncthreads();
#pragma unroll
      for (int q = 0; q < 4; ++q)
        if (base + q < total) { TJob jb; TJOB_DECODE(jb, base + q) tjob_store(jb, tl + q * (64 * 65), t); }
    }
#undef TJOB_DECODE
  }
  const int gt = bid * NT + t, gs = nb * NT;
  for (int i = gt; i < 2 * 8 * 2 * 128 * 64; i += gs) ((bf16_t*)(ws + OFF_KEYS))[i] = f2bf(p.p_keys[i]);
  for (int i = gt; i < 16 * 1024; i += gs) {
    int n = i >> 10, k = i & 1023;
    ((float*)(ws + OFF_WAB))[i] = p.ev_w_in[(size_t)k * 3600 + 3584 + n];
  }
  for (int i = gt; i < 64 * 1024; i += gs) ((bf16_t*)(ws + OFF_WT_IN1))[704 * 1024 + i] = 0;
  for (int i = gt; i < 64 * 16; i += gs) {
    int pos = i >> 4, f = i & 15;
    float freq = powf(10000.f, -(float)f / 16.f);
    float ang = (float)pos * freq;
    ((float*)(ws + OFF_ROPE))[i] = cosf(ang);
    ((float*)(ws + OFF_ROPE))[1024 + i] = sinf(ang);
  }
}

DI void load_row(const float* __restrict__ row, int lane, float (&v)[16]) {
#pragma unroll
  for (int j = 0; j < 4; ++j) {
    float4 a = *(const float4*)(row + 256 * j + 4 * lane);
    v[4 * j] = a.x; v[4 * j + 1] = a.y; v[4 * j + 2] = a.z; v[4 * j + 3] = a.w;
  }
}
DI void norm_mod(const float (&xv)[16], const float* __restrict__ gain, const float* __restrict__ shift, const float* __restrict__ scale,
                 int lane, float (&hv)[16]) {
  float ss = 0.f;
#pragma unroll
  for (int i = 0; i < 16; ++i) ss += xv[i] * xv[i];
  ss = wave_sum(ss);
  float r = rsqrtf(ss * (1.f / 1024.f) + EPS);
#pragma unroll
  for (int j = 0; j < 4; ++j) {
    float4 g = *(const float4*)(gain + 256 * j + 4 * lane);
    float4 sh = *(const float4*)(shift + 256 * j + 4 * lane);
    float4 sc = *(const float4*)(scale + 256 * j + 4 * lane);
    hv[4 * j + 0] = xv[4 * j + 0] * r * g.x * (1.f + sc.x) + sh.x;
    hv[4 * j + 1] = xv[4 * j + 1] * r * g.y * (1.f + sc.y) + sh.y;
    hv[4 * j + 2] = xv[4 * j + 2] * r * g.z * (1.f + sc.z) + sh.z;
    hv[4 * j + 3] = xv[4 * j + 3] * r * g.w * (1.f + sc.w) + sh.w;
  }
}
DI void store_row_bf16(bf16_t* __restrict__ row, int lane, const float (&v)[16]) {
#pragma unroll
  for (int j = 0; j < 4; ++j) {
    uint2 o;
    o.x = pack2(v[4 * j], v[4 * j + 1]);
    o.y = pack2(v[4 * j + 2], v[4 * j + 3]);
    *(uint2*)(row + 256 * j + 4 * lane) = o;
  }
}

DI void phase_h0(const Params& p, char* smem, const int wave_) {
  const int t = TIDX, lane = t & 63, wv = t >> 6;
  float* wab = (float*)smem;
  for (int i = t; i < 16 * 1024; i += NT) wab[i] = ((const float*)(p.ws + OFF_WAB))[i];
  __syncthreads();
  const float* mod = (const float*)(p.ws + OFF_MOD);
  bf16_t* hbuf = (bf16_t*)(p.ws + OFF_HBUF);
  float* ab = (float*)(p.ws + OFF_AB);
  for (int row = blockIdx.x * 8 + wv; row < TT; row += gridDim.x * 8) {
    const float* xr = row < TX ? p.x + (size_t)row * D : p.ctx + (size_t)(row - TX) * D;
    int mb = row_mb(row);
    float xv[16], hv[16];
    load_row(xr, lane, xv);
    norm_mod(xv, p.norm1, mod + (size_t)mb * 6144, mod + (size_t)mb * 6144 + 1024, lane, hv);
    store_row_bf16(hbuf + (size_t)row * D, lane, hv);
    float sv[16];
#pragma unroll
    for (int n = 0; n < 16; ++n) {
      float s = 0.f;
#pragma unroll
      for (int j = 0; j < 4; ++j) {
        float4 w = *(const float4*)(wab + n * 1024 + 256 * j + 4 * lane);
        s += hv[4 * j] * w.x + hv[4 * j + 1] * w.y + hv[4 * j + 2] * w.z + hv[4 * j + 3] * w.w;
      }
      sv[n] = s;
      __builtin_amdgcn_sched_barrier(0);
    }
#define TR_(d, lo, hi, m, off) { const unsigned ul_ = __float_as_uint(lo), uh_ = __float_as_uint(hi); \
      d = __uint_as_float(ul_ ^ ((ul_ ^ uh_) & (m))) + __shfl_xor(__uint_as_float(uh_ ^ ((uh_ ^ ul_) & (m))), off); }
    {
      const unsigned m0_ = (lane & 1) ? ~0u : 0u, m1_ = (lane & 2) ? ~0u : 0u, m2_ = (lane & 4) ? ~0u : 0u, m3_ = (lane & 8) ? ~0u : 0u;
      float a0, a1, a2, a3, a4, a5, a6, a7, b0, b1, b2, b3, c0, c1;
      TR_(a0, sv[0], sv[1], m0_, 1) TR_(a1, sv[2], sv[3], m0_, 1) TR_(a2, sv[4], sv[5], m0_, 1) TR_(a3, sv[6], sv[7], m0_, 1)
      TR_(a4, sv[8], sv[9], m0_, 1) TR_(a5, sv[10], sv[11], m0_, 1) TR_(a6, sv[12], sv[13], m0_, 1) TR_(a7, sv[14], sv[15], m0_, 1)
      TR_(b0, a0, a1, m1_, 2) TR_(b1, a2, a3, m1_, 2) TR_(b2, a4, a5, m1_, 2) TR_(b3, a6, a7, m1_, 2)
      TR_(c0, b0, b1, m2_, 4) TR_(c1, b2, b3, m2_, 4)
      TR_(sv[0], c0, c1, m3_, 8)
    }
#undef TR_
    float myab = sv[0];
    myab += __shfl_xor(myab, 16);
    myab += __shfl_xor(myab, 32);
    if (lane < 16) ab[(size_t)row * 16 + lane] = myab;
  }
  {
    const bf16_t* wq = (const bf16_t*)(p.ws + OFF_WT_PQ);
    float* pqb = (float*)(p.ws + OFF_PQB);
    for (int j = blockIdx.x * 8 + wv; j < 2 * 9 * 1024; j += gridDim.x * 8) {
      const int layer = j / 9216, rem = j - layer * 9216, mb = rem >> 10, n = rem & 1023;
      const float* sh = mod + (size_t)(layer * 9 + mb) * 6144 + 3 * 1024 + 16 * lane;
      const bf16_t* wrow = wq + ((size_t)layer * 1024 + n) * 1024 + 16 * lane;
      const uint4 w0 = *(const uint4*)wrow, w1 = *(const uint4*)(wrow + 8);
      const unsigned wu[8] = {w0.x, w0.y, w0.z, w0.w, w1.x, w1.y, w1.z, w1.w};
      float sacc = 0.f;
#pragma unroll
      for (int i = 0; i < 8; ++i) sacc += sh[2 * i] * bflo(wu[i]) + sh[2 * i + 1] * bfhi(wu[i]);
      sacc = wave_sum(sacc);
      if (lane == 0) pqb[j] = sacc;
    }
  }
}

DI void phase_hnorm(const Params& p, const float* gain, int layer, int shift_idx, int nrows, const int wave_) {
  const int t = TIDX, lane = t & 63, wv = t >> 6;
  const float* mod = (const float*)(p.ws + OFF_MOD) + (size_t)layer * 9 * 6144;
  bf16_t* hbuf = (bf16_t*)(p.ws + OFF_HBUF);
  for (int row = blockIdx.x * 8 + wv; row < nrows; row += gridDim.x * 8) {
    const float* xr = row < TX ? p.out + (size_t)row * D : (const float*)(p.ws + OFF_CTXBUF) + (size_t)(row - TX) * D;
    int mb = row_mb(row);
    float xv[16], hv[16];
    load_row(xr, lane, xv);
    norm_mod(xv, gain, mod + (size_t)mb * 6144 + shift_idx * 1024, mod + (size_t)mb * 6144 + (shift_idx + 1) * 1024, lane, hv);
    store_row_bf16(hbuf + (size_t)row * D, lane, hv);
  }
}

DI void phase_inproj0(const Params& p, char* smem, const int wave_) {
  const bf16_t* A = (const bf16_t*)(p.ws + OFF_HBUF);
  const bf16_t* Bt = (const bf16_t*)(p.ws + OFF_WT_IN0);
  bf16_t* gate = (bf16_t*)(p.ws + OFF_GATE);
  bf16_t* qkv = (bf16_t*)((char*)p.out + DO_QKV);
  bf16_t* z = (bf16_t*)(p.ws + OFF_Z);
  const int ntn = 14, ntm = TT / 256;
  const int ntl = ntm * ntn, gsz = gridDim.x, remt = ntl % gsz, fullt = ntl - remt;
  const bool split_tail = remt > 0 && 2 * remt <= gsz;
  for (int tbase = 0; tbase < ntl; tbase += gsz) {
    int tile, bsel = 3;
    if (split_tail && tbase == fullt) {
      const int pos = xcd_item(0);
      if (pos >= 2 * remt) continue;
      tile = fullt + (pos >> 1); bsel = 1 << (pos & 1);
    } else {
      tile = xcd_item(tbase);
      if (tile >= ntl) continue;
    }
    const int tm = tile / ntn, tn = tile % ntn;
    const int m0 = tm * 256, n0 = tn * 256;
    bf16_t* dst; int ld, nb;
    if (n0 < 1536) { dst = gate; ld = 1536; nb = n0; }
    else if (n0 < 3072) { dst = qkv; ld = 1536; nb = n0 - 1536; }
    else { dst = z; ld = 512; nb = n0 - 3072; }
    acc256_t acc;
    if (bsel == 3) gemm256<3, 3>(A + (size_t)m0 * D, D, Bt + (size_t)n0 * D, D, D, smem, wave_, acc);
    else if (bsel == 1) gemm256<3, 1>(A + (size_t)m0 * D, D, Bt + (size_t)n0 * D, D, D, smem, wave_, acc);
    else gemm256<3, 2>(A + (size_t)m0 * D, D, Bt + (size_t)n0 * D, D, D, smem, wave_, acc);
    int t = TIDX; asm volatile("" : "+v"(t));
    const int lane = t & 63, wid = t >> 6, wr = wid >> 2, wc = wid & 3, fr = lane & 15, fq = lane >> 4;
#pragma unroll
    for (int ai = 0; ai < 2; ++ai)
#pragma unroll
      for (int m = 0; m < 4; ++m) {
        bf16_t* drow = dst + (size_t)(m0 + ai * 128 + wr * 64 + m * 16 + fr) * ld + nb + wc * 32;
#pragma unroll
        for (int bj = 0; bj < 2; ++bj)
          if ((bsel >> bj) & 1) store_bf16x8_pair(drow + bj * 128, acc[ai][bj][m][0], acc[ai][bj][m][1], fq);
      }
  }
}

#define LA_(i, j) (UPPER ? A[(63 - (i)) * 68 + (63 - (j))] : A[(i) * 68 + (j)])
#define TI_(i, j) (UPPER ? ((63 - (i)) * 65 + (63 - (j))) : ((i) * 65 + (j)))
template <bool UPPER>
DI void tri_diag_wave(const float* __restrict__ A, float* __restrict__ T32, int lane) {
  int g = lane >> 4, c = lane & 15;
  asm volatile("" : "+v"(g), "+v"(c));
  float tv[16];
#pragma unroll
  for (int i = 0; i < 16; ++i) {
    float acc = (i == c) ? 1.f : 0.f;
#pragma unroll
    for (int j = 0; j < i; ++j) acc -= LA_(16 * g + i, 16 * g + j) * tv[j];
    tv[i] = acc;
  }
#pragma unroll
  for (int i = 0; i < 16; ++i) T32[TI_(16 * g + i, 16 * g + c)] = tv[i];
}
template <bool UPPER, int DD>
DI void tri_block_wave(const float* __restrict__ A, float* __restrict__ T32, int lane, int q) {
  int g = lane >> 4, c = lane & 15;
  asm volatile("" : "+v"(g), "+v"(c));
  const int pb = q + DD;
  f32x4 S = {0.f, 0.f, 0.f, 0.f};
#pragma unroll
  for (int kd = 0; kd < DD; ++kd) {
    const int k = q + kd;
#pragma unroll
    for (int ks = 0; ks < 4; ++ks) {
      float av = LA_(16 * pb + c, 16 * k + 4 * ks + g);
      float bv = T32[TI_(16 * k + 4 * ks + g, 16 * q + c)];
      S = __builtin_amdgcn_mfma_f32_16x16x4f32(av, bv, S, 0, 0, 0);
    }
  }
  f32x4 R = {0.f, 0.f, 0.f, 0.f};
#pragma unroll
  for (int ks = 0; ks < 4; ++ks) {
    float av = T32[TI_(16 * pb + c, 16 * pb + 4 * g + ks)];
    R = __builtin_amdgcn_mfma_f32_16x16x4f32(av, S[ks], R, 0, 0, 0);
  }
#pragma unroll
  for (int e = 0; e < 4; ++e) T32[TI_(16 * pb + 4 * g + e, 16 * q + c)] = -R[e];
}
#undef LA_
#undef TI_

DI int item_row0(int b, int gc) { return gc < 4 ? TX + b * CTXL + gc * 64 : b * SEQ + (gc - 4) * 64; }

DI void phase_g1(const Params& p, char* smem, const int wave_) {
  const int tid0 = TIDX;
  bf16_t* qn = (bf16_t*)smem;
  bf16_t* kn = qn + 64 * 136;
  bf16_t* vn = kn + 64 * 136;
  char* big = (char*)(vn + 64 * 136);
  float* KKs = (float*)big;
  float* QKs = KKs + 64 * 65;
  float* T32f = KKs;
  float* T32b = QKs;
  float* Af = (float*)(big + 33280);
  float* Ab = Af + 64 * 68;
  bf16_t* kbdT = (bf16_t*)big;
  bf16_t* vbT = kbdT + 128 * 72;
  bf16_t* Tf = (bf16_t*)(big + 68096);
  bf16_t* Tb = Tf + 64 * 72;
  float* sc = (float*)(Tb + 64 * 72);
  float *decf = sc, *decb = sc + 64, *betaf = sc + 128, *betab = sc + 192, *ckf = sc + 256, *ckb = sc + 320;
  float* cwq = sc + 384;
  float* cwa = cwq + 1152;

  const bf16_t* gate = (const bf16_t*)(p.ws + OFF_GATE);
  const bf16_t* qkv = (const bf16_t*)((const char*)p.out + DO_QKV);
  const float* ab = (const float*)(p.ws + OFF_AB);
  bf16_t* y = (bf16_t*)(p.ws + OFF_HBUF);
  const float scale = 0.08838834764831845f;

  for (int item = blockIdx.x; item < NITEM; item += gridDim.x) {
    int t = tid0;
    asm volatile("" : "+v"(t));
    const int lane = t & 63, wv = __builtin_amdgcn_readfirstlane(t >> 6), r = lane & 31, h2 = lane >> 5;
    const int b = item / (4 * NCH), hh = (item / NCH) & 3, gc = item % NCH;
    const int row0 = item_row0(b, gc);
    const int L = gc < 4 ? CTXL : SEQ;
    const int tpos0 = gc < 4 ? gc * 64 : (gc - 4) * 64;
    {
      float wst[3];
#pragma unroll
      for (int e = 0; e < 3; ++e) {
        const int idx = t + e * NT;
        const int ten = idx / 384, rem = idx - ten * 384, tap = rem >> 7, ch = rem & 127;
        const float* sp = idx < 1152 ? p.ev_qkv_conv + tap * 1536 + ten * 512 + hh * 128 + ch : p.ev_a_conv + tap * 512 + hh * 128 + ch;
        wst[e] = *sp;
      }
#pragma unroll
      for (int e = 0; e < 3; ++e) cwq[t + e * NT] = wst[e];
    }
    __syncthreads();
    float pre_af = 0.f, pre_abk = 0.f, pre_bfv = 0.f, pre_bbv = 0.f;
    if (wv == 0) {
      const float* abr = ab + (size_t)(row0 + lane) * 16;
      pre_af = abr[hh]; pre_abk = abr[4 + hh]; pre_bfv = abr[8 + hh]; pre_bbv = abr[12 + hh];
    }
    {
      const int i = t >> 3, part = t & 7;
      const int tp = tpos0 + i;
      const bool hasm = tp > 0, hasp = tp < L - 1;
      const int om = hasm ? 1536 : 0, op = hasp ? 1536 : 0;
      const unsigned mm = hasm ? ~0u : 0u, mp = hasp ? ~0u : 0u;
      const size_t rowc = (size_t)(row0 + i);
      const bf16_t* qsrc = qkv + rowc * 1536 + hh * 128 + part * 16;
      const bf16_t* gsrc = gate + rowc * 1536 + hh * 128 + part * 16;
      uint4 rc[3][2], rm[3][2], rp[3][2];
#pragma unroll
      for (int ten = 0; ten < 3; ++ten) {
        const bf16_t* src = qsrc + ten * 512;
        rc[ten][0] = *(const uint4*)(src); rc[ten][1] = *(const uint4*)(src + 8);
        rm[ten][0] = *(const uint4*)(src - om); rm[ten][1] = *(const uint4*)(src - om + 8);
        rp[ten][0] = *(const uint4*)(src + op); rp[ten][1] = *(const uint4*)(src + op + 8);
      }
      uint4 bg[2], cgm[2], cgc[2], cgp[2], xam[2], xac[2], xap[2];
      bg[0] = *(const uint4*)(gsrc); bg[1] = *(const uint4*)(gsrc + 8);
      cgc[0] = *(const uint4*)(gsrc + 512); cgc[1] = *(const uint4*)(gsrc + 512 + 8);
      xac[0] = *(const uint4*)(gsrc + 1024); xac[1] = *(const uint4*)(gsrc + 1024 + 8);
      cgm[0] = *(const uint4*)(gsrc - om + 512); cgm[1] = *(const uint4*)(gsrc - om + 512 + 8);
      xam[0] = *(const uint4*)(gsrc - om + 1024); xam[1] = *(const uint4*)(gsrc - om + 1024 + 8);
      cgp[0] = *(const uint4*)(gsrc + op + 512); cgp[1] = *(const uint4*)(gsrc + op + 512 + 8);
      xap[0] = *(const uint4*)(gsrc + op + 1024); xap[1] = *(const uint4*)(gsrc + op + 1024 + 8);
      __builtin_amdgcn_sched_barrier(0);
#pragma unroll
      for (int ten = 0; ten < 3; ++ten) {
        float v[16];
        const unsigned um[8] = {rm[ten][0].x & mm, rm[ten][0].y & mm, rm[ten][0].z & mm, rm[ten][0].w & mm, rm[ten][1].x & mm, rm[ten][1].y & mm, rm[ten][1].z & mm, rm[ten][1].w & mm};
        const unsigned uc[8] = {rc[ten][0].x, rc[ten][0].y, rc[ten][0].z, rc[ten][0].w, rc[ten][1].x, rc[ten][1].y, rc[ten][1].z, rc[ten][1].w};
        const unsigned up[8] = {rp[ten][0].x & mp, rp[ten][0].y & mp, rp[ten][0].z & mp, rp[ten][0].w & mp, rp[ten][1].x & mp, rp[ten][1].y & mp, rp[ten][1].z & mp, rp[ten][1].w & mp};
        const float* w0 = cwq + ten * 384 + part * 16; const float* w1 = w0 + 128; const float* w2 = w0 + 256;
        float ss = 0.f;
#pragma unroll
        for (int e = 0; e < 8; ++e) {
          float a0 = w0[2 * e] * bflo(um[e]) + w1[2 * e] * bflo(uc[e]) + w2[2 * e] * bflo(up[e]);
          float a1 = w0[2 * e + 1] * bfhi(um[e]) + w1[2 * e + 1] * bfhi(uc[e]) + w2[2 * e + 1] * bfhi(up[e]);
          a0 = siluf(a0); a1 = siluf(a1);
          v[2 * e] = a0; v[2 * e + 1] = a1;
          ss += a0 * a0 + a1 * a1;
        }
        float sc_ = 1.f;
        if (ten < 2) {
          ss += __shfl_xor(ss, 1); ss += __shfl_xor(ss, 2); ss += __shfl_xor(ss, 4);
          sc_ = rsqrtf(ss + EPS);
        }
        uint4 o0, o1;
        o0.x = pack2(v[0] * sc_, v[1] * sc_); o0.y = pack2(v[2] * sc_, v[3] * sc_); o0.z = pack2(v[4] * sc_, v[5] * sc_); o0.w = pack2(v[6] * sc_, v[7] * sc_);
        o1.x = pack2(v[8] * sc_, v[9] * sc_); o1.y = pack2(v[10] * sc_, v[11] * sc_); o1.z = pack2(v[12] * sc_, v[13] * sc_); o1.w = pack2(v[14] * sc_, v[15] * sc_);
        bf16_t* dstl = (ten == 0 ? qn : ten == 1 ? kn : vn) + i * 136 + part * 16;
        *(uint4*)dstl = o0; *(uint4*)(dstl + 8) = o1;
      }
      {
        const int ch0 = hh * 128 + part * 16;
        const unsigned ubg[8] = {bg[0].x, bg[0].y, bg[0].z, bg[0].w, bg[1].x, bg[1].y, bg[1].z, bg[1].w};
        const unsigned ucm[8] = {cgm[0].x & mm, cgm[0].y & mm, cgm[0].z & mm, cgm[0].w & mm, cgm[1].x & mm, cgm[1].y & mm, cgm[1].z & mm, cgm[1].w & mm};
        const unsigned ucc[8] = {cgc[0].x, cgc[0].y, cgc[0].z, cgc[0].w, cgc[1].x, cgc[1].y, cgc[1].z, cgc[1].w};
        const unsigned ucp[8] = {cgp[0].x & mp, cgp[0].y & mp, cgp[0].z & mp, cgp[0].w & mp, cgp[1].x & mp, cgp[1].y & mp, cgp[1].z & mp, cgp[1].w & mp};
        const unsigned uxm[8] = {xam[0].x, xam[0].y, xam[0].z, xam[0].w, xam[1].x, xam[1].y, xam[1].z, xam[1].w};
        const unsigned uxc[8] = {xac[0].x, xac[0].y, xac[0].z, xac[0].w, xac[1].x, xac[1].y, xac[1].z, xac[1].w};
        const unsigned uxp[8] = {xap[0].x, xap[0].y, xap[0].z, xap[0].w, xap[1].x, xap[1].y, xap[1].z, xap[1].w};
        const float* w0 = cwa + part * 16; const float* w1 = w0 + 128; const float* w2 = w0 + 256;
        unsigned o[8];
#pragma unroll
        for (int e = 0; e < 8; ++e) {
          float a0 = w0[2 * e] * bflo(ucm[e]) * bflo(uxm[e]) + w1[2 * e] * bflo(ucc[e]) * bflo(uxc[e]) + w2[2 * e] * bflo(ucp[e]) * bflo(uxp[e]);
          float a1 = w0[2 * e + 1] * bfhi(ucm[e]) * bfhi(uxm[e]) + w1[2 * e + 1] * bfhi(ucc[e]) * bfhi(uxc[e]) + w2[2 * e + 1] * bfhi(ucp[e]) * bfhi(uxp[e]);
          o[e] = pack2(bflo(ubg[e]) * a0, bfhi(ubg[e]) * a1);
        }
        bf16_t* yd = y + rowc * 1024 + ch0;
        *(uint4*)yd = make_uint4(o[0], o[1], o[2], o[3]);
        *(uint4*)(yd + 8) = make_uint4(o[4], o[5], o[6], o[7]);
      }
    }
    if (wv == 0) {
      const float af = pre_af, abk = pre_abk, bfv = pre_bfv, bbv = pre_bbv;
      float gf = -expf(p.ev_a_log[hh]) * softplusf(af + p.ev_dt_bias[hh]);
      float gb = -expf(p.ev_a_log[4 + hh]) * softplusf(abk + p.ev_dt_bias[4 + hh]);
      float bef = sigmoidf(bfv), beb = sigmoidf(bbv);
      float pf = gf, sb = gb;
#pragma unroll
      for (int o = 1; o < 64; o <<= 1) {
        float u = __shfl_up(pf, o);
        if (lane >= o) pf += u;
        float d = __shfl_down(sb, o);
        if (lane + o < 64) sb += d;
      }
      decf[lane] = pf; decb[lane] = sb; betaf[lane] = bef; betab[lane] = beb;
      ckf[lane] = bef * __expf(pf); ckb[lane] = beb * __expf(sb);
      float lastf = __shfl(pf, 63), lastb = __shfl(sb, 0);
      float* scg = (float*)(p.ws + OFF_SC) + (size_t)(item * 2) * 256;
      scg[lane] = scale * __expf(pf);
      scg[64 + lane] = __expf(lastf - pf);
      if (lane == 0) scg[128] = __expf(lastf);
      scg[256 + lane] = scale * __expf(sb);
      scg[256 + 64 + lane] = __expf(lastb - sb);
      if (lane == 0) scg[256 + 128] = __expf(lastb);
    }
    __syncthreads();
    {
      const int which = wv >> 2, mt = (wv >> 1) & 1, nt = wv & 1;
      const bf16_t* Asrc = which ? qn : kn;
      f32x16 acc;
#pragma unroll
      for (int e = 0; e < 16; ++e) acc[e] = 0.f;
#pragma unroll
      for (int kk = 0; kk < 8; ++kk) {
        bf16x8 a = *(const bf16x8*)(Asrc + (mt * 32 + r) * 136 + (2 * kk + h2) * 8);
        bf16x8 bb = *(const bf16x8*)(kn + (nt * 32 + r) * 136 + (2 * kk + h2) * 8);
        acc = MFMA32(a, bb, acc);
      }
      float* dstm = which ? QKs : KKs;
#pragma unroll
      for (int e = 0; e < 16; ++e) dstm[(mt * 32 + crow32(e, h2)) * 65 + nt * 32 + r] = acc[e];
    }
    __syncthreads();
    {
      bf16_t* qg = (bf16_t*)(p.ws + OFF_QN) + (size_t)item * 8192;
#pragma unroll
      for (int e = 0; e < 2; ++e) {
        int c = t + e * NT, row = c >> 4, cc = c & 15;
        *(uint4*)(qg + row * 128 + cc * 8) = *(const uint4*)(qn + row * 136 + cc * 8);
      }
      bf16_t* kg = (bf16_t*)(p.ws + OFF_KT) + (size_t)item * 8192;
      const int d = t >> 2, jg = t & 3;
      unsigned o[8];
#pragma unroll
      for (int e = 0; e < 8; ++e) {
        unsigned lo = kn[(jg * 16 + 2 * e) * 136 + d], hi = kn[(jg * 16 + 2 * e + 1) * 136 + d];
        o[e] = lo | (hi << 16);
      }
      *(uint4*)(kg + d * 64 + jg * 16) = make_uint4(o[0], o[1], o[2], o[3]);
      *(uint4*)(kg + d * 64 + jg * 16 + 8) = make_uint4(o[4], o[5], o[6], o[7]);
    }
    {
      bf16_t* inf_ = (bf16_t*)(p.ws + OFF_INTRA) + (size_t)(item * 2) * 4096;
      bf16_t* inb_ = inf_ + 4096;
      const int i = t >> 3, j8 = (t & 7) * 8;
      const float dfi = decf[i], dbi = decb[i], bfi = betaf[i], bbi = betab[i];
      float af_[8], ab_[8], if_[8], ib_[8];
#pragma unroll
      for (int e = 0; e < 8; ++e) {
        const int j = j8 + e;
        float kk = KKs[i * 65 + j], qk = QKs[i * 65 + j];
        float ef = __expf(fminf(dfi - decf[j], 0.f)), eb = __expf(fminf(dbi - decb[j], 0.f));
        af_[e] = (i > j) ? bfi * kk * ef : 0.f;
        ab_[e] = (i < j) ? bbi * kk * eb : 0.f;
        if_[e] = (i >= j) ? scale * qk * ef : 0.f;
        ib_[e] = (i <= j) ? scale * qk * eb : 0.f;
      }
      *(float4*)(Af + i * 68 + j8) = make_float4(af_[0], af_[1], af_[2], af_[3]);
      *(float4*)(Af + i * 68 + j8 + 4) = make_float4(af_[4], af_[5], af_[6], af_[7]);
      *(float4*)(Ab + i * 68 + j8) = make_float4(ab_[0], ab_[1], ab_[2], ab_[3]);
      *(float4*)(Ab + i * 68 + j8 + 4) = make_float4(ab_[4], ab_[5], ab_[6], ab_[7]);
      *(uint4*)(inf_ + i * 64 + j8) = make_uint4(pack2(if_[0], if_[1]), pack2(if_[2], if_[3]), pack2(if_[4], if_[5]), pack2(if_[6], if_[7]));
      *(uint4*)(inb_ + i * 64 + j8) = make_uint4(pack2(ib_[0], ib_[1]), pack2(ib_[2], ib_[3]), pack2(ib_[4], ib_[5]), pack2(ib_[6], ib_[7]));
    }
    __syncthreads();
    if (wv == 0) tri_diag_wave<false>(Af, T32f, lane);
    else if (wv == 1) tri_diag_wave<true>(Ab, T32b, lane);
    __syncthreads();
    if (wv < 6) { if (wv & 1) tri_block_wave<true, 1>(Ab, T32b, lane, wv >> 1); else tri_block_wave<false, 1>(Af, T32f, lane, wv >> 1); }
    __syncthreads();
    if (wv < 4) { if (wv & 1) tri_block_wave<true, 2>(Ab, T32b, lane, wv >> 1); else tri_block_wave<false, 2>(Af, T32f, lane, wv >> 1); }
    __syncthreads();
    if (wv < 2) { if (wv & 1) tri_block_wave<true, 3>(Ab, T32b, lane, 0); else tri_block_wave<false, 3>(Af, T32f, lane, 0); }
    __syncthreads();
#pragma unroll
    for (int e = 0; e < 8; ++e) {
      int idx = t + e * NT, i = idx >> 6, j = idx & 63;
      Tf[i * 72 + j] = f2bf(((i >> 4) >= (j >> 4)) ? T32f[i * 65 + j] : 0.f);
      Tb[i * 72 + j] = f2bf(((i >> 4) <= (j >> 4)) ? T32b[i * 65 + j] : 0.f);
    }
    __syncthreads();
#pragma unroll 1
    for (int dir = 0; dir < 2; ++dir) {
      const float* ck = dir ? ckb : ckf;
      const float* be = dir ? betab : betaf;
      {
        const int d = t >> 2, jg = t & 3;
        unsigned ok[8], ov[8];
#pragma unroll
        for (int e = 0; e < 8; ++e) {
          int j0 = jg * 16 + 2 * e, j1 = j0 + 1;
          ok[e] = pack2(bf2f(kn[j0 * 136 + d]) * ck[j0], bf2f(kn[j1 * 136 + d]) * ck[j1]);
          ov[e] = pack2(bf2f(vn[j0 * 136 + d]) * be[j0], bf2f(vn[j1 * 136 + d]) * be[j1]);
        }
        *(uint4*)(kbdT + d * 72 + jg * 16) = make_uint4(ok[0], ok[1], ok[2], ok[3]);
        *(uint4*)(kbdT + d * 72 + jg * 16 + 8) = make_uint4(ok[4], ok[5], ok[6], ok[7]);
        *(uint4*)(vbT + d * 72 + jg * 16) = make_uint4(ov[0], ov[1], ov[2], ov[3]);
        *(uint4*)(vbT + d * 72 + jg * 16 + 8) = make_uint4(ov[4], ov[5], ov[6], ov[7]);
      }
      __syncthreads();
      {
        const bf16_t* T = dir ? Tb : Tf;
        const int mt = wv >> 2, nt = wv & 3;
        f32x16 aw, au;
#pragma unroll
        for (int e = 0; e < 16; ++e) { aw[e] = 0.f; au[e] = 0.f; }
#pragma unroll
        for (int kk = 0; kk < 4; ++kk) {
          bf16x8 a = *(const bf16x8*)(T + (mt * 32 + r) * 72 + (2 * kk + h2) * 8);
          bf16x8 bk = *(const bf16x8*)(kbdT + (nt * 32 + r) * 72 + (2 * kk + h2) * 8);
          bf16x8 bv = *(const bf16x8*)(vbT + (nt * 32 + r) * 72 + (2 * kk + h2) * 8);
          aw = MFMA32(bk, a, aw);
          au = MFMA32(a, bv, au);
        }
        bf16_t* wg = (bf16_t*)(p.ws + OFF_W) + (size_t)(item * 2 + dir) * 8192;
        bf16_t* ug = (bf16_t*)(p.ws + OFF_UT) + (size_t)(item * 2 + dir) * 8192;
#pragma unroll
        for (int g = 0; g < 4; ++g) {
          uint2 o;
          o.x = pack2(aw[4 * g], aw[4 * g + 1]);
          o.y = pack2(aw[4 * g + 2], aw[4 * g + 3]);
          *(uint2*)(wg + (mt * 32 + r) * 128 + nt * 32 + 8 * g + 4 * h2) = o;
          o.x = pack2(au[4 * g], au[4 * g + 1]);
          o.y = pack2(au[4 * g + 2], au[4 * g + 3]);
          *(uint2*)(ug + (nt * 32 + r) * 64 + mt * 32 + 8 * g + 4 * h2) = o;
        }
      }
      __syncthreads();
    }
  }
}

DI void phase_g2(const Params& p, char* smem, const int wave_) {
  int t = TIDX;
  asm volatile("" : "+v"(t));
  const int lane = t & 63, wv = t >> 6, l15 = lane & 15, lg = lane >> 4;
  bf16_t* wS = (bf16_t*)smem;
  bf16_t* qS = wS + 64 * 136;
  bf16_t* kTS = qS + 64 * 136;
  bf16_t* inS = kTS + 128 * 72;
  bf16_t* Sbf = inS + 64 * 72;
  bf16_t* vnT = Sbf + 2 * 32 * 136;
  bf16_t* veT = vnT + 32 * 72;
  const int mt = wv >> 1, nt = wv & 1;

  for (int cbase = 0; cbase < 256; cbase += gridDim.x) {
    const int chain = xcd_item(cbase);
    if (chain >= 256) continue;
    const int b = chain >> 5, hh = (chain >> 3) & 3, dir = (chain >> 2) & 1, dvq = chain & 3;
    bf16_t* og = (bf16_t*)((char*)p.out + (dir ? DO_OB : DO_OF));
    __syncthreads();
    f32x4 Sacc[2];
#pragma unroll
    for (int n = 0; n < 2; ++n)
#pragma unroll
      for (int e = 0; e < 4; ++e) Sacc[n][e] = 0.f;
    for (int i = t; i < 32 * 136; i += NT) Sbf[i] = 0;
    int cur = 0;
    auto gc_of = [&](int n) { return dir == 0 ? n : (n < 4 ? 3 - n : 71 - n); };
    auto item_of = [&](int n) { return (b * 4 + hh) * NCH + gc_of(n); };
    uint4 rw0A, rw1A, rq0A, rq1A, rk0A, rk1A, riA, rw0B, rw1B, rq0B, rq1B, rk0B, rk1B, riB;
    uint2 ruA, ruB; float4 rs4A, re4A, rs4B, re4B; float rlastA, rlastB;
#define G2_LOAD_W(n_, S) { \
      const bf16_t* wg_ = (const bf16_t*)(p.ws + OFF_W) + (size_t)(item_of(n_) * 2 + dir) * 8192; \
      rw0##S = *(const uint4*)(wg_ + (size_t)t * 8); rw1##S = *(const uint4*)(wg_ + (size_t)(t + NT) * 8); }
#define G2_STORE_W(S) { \
      *(uint4*)(wS + (t >> 4) * 136 + (t & 15) * 8) = rw0##S; \
      *(uint4*)(wS + ((t + NT) >> 4) * 136 + (t & 15) * 8) = rw1##S; }
#define G2_LOAD_REST(n_, S) { \
      const int it_ = item_of(n_); \
      const bf16_t* qg_ = (const bf16_t*)(p.ws + OFF_QN) + (size_t)it_ * 8192; \
      const bf16_t* kg_ = (const bf16_t*)(p.ws + OFF_KT) + (size_t)it_ * 8192; \
      const bf16_t* ig_ = (const bf16_t*)(p.ws + OFF_INTRA) + (size_t)(it_ * 2 + dir) * 4096; \
      const bf16_t* ug_ = (const bf16_t*)(p.ws + OFF_UT) + (size_t)(it_ * 2 + dir) * 8192; \
      const float* scg_ = (const float*)(p.ws + OFF_SC) + (size_t)(it_ * 2 + dir) * 256; \
      rq0##S = *(const uint4*)(qg_ + (size_t)t * 8); rq1##S = *(const uint4*)(qg_ + (size_t)(t + NT) * 8); \
      rk0##S = *(const uint4*)(kg_ + (size_t)t * 8); rk1##S = *(const uint4*)(kg_ + (size_t)(t + NT) * 8); \
      ri##S = *(const uint4*)(ig_ + (size_t)t * 8); \
      ru##S = *(const uint2*)(ug_ + (dvq * 32 + nt * 16 + l15) * 64 + mt * 16 + 4 * lg); \
      rs4##S = *(const float4*)(scg_ + mt * 16 + 4 * lg); \
      re4##S = *(const float4*)(scg_ + 64 + mt * 16 + 4 * lg); \
      rlast##S = scg_[128]; }
#define G2_STORE_REST(S) { \
      *(uint4*)(qS + (t >> 4) * 136 + (t & 15) * 8) = rq0##S; \
      *(uint4*)(qS + ((t + NT) >> 4) * 136 + (t & 15) * 8) = rq1##S; \
      *(uint4*)(kTS + (t >> 3) * 72 + (t & 7) * 8) = rk0##S; \
      *(uint4*)(kTS + ((t + NT) >> 3) * 72 + (t & 7) * 8) = rk1##S; \
      *(uint4*)(inS + (t >> 3) * 72 + (t & 7) * 8) = ri##S; }
#define G2_STEP(n_, S, T) { \
      const uint2 u_cur = ru##S; const float4 s_cur = rs4##S, e_cur = re4##S; const float last_cur = rlast##S; \
      G2_STORE_REST(S); \
      if ((n_) + 2 < NCH) G2_LOAD_REST((n_) + 2, S); \
      { \
        f32x4 R = {0.f, 0.f, 0.f, 0.f}; \
        const bf16_t* Sb = Sbf + cur * 32 * 136; \
        _Pragma("unroll") for (int kk = 0; kk < 4; ++kk) { \
          bf16x8 a = *(const bf16x8*)(wS + (mt * 16 + l15) * 136 + (4 * kk + lg) * 8); \
          bf16x8 bb = *(const bf16x8*)(Sb + (nt * 16 + l15) * 136 + (4 * kk + lg) * 8); \
          R = MFMA16(a, bb, R); \
        } \
        float v0 = bflo(u_cur.x) - R[0], v1 = bfhi(u_cur.x) - R[1], v2 = bflo(u_cur.y) - R[2], v3 = bfhi(u_cur.y) - R[3]; \
        uint2 o, oe; \
        o.x = pack2(v0, v1); o.y = pack2(v2, v3); \
        oe.x = pack2(v0 * e_cur.x, v1 * e_cur.y); oe.y = pack2(v2 * e_cur.z, v3 * e_cur.w); \
        *(uint2*)(vnT + (nt * 16 + l15) * 72 + mt * 16 + 4 * lg) = o; \
        *(uint2*)(veT + (nt * 16 + l15) * 72 + mt * 16 + 4 * lg) = oe; \
      } \
      __syncthreads(); \
      { \
        const bf16_t* Sb = Sbf + cur * 32 * 136; \
        f32x4 O = {0.f, 0.f, 0.f, 0.f}; \
        _Pragma("unroll") for (int kk = 0; kk < 4; ++kk) { \
          bf16x8 a = *(const bf16x8*)(qS + (mt * 16 + l15) * 136 + (4 * kk + lg) * 8); \
          bf16x8 bb = *(const bf16x8*)(Sb + (nt * 16 + l15) * 136 + (4 * kk + lg) * 8); \
          O = MFMA16(a, bb, O); \
        } \
        O[0] *= s_cur.x; O[1] *= s_cur.y; O[2] *= s_cur.z; O[3] *= s_cur.w; \
        _Pragma("unroll") for (int kk = 0; kk < 2; ++kk) { \
          bf16x8 a = *(const bf16x8*)(inS + (mt * 16 + l15) * 72 + (4 * kk + lg) * 8); \
          bf16x8 bb = *(const bf16x8*)(vnT + (nt * 16 + l15) * 72 + (4 * kk + lg) * 8); \
          O = MFMA16(a, bb, O); \
        } \
        const int row0 = item_row0(b, gc_of(n_)); \
        _Pragma("unroll") for (int e = 0; e < 4; ++e) \
          og[(size_t)(row0 + mt * 16 + 4 * lg + e) * 512 + hh * 128 + dvq * 32 + nt * 16 + l15] = f2bf(O[e]); \
        bf16_t* Sn = Sbf + (cur ^ 1) * 32 * 136; \
        _Pragma("unroll") for (int n2 = 0; n2 < 2; ++n2) { \
          f32x4 sa = Sacc[n2]; \
          sa[0] *= last_cur; sa[1] *= last_cur; sa[2] *= last_cur; sa[3] *= last_cur; \
          _Pragma("unroll") for (int kk = 0; kk < 2; ++kk) { \
            bf16x8 a = *(const bf16x8*)(kTS + (wv * 16 + l15) * 72 + (4 * kk + lg) * 8); \
            bf16x8 bb = *(const bf16x8*)(veT + (n2 * 16 + l15) * 72 + (4 * kk + lg) * 8); \
            sa = MFMA16(a, bb, sa); \
          } \
          Sacc[n2] = sa; \
          uint2 o; \
          o.x = pack2(sa[0], sa[1]); o.y = pack2(sa[2], sa[3]); \
          *(uint2*)(Sn + (n2 * 16 + l15) * 136 + wv * 16 + 4 * lg) = o; \
        } \
      } \
      if ((n_) + 1 < NCH) G2_STORE_W(T); \
      if ((n_) + 3 < NCH) G2_LOAD_W((n_) + 3, T); \
      __syncthreads(); \
      cur ^= 1; }
    G2_LOAD_W(0, A); G2_STORE_W(A);
    G2_LOAD_REST(0, A);
    G2_LOAD_W(1, B); G2_LOAD_REST(1, B);
    G2_LOAD_W(2, A);
    __syncthreads();
#pragma unroll 1
    for (int n = 0; n < NCH; n += 2) {
      G2_STEP(n, A, B)
      G2_STEP(n + 1, B, A)
    }
#undef G2_STEP
  }
}

DI void phase_yb(const Params& p, const int wave_) {
  const int t = TIDX, lane = t & 63, wv = t >> 6;
  const bf16_t* of = (const bf16_t*)((const char*)p.out + DO_OF);
  const bf16_t* ob = (const bf16_t*)((const char*)p.out + DO_OB);
  const bf16_t* z = (const bf16_t*)(p.ws + OFF_Z);
  bf16_t* y = (bf16_t*)(p.ws + OFF_HBUF);
  for (int row = blockIdx.x * 8 + wv; row < TT; row += gridDim.x * 8) {
    uint4 a = *(const uint4*)(of + (size_t)row * 512 + lane * 8);
    uint4 b = *(const uint4*)(ob + (size_t)row * 512 + lane * 8);
    uint4 zz = *(const uint4*)(z + (size_t)row * 512 + lane * 8);
    const unsigned *ua = (const unsigned*)&a, *ub = (const unsigned*)&b, *uz = (const unsigned*)&zz;
    float o[8], ss = 0.f;
#pragma unroll
    for (int e = 0; e < 4; ++e) {
      o[2 * e] = bflo(ua[e]) + bflo(ub[e]);
      o[2 * e + 1] = bfhi(ua[e]) + bfhi(ub[e]);
      ss += o[2 * e] * o[2 * e] + o[2 * e + 1] * o[2 * e + 1];
    }
    ss += __shfl_xor(ss, 1); ss += __shfl_xor(ss, 2); ss += __shfl_xor(ss, 4); ss += __shfl_xor(ss, 8);
    float rr = rsqrtf(ss * (1.f / 128.f) + EPS);
    const float* gn = p.ev_o_norm + (lane & 15) * 8;
    unsigned oo[4];
#pragma unroll
    for (int e = 0; e < 4; ++e) {
      float z0 = bflo(uz[e]), z1 = bfhi(uz[e]);
      oo[e] = pack2(o[2 * e] * rr * gn[2 * e] * siluf(z0), o[2 * e + 1] * rr * gn[2 * e + 1] * siluf(z1));
    }
    *(uint4*)(y + (size_t)row * 1024 + 512 + lane * 8) = make_uint4(oo[0], oo[1], oo[2], oo[3]);
  }
}

DI void phase_outproj(const Params& p, char* smem, int layer, const int wave_) {
  const bf16_t* A = (const bf16_t*)(p.ws + OFF_HBUF);
  const bf16_t* Bt = (const bf16_t*)(p.ws + (layer ? OFF_WT_OUT1 : OFF_WT_OUT0));
  const float* mod = (const float*)(p.ws + OFF_MOD) + (size_t)layer * 9 * 6144;
  float* ctxbuf = (float*)(p.ws + OFF_CTXBUF);
  const int ntm = (layer ? TX : TT) / 256, ntn = 4;
  for (int tbase = 0; tbase < ntm * ntn; tbase += gridDim.x) {
    const int tile = xcd_item(tbase);
    if (tile >= ntm * ntn) continue;
    const int tm = tile / ntn, tn = tile % ntn;
    const int m0 = tm * 256, n0 = tn * 256;
    const int mb = row_mb(m0);
    const float* g = mod + (size_t)mb * 6144 + 2 * 1024;
    acc256_t acc;
    gemm256<3>(A + (size_t)m0 * D, D, Bt + (size_t)n0 * D, D, D, smem, wave_, acc);
    int t = TIDX; asm volatile("" : "+v"(t));
    const int lane = t & 63, wid = t >> 6, wr = wid >> 2, wc = wid & 3, fr = lane & 15, fq = lane >> 4;
    const bool isx = m0 < TX;
    const float* resb = layer ? p.out : (isx ? p.x : p.ctx - (size_t)TX * D);
    float* outb = isx ? p.out : ctxbuf - (size_t)TX * D;
    const float* csc = mod + (size_t)mb * 6144 + 4 * 1024;
    const float* gn2 = p.norm2 + layer * 1024;
    bf16_t* apr = (bf16_t*)(p.ws + OFF_Q);
    float ssl[2][4];
#pragma unroll
    for (int ai = 0; ai < 2; ++ai)
#pragma unroll
      for (int m = 0; m < 4; ++m) ssl[ai][m] = 0.f;
#pragma unroll
    for (int bj = 0; bj < 2; ++bj) {
      const int col = n0 + bj * 128 + wc * 32 + fq * 4;
      const float4 gg0 = *(const float4*)(g + col), gg1 = *(const float4*)(g + col + 16);
      const float4 ca = *(const float4*)(csc + col), cb = *(const float4*)(csc + col + 16);
      const float4 na = *(const float4*)(gn2 + col), nb = *(const float4*)(gn2 + col + 16);
      const f32x4 cc0 = {na.x * (1.f + ca.x), na.y * (1.f + ca.y), na.z * (1.f + ca.z), na.w * (1.f + ca.w)};
      const f32x4 cc1 = {nb.x * (1.f + cb.x), nb.y * (1.f + cb.y), nb.z * (1.f + cb.z), nb.w * (1.f + cb.w)};
#pragma unroll
      for (int ai = 0; ai < 2; ++ai)
#pragma unroll
        for (int m = 0; m < 4; ++m) {
          const size_t rowoff = (size_t)(m0 + ai * 128 + wr * 64 + m * 16 + fr) * D;
          const float4 r0_ = *(const float4*)(resb + rowoff + col), r1_ = *(const float4*)(resb + rowoff + col + 16);
          const f32x4 v0 = acc[ai][bj][m][0], v1 = acc[ai][bj][m][1];
          const f32x4 x0 = {r0_.x + gg0.x * v0[0], r0_.y + gg0.y * v0[1], r0_.z + gg0.z * v0[2], r0_.w + gg0.w * v0[3]};
          const f32x4 x1 = {r1_.x + gg1.x * v1[0], r1_.y + gg1.y * v1[1], r1_.z + gg1.z * v1[2], r1_.w + gg1.w * v1[3]};
          *(float4*)(outb + rowoff + col) = make_float4(x0[0], x0[1], x0[2], x0[3]);
          *(float4*)(outb + rowoff + col + 16) = make_float4(x1[0], x1[1], x1[2], x1[3]);
          ssl[ai][m] += x0[0] * x0[0] + x0[1] * x0[1] + x0[2] * x0[2] + x0[3] * x0[3] + x1[0] * x1[0] + x1[1] * x1[1] + x1[2] * x1[2] + x1[3] * x1[3];
          store_bf16x8_pair(apr + rowoff + n0 + bj * 128 + wc * 32, x0 * cc0, x1 * cc1, fq);
        }
    }
    float* red = (float*)(smem + G8_LDS);
#pragma unroll
    for (int ai = 0; ai < 2; ++ai)
#pragma unroll
      for (int m = 0; m < 4; ++m) {
        float ss = ssl[ai][m];
        ss += __shfl_xor(ss, 16);
        ss += __shfl_xor(ss, 32);
        if (fq == 0) red[(ai * 128 + wr * 64 + m * 16 + fr) * 4 + wc] = ss;
      }
    __syncthreads();
    if (t < 256) {
      const float4 v = *(const float4*)(red + t * 4);
      ((float*)(p.ws + OFF_SSQ2))[(size_t)(m0 + t) * 4 + tn] = (v.x + v.y) + (v.z + v.w);
    }
  }
}

DI unsigned f2ord(float f) { unsigned u = __float_as_uint(f); return (u & 0x80000000u) ? ~u : (u | 0x80000000u); }
DI float ord2f(unsigned u) { return __uint_as_float((u & 0x80000000u) ? (u & 0x7fffffffu) : ~u); }
#define CE_DESC(a, b) { unsigned mx_ = max(a, b), mn_ = min(a, b); a = mx_; b = mn_; }

DI void bitonic_merge16(unsigned (&v)[16]) {
#pragma unroll
  for (int j = 8; j > 0; j >>= 1)
#pragma unroll
    for (int i = 0; i < 16; ++i)
      if ((i & j) == 0) CE_DESC(v[i], v[i | j]);
}
DI void sort16_desc(unsigned (&v)[16]) {
#define S_(i, j) CE_DESC(v[i], v[j]);
  S_(0, 13) S_(1, 12) S_(2, 15) S_(3, 14) S_(4, 8) S_(5, 6) S_(7, 11) S_(9, 10)
  S_(0, 5) S_(1, 7) S_(2, 9) S_(3, 4) S_(6, 13) S_(8, 14) S_(10, 15) S_(11, 12)
  S_(0, 1) S_(2, 3) S_(4, 5) S_(6, 8) S_(7, 9) S_(10, 11) S_(12, 13) S_(14, 15)
  S_(0, 2) S_(1, 3) S_(4, 10) S_(5, 11) S_(6, 7) S_(8, 9) S_(12, 14) S_(13, 15)
  S_(1, 2) S_(3, 12) S_(4, 6) S_(5, 7) S_(8, 10) S_(9, 11) S_(13, 14)
  S_(1, 4) S_(2, 6) S_(5, 8) S_(7, 10) S_(9, 13) S_(11, 14)
  S_(2, 4) S_(3, 6) S_(9, 12) S_(11, 13)
  S_(3, 5) S_(6, 8) S_(7, 9) S_(10, 12)
  S_(3, 4) S_(5, 6) S_(7, 8) S_(9, 10) S_(11, 12)
  S_(6, 7) S_(8, 9)
#undef S_
}
DI void merge_top16(unsigned (&a)[16], const unsigned (&b)[16]) {
#pragma unroll
  for (int i = 0; i < 16; ++i) a[i] = max(a[i], b[15 - i]);
  bitonic_merge16(a);
}
DI void top16_of_64(unsigned (&g0)[16], unsigned (&g1)[16], unsigned (&g2)[16], unsigned (&g3)[16]) {
  sort16_desc(g0); sort16_desc(g1); sort16_desc(g2); sort16_desc(g3);
  merge_top16(g0, g1);
  merge_top16(g2, g3);
  merge_top16(g0, g2);
}
DI void top16set_of_64(unsigned (&g0)[16], unsigned (&g1)[16], unsigned (&g2)[16], unsigned (&g3)[16]) {
  sort16_desc(g0); sort16_desc(g1); sort16_desc(g2); sort16_desc(g3);
  merge_top16(g0, g1);
  merge_top16(g2, g3);
#pragma unroll
  for (int i = 0; i < 16; ++i) g0[i] = max(g0[i], g2[15 - i]);
}


__constant__ unsigned char CAND_AB[64] = {
    0x00, 0x01, 0x02, 0x03, 0x04, 0x05, 0x06, 0x07, 0x08, 0x09, 0x0A, 0x0B, 0x0C, 0x0D, 0x0E, 0x0F,
    0x10, 0x11, 0x12, 0x13, 0x14, 0x15, 0x16, 0x17,
    0x20, 0x21, 0x22, 0x23, 0x24,
    0x30, 0x31, 0x32, 0x33,
    0x40, 0x41, 0x42,
    0x50, 0x51, 0x60, 0x61, 0x70, 0x71,
    0x80, 0x90, 0xA0, 0xB0, 0xC0, 0xD0, 0xE0, 0xF0,
    0, 0, 0, 0, 0, 0, 0, 0, 0, 0, 0, 0, 0, 0};
constexpr int cand_index(int a, int b) {
  int c = 0;
  for (int aa = 0; aa < 16; ++aa)
    for (int bb = 0; bb < 16; ++bb) {
      if (aa == a && bb == b) return c;
      if ((aa + 1) * (bb + 1) <= 16) ++c;
    }
  return c;
}

constexpr int cand_ab(int ci) {
  int c = 0;
  for (int aa = 0; aa < 16; ++aa)
    for (int bb = 0; bb < 16; ++bb)
      if ((aa + 1) * (bb + 1) <= 16) { if (c == ci) return (aa << 4) | bb; ++c; }
  return 0;
}
template <int S>
DI unsigned cand_key(const float (&v1)[16], const float (&v2)[16], int h) {
  constexpr int abA = cand_ab(2 * S), abB = cand_ab(2 * S + 1);
  const float sA = v1[abA >> 4] + v2[abA & 15], sB = v1[abB >> 4] + v2[abB & 15];
  return (f2ord(h ? sB : sA) & ~63u) | (unsigned)(2 * S) | (unsigned)h;
}

DI void phase_peerq(const Params& p, char* smem, int layer, const int wave_) {
  const int tid0 = TIDX;
  const bf16_t* A = (const bf16_t*)(p.ws + OFF_Q);
  const bf16_t* Bt = (const bf16_t*)(p.ws + OFF_WT_PQ) + (size_t)layer * 1024 * 1024;
  const bf16_t* keys = (const bf16_t*)(p.ws + OFF_KEYS) + (size_t)layer * 8 * 2 * 128 * 64;
  int* seli = (int*)(p.ws + OFF_SELI);
  float* selg = (float*)(p.ws + OFF_SELG);
  float* selu = (float*)(p.ws + OFF_SELU);
  const float* tsc = (const float*)(p.ws + (layer ? OFF_TSC1 : OFF_TSC));
  bf16_t* qs = (bf16_t*)smem;
  unsigned char* isc = (unsigned char*)(smem + 135168);
  const int ntm = (layer ? TX : TT) / 256;
  const int ntl = ntm * 4, gsz = gridDim.x, remt = ntl % gsz, fullt = ntl - remt;
  const bool split_tail = remt > 0 && 2 * remt <= gsz;
  for (int tbase = 0; tbase < ntl; tbase += gsz) {
    int tile, hb0 = 0, hb1 = 2;
    if (split_tail && tbase == fullt) {
      const int pos = xcd_item(0);
      if (pos >= 2 * remt) continue;
      tile = fullt + (pos >> 1); hb0 = pos & 1; hb1 = hb0 + 1;
    } else {
      tile = xcd_item(tbase);
      if (tile >= ntl) continue;
    }
    const int tm = tile >> 2, tn = tile & 3;
    const int m0 = tm * 256, n0 = tn * 256;
    {
      acc256_t acc;
      gemm256<3>(A + (size_t)m0 * D, D, Bt + (size_t)n0 * D, D, D, smem, wave_, acc);
      int t = tid0; asm volatile("" : "+v"(t));
      const int lane = t & 63, wid = t >> 6, wr = wid >> 2, wc = wid & 3, fr = lane & 15, fq = lane >> 4;
      const float* pqb = (const float*)(p.ws + OFF_PQB) + (size_t)(layer * 9 + row_mb(m0)) * 1024 + n0 + wc * 32 + fq * 4;
      float4 bias[2][2];
#pragma unroll
      for (int bj = 0; bj < 2; ++bj)
#pragma unroll
        for (int n = 0; n < 2; ++n) bias[bj][n] = *(const float4*)(pqb + bj * 128 + n * 16);
#pragma unroll
      for (int ai = 0; ai < 2; ++ai)
#pragma unroll
        for (int m = 0; m < 4; ++m) {
          const int rl = ai * 128 + wr * 64 + m * 16 + fr;
          const float4 sq = *(const float4*)((const float*)(p.ws + OFF_SSQ2) + (size_t)(m0 + rl) * 4);
          const float rr = rsqrtf(((sq.x + sq.y) + (sq.z + sq.w)) * (1.f / 1024.f) + EPS);
          bf16_t* qd = qs + rl * 264 + wc * 32 + fq * 4;
#pragma unroll
          for (int bj = 0; bj < 2; ++bj)
#pragma unroll
            for (int n = 0; n < 2; ++n) {
              const f32x4 v = acc[ai][bj][m][n];
              const float4 bb = bias[bj][n];
              *(uint2*)(qd + bj * 128 + n * 16) = make_uint2(pack2(v[0] * rr + bb.x, v[1] * rr + bb.y), pack2(v[2] * rr + bb.z, v[3] * rr + bb.w));
            }
        }
    }
    __syncthreads();
#pragma unroll 1
    for (int hb = hb0; hb < hb1; ++hb) {
    int t = tid0;
    asm volatile("" : "+v"(t));
    const int lane = t & 63, wv = t >> 6, r = lane & 31, h = lane >> 5;
    const int hd = tn * 2 + hb;
    unsigned top0[16], top1[16];
#pragma unroll
    for (int half = 0; half < 2; ++half) {
      f32x16 acc[4];
#pragma unroll
      for (int m = 0; m < 4; ++m)
#pragma unroll
        for (int e = 0; e < 16; ++e) acc[m][e] = 0.f;
      const bf16_t* kb = keys + (size_t)((hd * 2 + half) * 128) * 64;
#pragma unroll
      for (int kk = 0; kk < 4; ++kk) {
        bf16x8 bq = *(const bf16x8*)(qs + (wv * 32 + r) * 264 + hb * 128 + half * 64 + 16 * kk + 8 * h);
#pragma unroll
        for (int m = 0; m < 4; ++m) {
          bf16x8 ak = *(const bf16x8*)(kb + (m * 32 + r) * 64 + 16 * kk + 8 * h);
          acc[m] = MFMA32(ak, bq, acc[m]);
        }
      }
      unsigned g0[16], g1[16], g2[16], g3[16];
#pragma unroll
      for (int e = 0; e < 16; ++e) {
        g0[e] = (f2ord(acc[0][e]) & ~127u) | (unsigned)(0 + crow32(e, h));
        g1[e] = (f2ord(acc[1][e]) & ~127u) | (unsigned)(32 + crow32(e, h));
        g2[e] = (f2ord(acc[2][e]) & ~127u) | (unsigned)(64 + crow32(e, h));
        g3[e] = (f2ord(acc[3][e]) & ~127u) | (unsigned)(96 + crow32(e, h));
      }
      top16_of_64(g0, g1, g2, g3);
      unsigned pp[16];
#pragma unroll
      for (int i = 0; i < 16; ++i) pp[i] = __shfl_xor(g0[i], 32);
      merge_top16(g0, pp);
      if (half == 0) {
#pragma unroll
        for (int i = 0; i < 16; ++i) top0[i] = g0[i];
      } else {
#pragma unroll
        for (int i = 0; i < 16; ++i) top1[i] = g0[i];
      }
    }
#pragma unroll
    for (int i = 0; i < 16; ++i) {
      isc[t * 32 + i] = (unsigned char)(top0[i] & 127u);
      isc[t * 32 + 16 + i] = (unsigned char)(top1[i] & 127u);
    }
    float v1[16], v2[16];
#pragma unroll
    for (int i = 0; i < 16; ++i) { v1[i] = ord2f(top0[i] & ~127u); v2[i] = ord2f(top1[i] & ~127u); }
    unsigned c0[16], c1[16];
    c0[0] = cand_key<0>(v1, v2, h); c0[1] = cand_key<1>(v1, v2, h); c0[2] = cand_key<2>(v1, v2, h); c0[3] = cand_key<3>(v1, v2, h);
    c0[4] = cand_key<4>(v1, v2, h); c0[5] = cand_key<5>(v1, v2, h); c0[6] = cand_key<6>(v1, v2, h); c0[7] = cand_key<7>(v1, v2, h);
    c0[8] = cand_key<8>(v1, v2, h); c0[9] = cand_key<9>(v1, v2, h); c0[10] = cand_key<10>(v1, v2, h); c0[11] = cand_key<11>(v1, v2, h);
    c0[12] = cand_key<12>(v1, v2, h); c0[13] = cand_key<13>(v1, v2, h); c0[14] = cand_key<14>(v1, v2, h); c0[15] = cand_key<15>(v1, v2, h);
    c1[0] = cand_key<16>(v1, v2, h); c1[1] = cand_key<17>(v1, v2, h); c1[2] = cand_key<18>(v1, v2, h); c1[3] = cand_key<19>(v1, v2, h);
    c1[4] = cand_key<20>(v1, v2, h); c1[5] = cand_key<21>(v1, v2, h); c1[6] = cand_key<22>(v1, v2, h); c1[7] = cand_key<23>(v1, v2, h);
    c1[8] = cand_key<24>(v1, v2, h);
#pragma unroll
    for (int i = 9; i < 16; ++i) c1[i] = 0u;
    sort16_desc(c0); sort16_desc(c1);
    merge_top16(c0, c1);
    {
      unsigned pq[16];
#pragma unroll
      for (int i = 0; i < 16; ++i) pq[i] = __shfl_xor(c0[i], 32);
#pragma unroll
      for (int i = 0; i < 16; ++i) c0[i] = max(c0[i], pq[15 - i]);
    }
    unsigned umx = c0[0];
#pragma unroll
    for (int i = 1; i < 16; ++i) umx = max(umx, c0[i]);
    float sc[16], mx = ord2f(umx & ~63u), sum = 0.f;
#pragma unroll
    for (int i = 0; i < 16; ++i) { sc[i] = __expf(ord2f(c0[i] & ~63u) - mx); sum += sc[i]; }
    float inv = 1.f / sum;
    const int row = m0 + wv * 32 + r;
    int* di = seli + ((size_t)row * 8 + hd) * 16 + 8 * h;
    float* dg = selg + ((size_t)row * 8 + hd) * 16 + 8 * h;
    float* du = selu + ((size_t)row * 8 + hd) * 16 + 8 * h;
    int exv[8];
    float uuv[8], ggv[8];
#pragma unroll
    for (int i = 0; i < 8; ++i) {
      const unsigned s_ = c0[i];
      const float g_ = sc[i] * inv;
      unsigned ab = CAND_AB[s_ & 63u];
      int i1 = isc[t * 32 + (ab >> 4)], i2 = isc[t * 32 + 16 + (ab & 15)];
      const int ex = i1 * 128 + i2;
      exv[i] = ex;
      uuv[i] = tsc[ex];
      ggv[i] = g_ * tsc[16384 + ex];
    }
    *(int4*)di = make_int4(exv[0], exv[1], exv[2], exv[3]); *(int4*)(di + 4) = make_int4(exv[4], exv[5], exv[6], exv[7]);
    *(float4*)du = make_float4(uuv[0], uuv[1], uuv[2], uuv[3]); *(float4*)(du + 4) = make_float4(uuv[4], uuv[5], uuv[6], uuv[7]);
    *(float4*)dg = make_float4(ggv[0], ggv[1], ggv[2], ggv[3]); *(float4*)(dg + 4) = make_float4(ggv[4], ggv[5], ggv[6], ggv[7]);
    }
    __syncthreads();
  }
}

DI float gelu_exact(float x) { return 0.5f * x * (1.f + erff(x * 0.7071067811865476f)); }
DI float blendf(float a, float b, unsigned m) {
  unsigned ua = __float_as_uint(a), ub = __float_as_uint(b);
  return __uint_as_float(ua ^ ((ua ^ ub) & m));
}
DI float wave_max(float v) {
#pragma unroll
  for (int o = 32; o > 0; o >>= 1) v = fmaxf(v, __shfl_xor(v, o));
  return v;
}

typedef float f32x32v __attribute__((ext_vector_type(32)));
typedef unsigned u32x6v __attribute__((ext_vector_type(6)));
constexpr int TROW = 768;
constexpr int TVOFF = TROW;
constexpr int TPAIR = 2 * TROW;
DI void convert_tables(const Params& p, int layer, int part, int nparts, const int wave_) {
  const int wv = wave_;
  char* tab = p.ws + (layer ? OFF_TAB1 : OFF_TAB);
  float* tsc = (float*)(p.ws + (layer ? OFF_TSC1 : OFF_TSC));
  for (int pr2 = part * 8 + wv; pr2 < 16384; pr2 += nparts * 8) {
    int lane = TIDX & 63;
    asm volatile("" : "+v"(lane));
    const int l31 = lane & 31, rr = pr2 * 2 + (lane >> 5);
    const float* src = ((rr >> 14) ? p.p_v : p.p_u) + (size_t)layer * 16384 * 1024 + (size_t)(rr & 16383) * 1024 + 32 * l31;
    float v[32];
    float m = 0.f;
#pragma unroll
    for (int j = 0; j < 8; ++j) {
      float4 a = *(const float4*)(src + 4 * j);
      v[4 * j] = a.x; v[4 * j + 1] = a.y; v[4 * j + 2] = a.z; v[4 * j + 3] = a.w;
      m = fmaxf(m, fmaxf(fmaxf(fabsf(a.x), fabsf(a.y)), fmaxf(fabsf(a.z), fabsf(a.w))));
    }
#pragma unroll
    for (int o = 16; o > 0; o >>= 1) m = fmaxf(m, __shfl_xor(m, o));
    const float scale = m > 0.f ? m * (1.f / 7.5f) : 1.f;
    const float inv = 1.f / scale;
    unsigned w[7] = {0u, 0u, 0u, 0u, 0u, 0u, 0u};
#pragma unroll
    for (int i = 0; i < 32; ++i) {
      const float a = fminf(fabsf(v[i]) * inv, 7.5f);
      const float c = a < 2.f ? __builtin_rintf(a * 8.f) : (a < 4.f ? __builtin_rintf(a * 4.f) + 8.f : __builtin_rintf(a * 2.f) + 16.f);
      unsigned code = (unsigned)c;
      code = code > 31u ? 31u : code;
      code |= (__float_as_uint(v[i]) >> 31) << 5;
      const int bit = 6 * i, d = bit >> 5, sh = bit & 31;
      w[d] |= code << sh;
      if (sh > 26) w[d + 1] |= code >> (32 - sh);
    }
    char* dst = tab + (size_t)(rr & 16383) * TPAIR + (rr >> 14) * TROW + l31 * 24;
    *(uint2*)(dst) = make_uint2(w[0], w[1]);
    *(uint2*)(dst + 8) = make_uint2(w[2], w[3]);
    *(uint2*)(dst + 16) = make_uint2(w[4], w[5]);
    if (l31 == 0) tsc[rr] = scale;
  }
}

struct Row6 { uint2 a, b, c; };
DI Row6 row6_load(const __amdgpu_buffer_rsrc_t trs, int voff, int soff) {
  Row6 r;
  typedef unsigned u32x2v __attribute__((ext_vector_type(2)));
  u32x2v x0 = __builtin_amdgcn_raw_buffer_load_b64(trs, voff, soff, 0);
  u32x2v x1 = __builtin_amdgcn_raw_buffer_load_b64(trs, voff + 8, soff, 0);
  u32x2v x2 = __builtin_amdgcn_raw_buffer_load_b64(trs, voff + 16, soff, 0);
  r.a = make_uint2(x0[0], x0[1]); r.b = make_uint2(x1[0], x1[1]); r.c = make_uint2(x2[0], x2[1]);
  return r;
}
typedef __bf16 bf16x32v __attribute__((ext_vector_type(32)));
DI float row6_dot(const Row6& r, const unsigned (&hp)[16]) {
  u32x6v q = {r.a.x, r.a.y, r.b.x, r.b.y, r.c.x, r.c.y};
  const bf16x32v y = __builtin_amdgcn_cvt_scalef32_pk32_bf16_fp6(q, 1.0f);
  float s0 = 0.f, s1 = 0.f;
#pragma unroll
  for (int i = 0; i < 8; ++i) {
    s0 = __builtin_amdgcn_fdot2_f32_bf16(__builtin_bit_cast(bf16x2v, hp[2 * i]), bf16x2v{y[4 * i], y[4 * i + 1]}, s0, false);
    s1 = __builtin_amdgcn_fdot2_f32_bf16(__builtin_bit_cast(bf16x2v, hp[2 * i + 1]), bf16x2v{y[4 * i + 2], y[4 * i + 3]}, s1, false);
  }
  return s0 + s1;
}
DI f32x32v row6_decode(const Row6& r) {
  u32x6v q = {r.a.x, r.a.y, r.b.x, r.b.y, r.c.x, r.c.y};
  return __builtin_amdgcn_cvt_scalef32_pk32_f32_fp6(q, 1.0f);
}
DI int pick_voff(int ids, int k, int half, int l31) {
  const int ea = __builtin_amdgcn_readlane(ids, k & 63), eb = __builtin_amdgcn_readlane(ids, (k + 1) & 63);
  return (half ? eb : ea) * TPAIR + l31 * 24;
}

DI void convert_in_tail(const Params& p, int layer, int ntiles, const int wave_, int split = 1) {
  const int g = gridDim.x, rem0 = ntiles % g, rem = (split * rem0 <= g) ? split * rem0 : rem0;
  const int pos = (blockIdx.x & 7) * (g >> 3) + (blockIdx.x >> 3);
  if (rem == 0) convert_tables(p, layer, blockIdx.x, g, wave_);
  else if (pos >= rem) convert_tables(p, layer, pos - rem, g - rem, wave_);
}

DI void phase_gather(const Params& p, int layer, const int wave_) {
  const int wv = wave_;
  const float* mod = (const float*)(p.ws + OFF_MOD) + (size_t)layer * 9 * 6144;
  const float* mod1 = (const float*)(p.ws + OFF_MOD) + (size_t)9 * 6144;
  const __amdgpu_buffer_rsrc_t trs = __builtin_amdgcn_make_buffer_rsrc((void*)(p.ws + (layer ? OFF_TAB1 : OFF_TAB)), 0, 16384 * TPAIR, 0x00020000);
  const int* seli = (const int*)(p.ws + OFF_SELI);
  const float* selg = (const float*)(p.ws + OFF_SELG);
  const float* selu = (const float*)(p.ws + OFF_SELU);
  bf16_t* hbuf = (bf16_t*)(p.ws + OFF_HBUF);
  const int nrows = layer ? TX : TT;
  unsigned* qhead = (unsigned*)(p.ws + OFF_BAR) + 3584 + 64 * layer;
  const int nstatic = gridDim.x * 8;
  for (int row = blockIdx.x * 8 + wv; row < nrows;) {
    int lane = TIDX & 63;
    asm volatile("" : "+v"(lane));
    const int l31 = lane & 31, half = lane >> 5;
    const int pidx = 2 * (((lane >> 4) & 1) * 2 + ((lane >> 3) & 1)) + half;
    float* xr = (row < TX ? p.out + (size_t)row * D : (float*)(p.ws + OFF_CTXBUF) + (size_t)(row - TX) * D) + 32 * l31;
    const int mb = row_mb(row);
    const float* mrow = mod + (size_t)mb * 6144 + 32 * l31;
    unsigned hp[16];
    f32x32v acc;
    {
      float xv[32];
      float ss = 0.f;
#pragma unroll
      for (int j = 0; j < 8; ++j) {
        float4 a = *(const float4*)(xr + 4 * j);
        xv[4 * j] = a.x; xv[4 * j + 1] = a.y; xv[4 * j + 2] = a.z; xv[4 * j + 3] = a.w;
        ss += a.x * a.x + a.y * a.y + a.z * a.z + a.w * a.w;
      }
      ss = wave_sum(ss) * 0.5f;
      const float rr = rsqrtf(ss * (1.f / 1024.f) + EPS);
      const float* gn = p.norm2 + layer * 1024 + 32 * l31;
#pragma unroll
      for (int i = 0; i < 16; ++i)
        hp[i] = pack2(xv[2 * i] * rr * gn[2 * i] * (1.f + mrow[4 * 1024 + 2 * i]) + mrow[3 * 1024 + 2 * i],
                      xv[2 * i + 1] * rr * gn[2 * i + 1] * (1.f + mrow[4 * 1024 + 2 * i + 1]) + mrow[3 * 1024 + 2 * i + 1]);
    }
#pragma unroll
    for (int i = 0; i < 32; ++i) acc[i] = 0.f;
    const int* si = seli + (size_t)row * 128;
    const float* sg = selg + (size_t)row * 128 + pidx;
    const float* su = selu + (size_t)row * 128 + pidx;
    asm volatile("" ::: "memory");
    const int ia = si[lane], ib = si[64 + lane];
    Row6 UU[4], VV[4];
#pragma unroll
    for (int j = 0; j < 4; ++j) {
      const int vo = pick_voff(ia, 2 * j, half, l31);
      UU[j] = row6_load(trs, vo, 0);
      VV[j] = row6_load(trs, vo, TVOFF);
    }
    const unsigned m4 = (lane & 16) ? ~0u : 0u, m3 = (lane & 8) ? ~0u : 0u;
#define GATHER_GROUP(g_, MORE) { \
      const int isn = ((g_) + 1) < 8 ? ia : ib; \
      const int kb = ((g_) + 1) << 3; \
      const float su_g = su[(g_) * 8], sg_g = sg[(g_) * 8]; \
      float d[4]; \
      _Pragma("unroll") for (int j = 0; j < 4; ++j) { \
        d[j] = row6_dot(UU[j], hp); \
        if (MORE) UU[j] = row6_load(trs, pick_voff(isn, kb + 2 * j, half, l31), 0); \
        __builtin_amdgcn_sched_barrier(0); \
      } \
      float e2[2], e1; \
      _Pragma("unroll") for (int q = 0; q < 2; ++q) { \
        float keep = blendf(d[q], d[q + 2], m4), send = blendf(d[q + 2], d[q], m4); \
        e2[q] = keep + __shfl_xor(send, 16); \
      } \
      { float keep = blendf(e2[0], e2[1], m3), send = blendf(e2[1], e2[0], m3); e1 = keep + __shfl_xor(send, 8); } \
      e1 += __shfl_xor(e1, 4); e1 += __shfl_xor(e1, 2); e1 += __shfl_xor(e1, 1); \
      const int ai = __float_as_int(sg_g * gelu_exact(su_g * e1)); \
      _Pragma("unroll") for (int j = 0; j < 4; ++j) { \
        const int sl = 16 * (j >> 1) + 8 * (j & 1); \
        const int ca = __builtin_amdgcn_readlane(ai, sl), cb = __builtin_amdgcn_readlane(ai, 32 + sl); \
        const float cq = __int_as_float(half ? cb : ca); \
        const f32x32v y = row6_decode(VV[j]); \
        if (MORE) VV[j] = row6_load(trs, pick_voff(isn, kb + 2 * j, half, l31), TVOFF); \
        acc += y * cq; \
        __builtin_amdgcn_sched_barrier(0); \
      } }
#pragma unroll 1
    for (int g = 0; g < 15; ++g) GATHER_GROUP(g, true)
    unsigned ticket = 0u;
    if (lane == 0) ticket = __hip_atomic_fetch_add(qhead, 1u, __ATOMIC_RELAXED, __HIP_MEMORY_SCOPE_AGENT);
    GATHER_GROUP(15, false)
#undef GATHER_GROUP
    const int next_row = nstatic + (int)__builtin_amdgcn_readfirstlane(ticket);
    asm volatile("" ::: "memory");
    float xn[16];
    {
      float tot[16];
#pragma unroll
      for (int i = 0; i < 16; ++i) {
        const float lo = acc[i], hi = acc[16 + i];
        const float mine = half ? hi : lo, other = half ? lo : hi;
        tot[i] = mine + __shfl_xor(other, 32);
      }
      const float* xq = xr + 16 * half;
      const float* mq = mrow + 5 * 1024 + 16 * half;
#pragma unroll
      for (int j = 0; j < 4; ++j) {
        float4 a = *(const float4*)(xq + 4 * j);
        xn[4 * j] = a.x + mq[4 * j] * tot[4 * j]; xn[4 * j + 1] = a.y + mq[4 * j + 1] * tot[4 * j + 1];
        xn[4 * j + 2] = a.z + mq[4 * j + 2] * tot[4 * j + 2]; xn[4 * j + 3] = a.w + mq[4 * j + 3] * tot[4 * j + 3];
      }
    }
    const int c0 = 32 * l31 + 16 * half;
    float s2 = 0.f;
#pragma unroll
    for (int i = 0; i < 16; ++i) s2 += xn[i] * xn[i];
    s2 = wave_sum(s2);
    const float rr = rsqrtf(s2 * (1.f / 1024.f) + EPS);
    float* xo = xr + 16 * half;
    if (layer == 0) {
#pragma unroll
      for (int j = 0; j < 4; ++j) *(float4*)(xo + 4 * j) = make_float4(xn[4 * j], xn[4 * j + 1], xn[4 * j + 2], xn[4 * j + 3]);
      const float* gn = p.norm1 + 1024 + c0;
      const float* m1 = mod1 + (size_t)mb * 6144 + c0;
      unsigned o[8];
#pragma unroll
      for (int i = 0; i < 8; ++i)
        o[i] = pack2(xn[2 * i] * rr * gn[2 * i] * (1.f + m1[1024 + 2 * i]) + m1[2 * i],
                     xn[2 * i + 1] * rr * gn[2 * i + 1] * (1.f + m1[1024 + 2 * i + 1]) + m1[2 * i + 1]);
      bf16_t* hd = hbuf + (size_t)row * D + c0;
      *(uint4*)hd = make_uint4(o[0], o[1], o[2], o[3]);
      *(uint4*)(hd + 8) = make_uint4(o[4], o[5], o[6], o[7]);
    } else {
      const float* gn = p.norm_f + c0;
#pragma unroll
      for (int j = 0; j < 4; ++j)
        *(float4*)(xo + 4 * j) = make_float4(xn[4 * j] * rr * gn[4 * j], xn[4 * j + 1] * rr * gn[4 * j + 1], xn[4 * j + 2] * rr * gn[4 * j + 2], xn[4 * j + 3] * rr * gn[4 * j + 3]);
    }
    row = next_row;
  }
}

DI void phase_inproj1(const Params& p, char* smem, const int wave_) {
  const bf16_t* A = (const bf16_t*)(p.ws + OFF_HBUF);
  const bf16_t* Bt = (const bf16_t*)(p.ws + OFF_WT_IN1);
  bf16_t* pr = (bf16_t*)(p.ws + OFF_PROJ1);
  const int ntn = 3, ntm = TT / 256;
  for (int tbase = 0; tbase < ntm * ntn; tbase += gridDim.x) {
    const int tile = xcd_item(tbase);
    if (tile >= ntm * ntn) continue;
    const int tm = tile / ntn, tn = tile % ntn;
    const int m0 = tm * 256, n0 = tn * 256;
    acc256_t acc;
    gemm256<3>(A + (size_t)m0 * D, D, Bt + (size_t)n0 * D, D, D, smem, wave_, acc);
    int t = TIDX; asm volatile("" : "+v"(t));
    const int lane = t & 63, wid = t >> 6, wr = wid >> 2, wc = wid & 3, fr = lane & 15, fq = lane >> 4;
    float* red = (float*)(smem + G8_LDS);
#pragma unroll
    for (int ai = 0; ai < 2; ++ai)
#pragma unroll
      for (int m = 0; m < 4; ++m) {
        const int rl = ai * 128 + wr * 64 + m * 16 + fr;
        bf16_t* drow = pr + (size_t)(m0 + rl) * 768 + n0 + wc * 32;
#pragma unroll
        for (int bj = 0; bj < 2; ++bj) {
          const f32x4 a = acc[ai][bj][m][0], c = acc[ai][bj][m][1];
          float ss = a[0] * a[0] + a[1] * a[1] + a[2] * a[2] + a[3] * a[3] + c[0] * c[0] + c[1] * c[1] + c[2] * c[2] + c[3] * c[3];
          ss += __shfl_xor(ss, 16);
          ss += __shfl_xor(ss, 32);
          if (fq == 0) red[(rl * 2 + bj) * 4 + wc] = ss;
          store_bf16x8_pair(drow + bj * 128, a, c, fq);
        }
      }
    __syncthreads();
    {
      const int row = t >> 1, bj = t & 1;
      const float4 v = *(const float4*)(red + (row * 2 + bj) * 4);
      const int slot = tn == 0 ? (bj ? 4 : 0) : (tn == 1 ? (bj ? 2 : 1) : (bj ? -1 : 3));
      if (slot >= 0) ((float*)(p.ws + OFF_SSQ))[(size_t)(m0 + row) * 8 + slot] = (v.x + v.y) + (v.z + v.w);
    }
  }
}

DI void phase_upproj_q(const Params& p, char* smem, const int wave_) {
  const bf16_t* pr = (const bf16_t*)(p.ws + OFF_PROJ1);
  const bf16_t* wq = (const bf16_t*)(p.ws + OFF_WT_UQ);
  bf16_t* Qb = (bf16_t*)(p.ws + OFF_Q);
  const float* ropec = (const float*)(p.ws + OFF_ROPE);
  float* rs = (float*)(smem + G8_LDS);
  float* rtab = rs + 256;
  { const int t0_ = TIDX; for (int i = t0_; i < 2048; i += NT) rtab[i] = ropec[i]; }
  const int nq = (TX / 256) * 6;
  for (int tbase = 0; tbase < nq; tbase += gridDim.x) {
    const int tile = xcd_item(tbase);
    if (tile >= nq) continue;
    const int tm = tile / 6, tn = tile % 6;
    const int m0 = tm * 256, n0 = tn * 256;
    __syncthreads();
    {
      const int t_ = TIDX;
      if (t_ < 256) { const float* sq = (const float*)(p.ws + OFF_SSQ) + (size_t)(m0 + t_) * 8; rs[t_] = rsqrtf((sq[0] + sq[4] + sq[1]) * (1.f / 384.f) + EPS); }
    }
    acc256_t acc;
    gemm256<3>(pr + (size_t)m0 * 768, 768, wq + (size_t)n0 * 384, 384, 384, smem, wave_, acc);
    int t = TIDX; asm volatile("" : "+v"(t));
    const int lane = t & 63, wid = t >> 6, wr = wid >> 2, wc = wid & 3, fr = lane & 15, fq = lane >> 4;
    const int b = m0 >> 12, t0 = m0 & 4095;
#pragma unroll
    for (int bj = 0; bj < 2; ++bj) {
      const int cg = n0 + bj * 128 + wc * 32;
      const int hd = cg / 192, d0 = cg % 192;
      const bool rope = d0 >= 128;
      const int seg = (d0 - 128) >> 5;
#pragma unroll
      for (int ai = 0; ai < 2; ++ai)
#pragma unroll
        for (int m = 0; m < 4; ++m) {
          const int rl = ai * 128 + wr * 64 + m * 16 + fr;
          const float sc = rs[rl];
          f32x4 x1 = acc[ai][bj][m][0], x2 = acc[ai][bj][m][1];
#pragma unroll
          for (int j = 0; j < 4; ++j) { x1[j] *= sc; x2[j] *= sc; }
          if (rope) {
            const int tok = t0 + rl;
            const int pos = seg == 0 ? (tok >> 6) : (tok & 63);
            const float4 cs = *(const float4*)(rtab + pos * 16 + fq * 4);
            const float4 sn = *(const float4*)(rtab + 1024 + pos * 16 + fq * 4);
            const float c_[4] = {cs.x, cs.y, cs.z, cs.w}, s_[4] = {sn.x, sn.y, sn.z, sn.w};
#pragma unroll
            for (int j = 0; j < 4; ++j) {
              const float a1 = x1[j], a2 = x2[j];
              x1[j] = a1 * c_[j] - a2 * s_[j];
              x2[j] = a2 * c_[j] + a1 * s_[j];
            }
          }
          bf16_t* qd = Qb + ((size_t)(b * 8 + hd) * 4096 + t0 + rl) * 192 + d0;
          store_bf16x8_pair(qd, x1, x2, fq);
        }
    }
  }
}

DI void phase_upproj_kv(const Params& p, char* smem, const int wave_) {
  const bf16_t* pr = (const bf16_t*)(p.ws + OFF_PROJ1);
  const bf16_t* wkv = (const bf16_t*)(p.ws + OFF_WT_UKV);
  bf16_t* Kb = (bf16_t*)(p.ws + OFF_K);
  bf16_t* VTb = (bf16_t*)(p.ws + OFF_VT);
  const float* ropec = (const float*)(p.ws + OFF_ROPE);
  const float* ropes = ropec + 1024;
  float* rs = (float*)(smem + G8_LDS);
  const int nkv = (TT / 256) * 8;
  for (int tbase = 0; tbase < nkv; tbase += gridDim.x) {
    const int tile = xcd_item(tbase);
    if (tile >= nkv) continue;
    const int tm = tile >> 3, hd = tile & 7;
    const int m0 = tm * 256, n0 = hd * 256;
    __syncthreads();
    {
      const int t_ = TIDX;
      if (t_ < 256) { const float* sq = (const float*)(p.ws + OFF_SSQ) + (size_t)(m0 + t_) * 8; rs[t_] = rsqrtf((sq[2] + sq[3]) * (1.f / 256.f) + EPS); }
    }
    acc256_t acc;
    gemm256<1>(pr + (size_t)m0 * 768 + 384, 768, wkv + (size_t)n0 * 256, 256, 256, smem, wave_, acc);
    int t = TIDX; asm volatile("" : "+v"(t));
    const int lane = t & 63, wid = t >> 6, wr = wid >> 2, wc = wid & 3, fr = lane & 15, fq = lane >> 4;
    const bool isx = m0 < TX;
    const int b = isx ? (m0 >> 12) : ((m0 - TX) >> 8);
    const int key0 = isx ? (m0 & 4095) : 4096;
    const size_t bh = (size_t)(b * 8 + hd);
#pragma unroll
    for (int ai = 0; ai < 2; ++ai)
#pragma unroll
      for (int m = 0; m < 4; ++m) {
        const int rl = ai * 128 + wr * 64 + m * 16 + fr;
        const float sc = rs[rl];
        bf16_t* kd = Kb + (bh * NKEY + key0 + rl) * 192 + wc * 32;
        store_bf16x8_pair(kd, acc[ai][0][m][0] * sc, acc[ai][0][m][1] * sc, fq);
      }
#pragma unroll
    for (int ai = 0; ai < 2; ++ai)
#pragma unroll
      for (int m = 0; m < 4; ++m) {
        const int rl0 = ai * 128 + wr * 64 + m * 16 + fq * 4;
        const int rl0p = ai * 128 + wr * 64 + m * 16 + (fq & 1) * 8 + (fq >> 1) * 4;
        const float4 sc = *(const float4*)(rs + rl0);
        const f32x4 va = acc[ai][1][m][0], vb = acc[ai][1][m][1];
        const unsigned x0 = pack2(va[0] * sc.x, va[1] * sc.y), x1 = pack2(va[2] * sc.z, va[3] * sc.w);
        const unsigned y0 = pack2(vb[0] * sc.x, vb[1] * sc.y), y1 = pack2(vb[2] * sc.z, vb[3] * sc.w);
        const auto s0 = __builtin_amdgcn_permlane32_swap(x0, y0, false, false);
        const auto s1 = __builtin_amdgcn_permlane32_swap(x1, y1, false, false);
        const int rl0q = ai * 128 + wr * 64 + m * 16 + (fq & 1) * 8;
        bf16_t* vd = VTb + (bh * 128 + wc * 32 + (fq >> 1) * 16 + fr) * NKEY + key0 + rl0q;
        *(uint4*)vd = make_uint4(s0[0], s1[0], s0[1], s1[1]);
      }
    {
      const int tok = t >> 1, seg = t & 1;
      const bf16_t* src = pr + (size_t)(m0 + tok) * 768 + 640 + seg * 32;
      const uint4 i0 = *(const uint4*)(src), i1 = *(const uint4*)(src + 8), i2 = *(const uint4*)(src + 16), i3 = *(const uint4*)(src + 24);
      const unsigned ua[8] = {i0.x, i0.y, i0.z, i0.w, i1.x, i1.y, i1.z, i1.w};
      const unsigned ub[8] = {i2.x, i2.y, i2.z, i2.w, i3.x, i3.y, i3.z, i3.w};
      float a[16], bq[16];
#pragma unroll
      for (int e = 0; e < 8; ++e) { a[2 * e] = bflo(ua[e]); a[2 * e + 1] = bfhi(ua[e]); bq[2 * e] = bflo(ub[e]); bq[2 * e + 1] = bfhi(ub[e]); }
      if (isx) {
        const int tt = key0 + tok;
        const int pos = seg == 0 ? (tt >> 6) : (tt & 63);
#pragma unroll
        for (int i = 0; i < 16; ++i) {
          float cs = ropec[pos * 16 + i], sn = ropes[pos * 16 + i];
          float na = a[i] * cs - bq[i] * sn, nb = bq[i] * cs + a[i] * sn;
          a[i] = na; bq[i] = nb;
        }
      }
      bf16_t* dst = Kb + (bh * NKEY + key0 + tok) * 192 + 128 + seg * 32;
      *(uint4*)(dst) = make_uint4(pack2(a[0], a[1]), pack2(a[2], a[3]), pack2(a[4], a[5]), pack2(a[6], a[7]));
      *(uint4*)(dst + 8) = make_uint4(pack2(a[8], a[9]), pack2(a[10], a[11]), pack2(a[12], a[13]), pack2(a[14], a[15]));
      *(uint4*)(dst + 16) = make_uint4(pack2(bq[0], bq[1]), pack2(bq[2], bq[3]), pack2(bq[4], bq[5]), pack2(bq[6], bq[7]));
      *(uint4*)(dst + 24) = make_uint4(pack2(bq[8], bq[9]), pack2(bq[10], bq[11]), pack2(bq[12], bq[13]), pack2(bq[14], bq[15]));
    }
  }
}

constexpr int AT_KS = 64 * 384;
constexpr int AT_VS = 128 * 128;
constexpr int AT_RD = 6;
template <int OFF>
DI void lds_rd128(bf16x8& d, unsigned addr) {
  asm volatile("ds_read_b128 %0, %1 offset:%2" : "=v"(d) : "v"(addr), "n"(OFF) : "memory");
}
template <int N>
DI void lgkm_wait(bf16x8& d) {
  asm volatile("s_waitcnt lgkmcnt(%1)" : "+v"(d) : "n"(N) : "memory");
}
template <int J, int OFF, int NS>
DI void att_issue(bf16x8& d, const unsigned (&kb)[4], const unsigned (&vb)[4]) {
  if constexpr (J < NS) {
    constexpr int G = (J + OFF) % 40;
    if constexpr (G < 24) {
      constexpr int kk = G >> 1, m = G & 1;
      lds_rd128<m * (32 * 384) + (kk >> 2) * 128>(d, kb[kk & 3]);
    } else {
      constexpr int j = G - 24;
      lds_rd128<(j & 3) * (32 * 128)>(d, vb[j >> 2]);
    }
  }
}
DI void phase_attn(const Params& p, char* smem, const int wave_) {
  int t = TIDX;
  asm volatile("" : "+v"(t));
  const int lane = t & 63, wv = t >> 6, r = lane & 31, h = lane >> 5;
  const bf16_t* Qb = (const bf16_t*)(p.ws + OFF_Q);
  const bf16_t* Kb = (const bf16_t*)(p.ws + OFF_K);
  const bf16_t* VTb = (const bf16_t*)(p.ws + OFF_VT);
  bf16_t* ob = (bf16_t*)(p.ws + OFF_HBUF);
  LAS char* lds = (LAS char*)smem;
  const unsigned ldsaddr = (unsigned)(size_t)lds;
  int kvo[3], vvo[2];
#pragma unroll
  for (int e = 0; e < 3; ++e) {
    const int L = (wv * 3 + e) * 1024 + lane * 16, row = L / 384, cs = (L % 384) >> 4;
    kvo[e] = row * 384 + ((cs ^ ((row >> 1) & 7)) << 4);
  }
#pragma unroll
  for (int e = 0; e < 2; ++e) {
    const int L = (wv * 2 + e) * 1024 + lane * 16, row = L >> 7, cs = (L & 127) >> 4;
    vvo[e] = row * (NKEY * 2) + ((cs ^ ((row >> 1) & 7)) << 4);
  }
  const int gh = ((r >> 1) & 7) ^ h;
  const int kro0 = r * 384 + (gh << 4), vro0 = r * 128 + (gh << 4);
  const f32x16 zero16 = {0.f, 0.f, 0.f, 0.f, 0.f, 0.f, 0.f, 0.f, 0.f, 0.f, 0.f, 0.f, 0.f, 0.f, 0.f, 0.f};
  for (int ibase = 0; ibase < 1024; ibase += gridDim.x) {
    const int item = xcd_item(ibase);
    if (item >= 1024) continue;
    const int bh = item >> 4, qb = item & 15;
    const int b = bh >> 3, hd = bh & 7;
    const __amdgpu_buffer_rsrc_t krs = __builtin_amdgcn_make_buffer_rsrc((void*)(Kb + (size_t)bh * NKEY * 192), 0, NKEY * 192 * 2, 0x00020000);
    const __amdgpu_buffer_rsrc_t vrs = __builtin_amdgcn_make_buffer_rsrc((void*)(VTb + (size_t)bh * 128 * NKEY), 0, 128 * NKEY * 2, 0x00020000);
    bf16x8 qf[12];
    {
      const bf16_t* qrow = Qb + ((size_t)bh * 4096 + qb * 256 + wv * 32 + r) * 192 + 8 * h;
#pragma unroll
      for (int kk = 0; kk < 12; ++kk) qf[kk] = *(const bf16x8*)(qrow + 16 * kk);
    }
    f32x16 O[4];
#pragma unroll
    for (int m = 0; m < 4; ++m)
#pragma unroll
      for (int e = 0; e < 16; ++e) O[m][e] = 0.f;
    float mrun = 0.f, lsum = 0.f;
    f32x16 negm = zero16;
#define AT_DMA_K(tile_, st_) { _Pragma("unroll") for (int e = 0; e < 3; ++e) \
      __builtin_amdgcn_raw_ptr_buffer_load_lds(krs, (LAS void*)(lds + (st_) * AT_KS + (wave_ * 3 + e) * 1024), 16, kvo[e], (tile_) * AT_KS, 0, 0); }
#define AT_DMA_V(tile_, st_) { _Pragma("unroll") for (int e = 0; e < 2; ++e) \
      __builtin_amdgcn_raw_ptr_buffer_load_lds(vrs, (LAS void*)(lds + 3 * AT_KS + (st_) * AT_VS + (wave_ * 2 + e) * 1024), 16, vvo[e], (tile_) * 128, 0, 0); }
    asm volatile("s_waitcnt vmcnt(0) lgkmcnt(0)" ::: "memory");
    __builtin_amdgcn_s_barrier();
    AT_DMA_K(0, 0); AT_DMA_V(0, 0);
    AT_DMA_K(1, 1); AT_DMA_V(1, 1);
    asm volatile("s_waitcnt vmcnt(0)" ::: "memory");
    __builtin_amdgcn_s_barrier();
    f32x16 S[2];
    bf16x8 fr[AT_RD];
    unsigned pw[16];
    int ksc = 0, ksn = 2, vsc = 0;
#define AT_STEP(j, OFF, NS) { \
      lgkm_wait<((j) + AT_RD - 1 < (NS) ? AT_RD - 1 : (NS) - 1 - (j))>(fr[(j) % AT_RD]); \
      if ((((j) + (OFF)) % 40) < 24) S[((j) + (OFF)) & 1] = MFMA32(fr[(j) % AT_RD], qf[((((j) + (OFF)) % 40) >> 1) % 12], (((j) + (OFF)) % 40) < 2 ? negm : S[((j) + (OFF)) & 1]); \
      else { const u32x4 pq_ = {pw[4 * ((((((j) + (OFF)) % 40) - 24) >> 2) & 3)], pw[4 * ((((((j) + (OFF)) % 40) - 24) >> 2) & 3) + 1], \
                                pw[4 * ((((((j) + (OFF)) % 40) - 24) >> 2) & 3) + 2], pw[4 * ((((((j) + (OFF)) % 40) - 24) >> 2) & 3) + 3]}; \
             O[((j) + (OFF)) & 3] = MFMA32(fr[(j) % AT_RD], __builtin_bit_cast(bf16x8, pq_), O[((j) + (OFF)) & 3]); } \
      att_issue<(j) + AT_RD, OFF, NS>(fr[(j) % AT_RD], kb, vb); }
#define AT_STEP8(j, OFF, NS) AT_STEP(j, OFF, NS) AT_STEP((j) + 1, OFF, NS) AT_STEP((j) + 2, OFF, NS) AT_STEP((j) + 3, OFF, NS) \
      AT_STEP((j) + 4, OFF, NS) AT_STEP((j) + 5, OFF, NS) AT_STEP((j) + 6, OFF, NS) AT_STEP((j) + 7, OFF, NS)
#define AT_FIRST(OFF, NS) { att_issue<0, OFF, NS>(fr[0], kb, vb); att_issue<1, OFF, NS>(fr[1], kb, vb); att_issue<2, OFF, NS>(fr[2], kb, vb); \
      att_issue<3, OFF, NS>(fr[3], kb, vb); att_issue<4, OFF, NS>(fr[4], kb, vb); att_issue<5, OFF, NS>(fr[5], kb, vb); }
#define AT_BASES(ks_, vs_) \
      unsigned kb[4], vb[4]; \
      { const unsigned kbase_ = ldsaddr + (ks_) * AT_KS, vbase_ = ldsaddr + 3 * AT_KS + (vs_) * AT_VS; \
        _Pragma("unroll") for (int x = 0; x < 4; ++x) { kb[x] = kbase_ + (kro0 ^ (x << 5)); vb[x] = vbase_ + (vro0 ^ (x << 5)); } }
#define AT_SM(FIRST) { \
      float mx = S[0][0]; \
      _Pragma("unroll") for (int m = 0; m < 2; ++m) _Pragma("unroll") for (int e = 0; e < 16; ++e) mx = fmaxf(mx, S[m][e]); \
      { const auto sw_ = __builtin_amdgcn_permlane32_swap(__float_as_uint(mx), __float_as_uint(mx), false, false); \
        mx = fmaxf(__uint_as_float(sw_[0]), __uint_as_float(sw_[1])); } \
      if ((FIRST) || __builtin_amdgcn_ballot_w64(mx > 8.f) != 0ull) { \
        const float d_ = (FIRST) ? mx : fmaxf(mx, 0.f);            \
        const float alpha = (FIRST) ? 0.f : __builtin_amdgcn_exp2f(-d_); \
        mrun += d_; \
        lsum *= alpha; \
        _Pragma("unroll") for (int m = 0; m < 4; ++m) _Pragma("unroll") for (int e = 0; e < 16; ++e) O[m][e] *= alpha; \
        _Pragma("unroll") for (int m = 0; m < 2; ++m) _Pragma("unroll") for (int e = 0; e < 16; ++e) S[m][e] -= d_; \
        _Pragma("unroll") for (int e = 0; e < 16; ++e) negm[e] = -mrun; \
      } \
      float ps = 0.f; \
      _Pragma("unroll") for (int i = 0; i < 16; ++i) { \
        const float p0_ = __builtin_amdgcn_exp2f(S[i >> 3][(2 * i) & 15]), p1_ = __builtin_amdgcn_exp2f(S[i >> 3][((2 * i) & 15) + 1]); \
        pw[i] = pack2(p0_, p1_); \
        ps = __builtin_amdgcn_fdot2_f32_bf16(__builtin_bit_cast(bf16x2v, pw[i]), __builtin_bit_cast(bf16x2v, 0x3F803F80u), ps, false); } \
      lsum += ps; }
#define AT_HEAD(kt_) { AT_DMA_K((kt_) + 2, ksn); AT_DMA_V((kt_) + 2, (vsc + 2) & 3); }
#define AT_TAIL() { \
      asm volatile("s_waitcnt vmcnt(5) lgkmcnt(0)" ::: "memory"); \
      __builtin_amdgcn_s_barrier(); \
      ksn = ksc; ksc = (ksc == 2) ? 0 : ksc + 1; \
      vsc = (vsc + 1) & 3; }
    if (wave_ < 4) {
#pragma unroll 1
      for (int kt = 0; kt < NCH; ++kt) {
        AT_BASES(ksc, vsc)
        AT_FIRST(0, 40)
        AT_HEAD(kt)
        AT_STEP8(0, 0, 40) AT_STEP8(8, 0, 40) AT_STEP8(16, 0, 40)
        AT_SM(kt == 0)
        AT_STEP8(24, 0, 40) AT_STEP8(32, 0, 40)
        AT_TAIL()
      }
    } else {
      {
        AT_BASES(ksc, vsc)
        AT_FIRST(0, 24)
        AT_HEAD(0)
        AT_STEP8(0, 0, 24) AT_STEP8(8, 0, 24) AT_STEP8(16, 0, 24)
        AT_TAIL()
      }
#pragma unroll 1
      for (int kt = 1; kt < NCH; ++kt) {
        AT_BASES(ksc, (vsc + 3) & 3)
        AT_FIRST(24, 40)
        AT_HEAD(kt)
        AT_SM(kt == 1)
        AT_STEP8(0, 24, 40) AT_STEP8(8, 24, 40) AT_STEP8(16, 24, 40) AT_STEP8(24, 24, 40) AT_STEP8(32, 24, 40)
        AT_TAIL()
      }
      {
        AT_BASES(ksc, (vsc + 3) & 3)
        AT_FIRST(24, 16)
        AT_SM(false)
        AT_STEP8(0, 24, 16) AT_STEP8(8, 24, 16)
      }
    }
    {
      const auto sw_ = __builtin_amdgcn_permlane32_swap(__float_as_uint(lsum), __float_as_uint(lsum), false, false);
      lsum = __uint_as_float(sw_[0]) + __uint_as_float(sw_[1]);
    }
    const float inv = 1.f / lsum;
    bf16_t* orow = ob + ((size_t)b * 4096 + qb * 256 + wv * 32 + r) * 1024 + hd * 128;
#pragma unroll
    for (int mo = 0; mo < 4; ++mo)
#pragma unroll
      for (int k = 0; k < 2; ++k) {
        const unsigned x0 = pack2(O[mo][8 * k] * inv, O[mo][8 * k + 1] * inv), x1 = pack2(O[mo][8 * k + 2] * inv, O[mo][8 * k + 3] * inv);
        const unsigned y0 = pack2(O[mo][8 * k + 4] * inv, O[mo][8 * k + 5] * inv), y1 = pack2(O[mo][8 * k + 6] * inv, O[mo][8 * k + 7] * inv);
        const auto s0 = __builtin_amdgcn_permlane32_swap(x0, y0, false, false);
        const auto s1 = __builtin_amdgcn_permlane32_swap(x1, y1, false, false);
        *(uint4*)(orow + mo * 32 + 16 * k + 8 * h) = make_uint4(s0[0], s1[0], s0[1], s1[1]);
      }
  }
  asm volatile("s_waitcnt vmcnt(0)" ::: "memory");
  __syncthreads();
#undef AT_DMA_K
#undef AT_DMA_V
#undef AT_STEP
#undef AT_STEP8
#undef AT_FIRST
#undef AT_BASES
#undef AT_SM
#undef AT_HEAD
#undef AT_TAIL
}

constexpr int SMEM_BYTES = 163840 - 16;


#define XB_TMO      128
#define XB_XCNT(j)  (256  + 64 * (j))
#define XB_XSUB(j)  (1280 + 64 * (j))
#define XB_XGEN(j)  (2304 + 64 * (j))
#define XB_TOP      3328
#define XB_TOPGEN   3392
#define XCD_BAR_WORDS 3456
#define XB_SPIN_CAP (1u << 22)
DI unsigned xb_ld(unsigned* p) { return __hip_atomic_load(p, __ATOMIC_RELAXED, __HIP_MEMORY_SCOPE_AGENT); }
DI unsigned xb_add(unsigned* p, unsigned v) { return __hip_atomic_fetch_add(p, v, __ATOMIC_RELAXED, __HIP_MEMORY_SCOPE_AGENT); }
DI unsigned xb_xcc_id() { return (unsigned)__builtin_amdgcn_s_getreg((3 << 11) | 20) & 0xFu; }
#define XB_SPIN(cond, bar) do { unsigned _sp = 0; while (cond) { __builtin_amdgcn_s_sleep(1); \
    if ((++_sp & 255u) == 0u) { if (xb_ld(&(bar)[XB_TMO])) break; if (_sp > XB_SPIN_CAP) { atomicAdd(&(bar)[XB_TMO], 1u); break; } } } } while (0)
struct XcdBarrier { unsigned* bar; unsigned x; volatile LAS unsigned* st; };
DI XcdBarrier xcd_barrier_post(unsigned* bar, volatile LAS unsigned* st, int tid) {
  XcdBarrier b; b.bar = bar; b.x = xb_xcc_id(); b.st = st;
  if (tid == 0) st[3] = xb_add(&bar[XB_XCNT(b.x)], 1u);
  return b;
}
DI void xcd_barrier_complete(unsigned* bar, unsigned x, unsigned& nloc, unsigned& nx, unsigned& dense) {
  const unsigned G = gridDim.x * gridDim.y * gridDim.z;
  unsigned sum, cnt, mine, below, sp = 0u;
  for (;;) {
    sum = 0u; cnt = 0u; mine = 0u; below = 0u;
#pragma unroll
    for (unsigned j = 0; j < 16; ++j) { const unsigned c = xb_ld(&bar[XB_XCNT(j)]); sum += c; cnt += (c > 0u) ? 1u : 0u; mine = (j == x) ? c : mine; below += (j < x && c > 0u) ? 1u : 0u; }
    if (sum == G) break;
    __builtin_amdgcn_s_sleep(1);
    if ((++sp & 255u) == 0u) { if (xb_ld(&bar[XB_TMO])) break; if (sp > XB_SPIN_CAP) { atomicAdd(&bar[XB_TMO], 1u); break; } }
  }
  nloc = mine > 0u ? mine : 1u; nx = cnt > 0u ? cnt : 1u; dense = below;
}
DI void xcd_barrier(const XcdBarrier& b, int tid) {
  asm volatile("s_waitcnt vmcnt(0)" ::: "memory");
  __syncthreads();
  if (tid == 0) {
    unsigned* bar = b.bar;
    __builtin_amdgcn_s_waitcnt(0);
    unsigned nloc = b.st[0], nx = b.st[1];
    if (nloc == 0u) { unsigned dense; xcd_barrier_complete(bar, b.x, nloc, nx, dense); b.st[0] = nloc; b.st[1] = nx; b.st[2] = dense; }
    const unsigned old = xb_add(&bar[XB_XSUB(b.x)], 1u);
    const unsigned gen = old / nloc;
    if (old + 1u == (gen + 1u) * nloc) {
      __builtin_amdgcn_fence(__ATOMIC_RELEASE, "agent");
      asm volatile("s_waitcnt vmcnt(0)" ::: "memory");
      const unsigned og = xb_add(&bar[XB_TOP], 1u);
      const unsigned tg = og / nx;
      if (og + 1u == (tg + 1u) * nx) xb_add(&bar[XB_TOPGEN], 1u);
      else XB_SPIN(xb_ld(&bar[XB_TOPGEN]) == tg, bar);
      __builtin_amdgcn_fence(__ATOMIC_ACQUIRE, "agent");
      xb_add(&bar[XB_XGEN(b.x)], 1u);
      asm volatile("s_waitcnt vmcnt(0)" ::: "memory");
    } else {
      XB_SPIN(xb_ld(&bar[XB_XGEN(b.x)]) == gen, bar);
      __builtin_amdgcn_fence(__ATOMIC_ACQUIRE, "agent");
      asm volatile("s_waitcnt vmcnt(0)" ::: "memory");
    }
  }
  __syncthreads();
}

#ifndef DUP_MASK
#define DUP_MASK 0
#endif
#define RUNP(ph, call) { call; if ((DUP_MASK >> (ph)) & 1) { call; } }
#define GATHER_SEQ(L) phase_gather(p, L, wave_);
#define PHASE_LIST(SYNC) \
  RUNP(0, phase_prep(p, smem, wave_)); SYNC; \
  RUNP(1, phase_h0(p, smem, wave_)); SYNC; \
  RUNP(2, phase_inproj0(p, smem, wave_)); SYNC; \
  RUNP(3, phase_g1(p, smem, wave_)); SYNC; \
  RUNP(4, phase_g2(p, smem, wave_)); SYNC; \
  RUNP(5, phase_yb(p, wave_)); SYNC; \
  RUNP(6, phase_outproj(p, smem, 0, wave_)); convert_in_tail(p, 0, (TT / 256) * 4, wave_); SYNC; \
  RUNP(8, phase_peerq(p, smem, 0, wave_)); convert_in_tail(p, 1, (TT / 256) * 4, wave_, 2); SYNC; \
  GATHER_SEQ(0) SYNC; \
  RUNP(10, phase_inproj1(p, smem, wave_)); SYNC; \
  RUNP(11, phase_upproj_q(p, smem, wave_); phase_upproj_kv(p, smem, wave_)); SYNC; \
  RUNP(12, phase_attn(p, smem, wave_)); SYNC; \
  phase_outproj(p, smem, 1, wave_); SYNC; \
  RUNP(15, phase_peerq(p, smem, 1, wave_)); SYNC; \
  GATHER_SEQ(1)

#if MEGA
__global__ void __launch_bounds__(NT) mega_kernel(Params p) {
  __shared__ __attribute__((aligned(16))) char smem[SMEM_BYTES + 16];
  cg::grid_group grid = cg::this_grid();
  const int wave_ = __builtin_amdgcn_readfirstlane((int)(__builtin_amdgcn_workitem_id_x() >> 6));
  volatile LAS unsigned* xst = (volatile LAS unsigned*)(smem + SMEM_BYTES);
  if (TIDX == 0) { xst[0] = 0u; xst[1] = 0u; xst[2] = 0u; xst[3] = 0u; }
  __syncthreads();
  const XcdBarrier xb = xcd_barrier_post((unsigned*)(p.ws + OFF_BAR), xst, TIDX);
  if (gridDim.z == 3) grid.sync();
#define SEAM { xcd_barrier(xb, TIDX); }
  PHASE_LIST(SEAM)
#undef SEAM
}
#else
template <int PH>
__global__ void __launch_bounds__(NT) phase_kernel(Params p) {
  __shared__ __attribute__((aligned(16))) char smem[SMEM_BYTES];
  const int wave_ = __builtin_amdgcn_readfirstlane((int)(__builtin_amdgcn_workitem_id_x() >> 6));
  switch (PH) {
    case 0: phase_prep(p, smem, wave_); break;
    case 1: phase_h0(p, smem, wave_); break;
    case 2: phase_inproj0(p, smem, wave_); break;
    case 3: phase_g1(p, smem, wave_); break;
    case 4: phase_g2(p, smem, wave_); break;
    case 5: phase_yb(p, wave_); break;
    case 6: phase_outproj(p, smem, 0, wave_); break;
    case 7: phase_hnorm(p, p.norm2, 0, 3, TT, wave_); convert_tables(p, 0, blockIdx.x, gridDim.x, wave_); convert_tables(p, 1, blockIdx.x, gridDim.x, wave_); break;
    case 8: phase_peerq(p, smem, 0, wave_); break;
    case 9: phase_gather(p, 0, wave_); break;
    case 10: phase_inproj1(p, smem, wave_); break;
    case 11: phase_upproj_q(p, smem, wave_); phase_upproj_kv(p, smem, wave_); break;
    case 12: phase_attn(p, smem, wave_); break;
    case 13: phase_outproj(p, smem, 1, wave_); break;
    case 14: phase_hnorm(p, p.norm2 + 1024, 1, 3, TX, wave_); break;
    case 15: phase_peerq(p, smem, 1, wave_); break;
    case 16: phase_gather(p, 1, wave_); break;
  }
}
#endif

extern "C" void kernel_launch(void* const* d_in, const int* in_sizes, int n_in, void* d_out, int out_size, void* d_ws,
                              size_t ws_size, hipStream_t stream) {
  (void)in_sizes; (void)n_in; (void)out_size; (void)ws_size;
  Params p{};
  const float** f = (const float**)&p;
  for (int i = 0; i < 26; ++i) f[i] = (const float*)d_in[i];
  p.out = (float*)d_out;
  p.ws = (char*)d_ws;
#if MEGA
  static int grid_blocks = 0;
  if (!grid_blocks) {
    int dev = 0, cus = 0, per_cu = 0;
    hipGetDevice(&dev);
    hipDeviceGetAttribute(&cus, hipDeviceAttributeMultiprocessorCount, dev);
    hipOccupancyMaxActiveBlocksPerMultiprocessor(&per_cu, mega_kernel, NT, 0);
    if (per_cu > 1) per_cu = 1;
    grid_blocks = cus * per_cu;
  }
  hipMemsetAsync((char*)d_ws + OFF_BAR, 0, 16384, stream);
  void* args[] = {&p};
  hipLaunchCooperativeKernel((void*)mega_kernel, dim3(grid_blocks), dim3(NT), args, 0, stream);
#else
  const dim3 g(256), b(NT);
  phase_kernel<0><<<g, b, 0, stream>>>(p);
  phase_kernel<1><<<g, b, 0, stream>>>(p);
  phase_kernel<2><<<g, b, 0, stream>>>(p);
  phase_kernel<3><<<g, b, 0, stream>>>(p);
  phase_kernel<4><<<g, b, 0, stream>>>(p);
  phase_kernel<5><<<g, b, 0, stream>>>(p);
  phase_kernel<6><<<g, b, 0, stream>>>(p);
  phase_kernel<7><<<g, b, 0, stream>>>(p);
  phase_kernel<8><<<g, b, 0, stream>>>(p);
  phase_kernel<9><<<g, b, 0, stream>>>(p);
  phase_kernel<10><<<g, b, 0, stream>>>(p);
  phase_kernel<11><<<g, b, 0, stream>>>(p);
  phase_kernel<12><<<g, b, 0, stream>>>(p);
  phase_kernel<13><<<g, b, 0, stream>>>(p);
  phase_kernel<14><<<g, b, 0, stream>>>(p);
  phase_kernel<15><<<g, b, 0, stream>>>(p);
  phase_kernel<16><<<g, b, 0, stream>>>(p);
#endif
}
```
